# Optimizing an MI355X kernel written in HIP

```python
import math
import jax, jax.numpy as jnp
from jax import lax
import numpy as np


D_MODEL = 2048
BATCH = 4
SEQ = 4096
DEPTH = 2

PLE_DIM = 256
N_BRANCH = 3
BRANCH_WIDTH = D_MODEL // 2
A_HEADS = 8
A_HEAD_DIM = BRANCH_WIDTH // A_HEADS
MOBA_BLOCK = 256
MOBA_TOPK = 3
MOBA_CHUNK = 32
B_Q_HEADS = 16
B_KV_HEADS = 4
B_HEAD_DIM = BRANCH_WIDTH // B_Q_HEADS
B_KV_WIDTH = B_KV_HEADS * B_HEAD_DIM
WINDOW = 128
C_BLOCKS = 8
C_BLOCK_DIM = BRANCH_WIDTH // C_BLOCKS
CONV_WIDTH = 4
LRU_C = 8.0
RPE_BUCKETS = 32
RPE_MAX_DIST = 128
RPE_HEADS = A_HEADS + B_Q_HEADS
EPS = 1e-6
NEG = -1e30
IN_SPLIT_SIZES = (BRANCH_WIDTH, BRANCH_WIDTH, BRANCH_WIDTH, BRANCH_WIDTH,
                  BRANCH_WIDTH, B_KV_WIDTH, B_KV_WIDTH, BRANCH_WIDTH,
                  BRANCH_WIDTH, BRANCH_WIDTH,
                  N_BRANCH * D_MODEL)
IN_WIDTH = sum(IN_SPLIT_SIZES)

kernel_name = 'hybrid_moba_swa_rglru_gated_merge'


def rmsnorm(x, g):
    xf = x.astype(jnp.float32)
    y = xf * lax.rsqrt(jnp.mean(xf * xf, axis=-1, keepdims=True) + EPS)
    return (y * g.astype(jnp.float32)).astype(x.dtype)


def t5_bucket(dist):
    n = jnp.maximum(dist, 0)
    max_exact = RPE_BUCKETS // 2
    large = max_exact + (jnp.log(jnp.maximum(n, 1).astype(jnp.float32) / max_exact)
                         / math.log(RPE_MAX_DIST / max_exact)
                         * (RPE_BUCKETS - max_exact)).astype(jnp.int32)
    large = jnp.minimum(large, RPE_BUCKETS - 1)
    return jnp.where(n < max_exact, n, large)


def moba_attention(q, k, v, table):
    bsz, seq, nh, dh = q.shape
    L = MOBA_BLOCK
    nb = -(-seq // L)
    pad = nb * L - seq
    scale = dh ** -0.5
    qh = q.transpose(0, 2, 1, 3)
    kb = jnp.pad(k, ((0, 0), (0, pad), (0, 0), (0, 0))).reshape(bsz, nb, L, nh, dh).transpose(0, 3, 1, 2, 4)
    vb = jnp.pad(v, ((0, 0), (0, pad), (0, 0), (0, 0))).reshape(bsz, nb, L, nh, dh).transpose(0, 3, 1, 2, 4)
    qblk = jnp.arange(seq) // L
    n_sel = min(MOBA_TOPK, nb - 1)
    if n_sel > 0:
        kmean = jnp.mean(kb.astype(jnp.float32), axis=3)
        gate = jnp.einsum('bhsd,bhnd->bhsn', qh.astype(jnp.float32), kmean)
        past = jnp.arange(nb)[None, :] < qblk[:, None]
        gate = jnp.where(past, gate, NEG)
        _, sel = lax.top_k(gate, n_sel)
    bi = jnp.arange(bsz)[:, None, None, None]
    hi = jnp.arange(nh)[None, :, None, None]

    def chunk(c):
        start = c * MOBA_CHUNK
        qc = lax.dynamic_slice_in_dim(qh, start, MOBA_CHUNK, axis=2)
        qpos = start + jnp.arange(MOBA_CHUNK)
        j = start // L
        k_own = lax.dynamic_index_in_dim(kb, j, axis=2, keepdims=False)
        v_own = lax.dynamic_index_in_dim(vb, j, axis=2, keepdims=False)
        dist = qpos[:, None] - (j * L + jnp.arange(L))[None, :]
        s_own = jnp.einsum('bhcd,bhld->bhcl', qc, k_own, preferred_element_type=jnp.float32) * scale
        s_own = s_own + table[:, t5_bucket(dist)].astype(jnp.float32)
        s_own = jnp.where(dist >= 0, s_own, NEG)
        if n_sel == 0:
            p_own = jax.nn.softmax(s_own, axis=-1).astype(v.dtype)
            return jnp.einsum('bhcl,bhld->bhcd', p_own, v_own)
        idx = lax.dynamic_slice_in_dim(sel, start, MOBA_CHUNK, axis=2)
        k_g = kb[bi, hi, idx]
        v_g = vb[bi, hi, idx]
        dist_g = qpos[None, None, :, None, None] - (idx[..., None] * L + jnp.arange(L))
        s_g = jnp.einsum('bhcd,bhcnld->bhcnl', qc, k_g, preferred_element_type=jnp.float32) * scale
        s_g = s_g + table[hi[..., None], t5_bucket(dist_g)].astype(jnp.float32)
        s_g = jnp.where((idx < j)[..., None], s_g, NEG)
        logits = jnp.concatenate([s_g.reshape(bsz, nh, MOBA_CHUNK, n_sel * L), s_own], axis=-1)
        p = jax.nn.softmax(logits, axis=-1).astype(v.dtype)
        p_g = p[..., :n_sel * L].reshape(bsz, nh, MOBA_CHUNK, n_sel, L)
        p_own = p[..., n_sel * L:]
        return (jnp.einsum('bhcnl,bhcnld->bhcd', p_g, v_g)
                + jnp.einsum('bhcl,bhld->bhcd', p_own, v_own))

    out = lax.map(chunk, jnp.arange(seq // MOBA_CHUNK))
    return out.transpose(1, 0, 3, 2, 4).reshape(bsz, seq, nh * dh)


def swa_attention(q, k, v, sinks, table):
    bsz, seq, hq, dh = q.shape
    hkv = k.shape[2]
    grp = hq // hkv
    W = WINDOW
    nb = seq // W
    scale = dh ** -0.5
    qb = q.reshape(bsz, nb, W, hkv, grp, dh)
    kb = k.reshape(bsz, nb, W, hkv, dh)
    vb = v.reshape(bsz, nb, W, hkv, dh)
    kband = jnp.concatenate([jnp.pad(kb, ((0, 0), (1, 0), (0, 0), (0, 0), (0, 0)))[:, :-1], kb], axis=2)
    vband = jnp.concatenate([jnp.pad(vb, ((0, 0), (1, 0), (0, 0), (0, 0), (0, 0)))[:, :-1], vb], axis=2)
    s = jnp.einsum('bnqhgd,bnlhd->bhgnql', qb, kband, preferred_element_type=jnp.float32) * scale
    koff = jnp.arange(2 * W) - W
    dist = jnp.arange(W)[:, None] - koff[None, :]
    bias = table[t5_bucket(dist)].transpose(2, 0, 1).reshape(hkv, grp, 1, W, 2 * W)
    s = s + bias.astype(jnp.float32)
    kpos = jnp.arange(nb)[:, None, None] * W + koff[None, None, :]
    mask = (dist >= 0)[None] & (dist < W)[None] & (kpos >= 0)
    s = jnp.where(mask, s, NEG)
    sink_col = jnp.broadcast_to(sinks.astype(jnp.float32).reshape(1, hkv, grp, 1, 1, 1), s.shape[:-1] + (1,))
    p = jax.nn.softmax(jnp.concatenate([s, sink_col], axis=-1), axis=-1)[..., :-1].astype(v.dtype)
    out = jnp.einsum('bhgnql,bnlhd->bnqhgd', p, vband)
    return out.reshape(bsz, seq, hq * dh)


def rglru_branch(xc, conv_w, conv_b, w_r, b_r, w_i, b_i, lam):
    bsz, seq, ch = xc.shape
    conv = lax.conv_general_dilated(xc, conv_w.reshape(CONV_WIDTH, 1, ch), window_strides=(1,),
                                    padding=[(CONV_WIDTH - 1, 0)], dimension_numbers=('NWC', 'WIO', 'NWC'),
                                    feature_group_count=ch) + conv_b
    xb = conv.reshape(bsz, seq, C_BLOCKS, C_BLOCK_DIM)
    r = jax.nn.sigmoid((jnp.einsum('bsnc,ncd->bsnd', xb, w_r).reshape(bsz, seq, ch) + b_r).astype(jnp.float32))
    i = jax.nn.sigmoid((jnp.einsum('bsnc,ncd->bsnd', xb, w_i).reshape(bsz, seq, ch) + b_i).astype(jnp.float32))
    log_a = -LRU_C * r * jax.nn.softplus(-lam.astype(jnp.float32))
    a = jnp.exp(log_a)
    b = jnp.sqrt(jnp.maximum(-jnp.expm1(2.0 * log_a), 0.0)) * (i * conv.astype(jnp.float32))

    def combine(left, right):
        a1, b1 = left
        a2, b2 = right
        return a1 * a2, a2 * b1 + b2

    _, h = lax.associative_scan(combine, (a, b), axis=1)
    return h.astype(xc.dtype)


def mixer_layer(x, p_i, rpe_table, norm_g, w_in, sinks, conv_w, conv_b, w_r, b_r, w_i, b_i, lam,
                w_br, w_out, ple_norm_g, w_pg, w_pp):
    bsz, seq, _ = x.shape
    h = rmsnorm(x, norm_g)
    proj = h @ w_in
    cuts = [int(c) for c in np.cumsum(IN_SPLIT_SIZES)[:-1]]
    qa, ka, va, ga, qb, kb, vb, gb, xc, gc, mg = jnp.split(proj, cuts, axis=-1)
    ya = moba_attention(qa.reshape(bsz, seq, A_HEADS, A_HEAD_DIM), ka.reshape(bsz, seq, A_HEADS, A_HEAD_DIM),
                        va.reshape(bsz, seq, A_HEADS, A_HEAD_DIM), rpe_table[:, :A_HEADS].T)
    yb = swa_attention(qb.reshape(bsz, seq, B_Q_HEADS, B_HEAD_DIM), kb.reshape(bsz, seq, B_KV_HEADS, B_HEAD_DIM),
                       vb.reshape(bsz, seq, B_KV_HEADS, B_HEAD_DIM), sinks, rpe_table[:, A_HEADS:])
    yc = rglru_branch(xc, conv_w, conv_b, w_r, b_r, w_i, b_i, lam)
    y = jnp.stack([ya * jax.nn.silu(ga), yb * jax.nn.silu(gb), yc * jax.nn.silu(gc)], axis=2)
    y_d = jnp.einsum('bsnc,ncd->bsnd', y, w_br)
    gates = jax.nn.sigmoid(mg.reshape(bsz, seq, N_BRANCH, D_MODEL))
    merged = jnp.einsum('bsnd,bsnd->bsd', gates, y_d)
    x = x + merged @ w_out
    x = x + jax.nn.sigmoid(rmsnorm(x, ple_norm_g) @ w_pg) * (p_i @ w_pp)
    return x


def setup_inputs(seed: int = 0) -> dict:
    key = jax.random.key(seed)
    ks = jax.random.split(key, 20)
    f32 = jnp.float32
    nrm = lambda k, shape, s: jax.random.normal(k, shape, f32) * s
    a8 = jax.random.uniform(ks[12], (DEPTH, BRANCH_WIDTH), f32, 0.9, 0.999)
    a = a8 ** (1.0 / LRU_C)
    lam = jnp.log(a) - jnp.log1p(-a)
    return {
        'x': nrm(ks[0], (BATCH, SEQ, D_MODEL), 1.0),
        'p': nrm(ks[1], (DEPTH, BATCH, SEQ, PLE_DIM), 1.0),
        'rpe_table': nrm(ks[2], (RPE_BUCKETS, RPE_HEADS), 0.1),
        'norm_g': 1.0 + nrm(ks[3], (DEPTH, D_MODEL), 0.02),
        'w_in': nrm(ks[4], (DEPTH, D_MODEL, IN_WIDTH), D_MODEL ** -0.5),
        'sinks': nrm(ks[5], (DEPTH, B_Q_HEADS), 0.5),
        'conv_w': nrm(ks[6], (DEPTH, CONV_WIDTH, BRANCH_WIDTH), CONV_WIDTH ** -0.5),
        'conv_b': nrm(ks[7], (DEPTH, BRANCH_WIDTH), 0.01),
        'w_r': nrm(ks[8], (DEPTH, C_BLOCKS, C_BLOCK_DIM, C_BLOCK_DIM), C_BLOCK_DIM ** -0.5),
        'b_r': nrm(ks[9], (DEPTH, BRANCH_WIDTH), 0.01),
        'w_i': nrm(ks[10], (DEPTH, C_BLOCKS, C_BLOCK_DIM, C_BLOCK_DIM), C_BLOCK_DIM ** -0.5),
        'b_i': nrm(ks[11], (DEPTH, BRANCH_WIDTH), 0.01),
        'lam': lam,
        'w_br': nrm(ks[13], (DEPTH, N_BRANCH, BRANCH_WIDTH, D_MODEL), BRANCH_WIDTH ** -0.5),
        'w_out': nrm(ks[14], (DEPTH, D_MODEL, D_MODEL), D_MODEL ** -0.5),
        'ple_norm_g': 1.0 + nrm(ks[15], (DEPTH, D_MODEL), 0.02),
        'w_pg': nrm(ks[16], (DEPTH, D_MODEL, D_MODEL), D_MODEL ** -0.5),
        'w_pp': nrm(ks[17], (DEPTH, PLE_DIM, D_MODEL), PLE_DIM ** -0.5),
        'final_norm_g': 1.0 + nrm(ks[18], (D_MODEL,), 0.02),
    }


def reference(x, p, rpe_table, norm_g, w_in, sinks, conv_w, conv_b, w_r, b_r, w_i, b_i, lam,
              w_br, w_out, ple_norm_g, w_pg, w_pp, final_norm_g):
    for i in range(DEPTH):
        x = mixer_layer(x, p[i], rpe_table, norm_g[i], w_in[i], sinks[i], conv_w[i], conv_b[i],
                        w_r[i], b_r[i], w_i[i], b_i[i], lam[i], w_br[i], w_out[i],
                        ple_norm_g[i], w_pg[i], w_pp[i])
    return rmsnorm(x, final_norm_g)
```

```cpp
#include <hip/hip_runtime.h>
#include <hip/hip_cooperative_groups.h>
#include <cstdio>
#include <cstdint>
namespace cg = cooperative_groups;

#define LAS __attribute__((address_space(3)))
typedef unsigned short bf16_t;
typedef short bf16x8 __attribute__((ext_vector_type(8)));
typedef float f32x4 __attribute__((ext_vector_type(4)));
typedef float f32x2 __attribute__((ext_vector_type(2)));
typedef float f32x16 __attribute__((ext_vector_type(16)));
typedef unsigned u32x4 __attribute__((ext_vector_type(4)));
typedef unsigned u32x2 __attribute__((ext_vector_type(2)));
typedef __bf16 bf16x2_t __attribute__((ext_vector_type(2)));

constexpr int BATCH = 4, SEQ = 4096, DM = 2048, M = BATCH * SEQ, DEPTH = 2, PLE = 256;
constexpr int NIN = 14848, NA = 8704, NG = 6144;
constexpr int C_QA = 0, C_KA = 1024, C_VA = 2048, C_GA = 3072, C_QB = 4096, C_KB = 5120, C_VB = 5376, C_GB = 5632, C_XC = 6656, C_GC = 7680;
constexpr float EPS = 1e-6f, LOG2E = 1.4426950408889634f, NEGF = -1e30f;

constexpr size_t SZ_WIN = (size_t)DEPTH * NIN * DM * 2, SZ_WBR = (size_t)DEPTH * 3 * DM * 1024 * 2, SZ_WSQ = (size_t)DEPTH * DM * DM * 2;
constexpr size_t SZ_WPP = (size_t)DEPTH * DM * PLE * 2, SZ_WRI = (size_t)DEPTH * 8 * 128 * 128 * 2;
constexpr int N8 = 10752, NB16 = 4096;
constexpr size_t OFF_WIN = 0, OFF_WIN8 = OFF_WIN, OFF_WINB = OFF_WIN8 + (size_t)DEPTH * N8 * DM, OFF_XB8 = OFF_WINB + (size_t)DEPTH * NB16 * DM * 2, OFF_WBR = OFF_WIN + SZ_WIN, OFF_WOUT = OFF_WBR + SZ_WBR, OFF_WPG = OFF_WOUT + SZ_WSQ, OFF_WPP = OFF_WPG + SZ_WSQ;
constexpr size_t OFF_WR = OFF_WPP + SZ_WPP, OFF_WI = OFF_WR + SZ_WRI;
constexpr size_t OFF_XB = OFF_WI + SZ_WRI;
constexpr size_t OFF_VTA = OFF_XB, OFF_VTB = OFF_XB + (size_t)BATCH * 1024 * SEQ * 2;
constexpr size_t OFF_PA = OFF_XB + (size_t)M * DM * 2;
constexpr size_t OFF_X1 = OFF_PA, OFF_MG = OFF_X1 + (size_t)M * DM * 4, OFF_XB1 = OFF_MG + (size_t)M * DM * 2;
constexpr size_t OFF_GT = OFF_PA + (size_t)M * NA * 2;
constexpr size_t OFF_Y = OFF_GT + (size_t)M * NG * 2;
constexpr size_t OFF_T = OFF_Y;
constexpr size_t OFF_Y8 = OFF_Y, OFF_YC = OFF_Y + (size_t)M * 2048;
constexpr size_t OFF_WBR8 = OFF_XB8 + (size_t)M * DM;
static_assert(OFF_WBR8 + (size_t)DEPTH * 2 * DM * 1024 <= OFF_WBR, "WBR8 fits");
constexpr size_t OFF_PB = OFF_Y + (size_t)M * 3072 * 2;
constexpr size_t OFF_SSQ = OFF_PB + (size_t)DEPTH * M * PLE * 2;
constexpr size_t OFF_KM = OFF_SSQ + (size_t)5 * M * 4;
constexpr size_t OFF_CHA = OFF_KM + (size_t)BATCH * 8 * 16 * 128 * 2, OFF_CHH = OFF_CHA + (size_t)BATCH * 64 * 1024 * 4;
constexpr size_t OFF_BAR = OFF_CHH + (size_t)BATCH * 64 * 1024 * 4, BAR_BYTES = 16384;
constexpr size_t OFF_SELCNT = OFF_BAR + BAR_BYTES;
constexpr size_t OFF_LIST = OFF_SELCNT + 4096;
constexpr size_t OFF_HL = OFF_LIST + (size_t)32 * 16 * 4096 * 4, OFF_CA = OFF_HL + (size_t)M * 1024 * 2;
constexpr size_t OFF_PO = OFF_HL;
constexpr size_t OFF_ML = OFF_PO + (size_t)32 * SEQ * 3 * 128 * 2;
constexpr size_t WS_END = OFF_ML + (size_t)32 * SEQ * 3 * 2 * 4;
static_assert(WS_END <= (size_t)973078528, "workspace budget (4 x largest tensor)");
static_assert(OFF_XB1 + (size_t)M * DM * 2 <= OFF_GT, "overlay fits");
static_assert(OFF_XB8 + (size_t)M * DM <= OFF_WBR, "fp8 / bf16 in-projection weight copies + fp8 x fit the old WIN region");
static_assert(OFF_VTB + (size_t)BATCH * 256 * SEQ * 2 <= OFF_PA, "VT overlay fits");

constexpr int LDS_BYTES = 147456;
constexpr int NTHR = 512;

__device__ __forceinline__ unsigned pk2(float lo, float hi) { f32x2 v = {lo, hi}; bf16x2_t b = __builtin_convertvector(v, bf16x2_t); return __builtin_bit_cast(unsigned, b); }
__device__ __forceinline__ float bf_lo(unsigned u) { return __uint_as_float(u << 16); }
__device__ __forceinline__ float bf_hi(unsigned u) { return __uint_as_float(u & 0xffff0000u); }
__device__ __forceinline__ float sigm(float v) { return __builtin_amdgcn_rcpf(1.f + __expf(-v)); }
__device__ __forceinline__ int opq(int v) { asm volatile("" : "+v"(v)); return v; }
__device__ __forceinline__ int sopq(int v) { asm volatile("" : "+s"(v)); return v; }
template <class T> __device__ __forceinline__ T launder_s(T p) { asm volatile("" : "+s"(p)); return p; }
__device__ __forceinline__ int lane_id() { return (int)__builtin_amdgcn_mbcnt_hi(~0u, __builtin_amdgcn_mbcnt_lo(~0u, 0u)); }
__device__ __forceinline__ int crow(int r, int hi) { return (r & 3) + 8 * (r >> 2) + 4 * hi; }
__device__ __forceinline__ float wave_sum(float v) {
#pragma unroll
    for (int o = 1; o < 64; o <<= 1) v += __shfl_xor(v, o);
    return v;
}
__device__ __forceinline__ int t5_bucket(int n) {
    if (n < 16) return n;
    int b = 16;
    b += (n >= 19); b += (n >= 21); b += (n >= 24); b += (n >= 27); b += (n >= 31); b += (n >= 35); b += (n >= 40); b += (n >= 46);
    b += (n >= 52); b += (n >= 59); b += (n >= 67); b += (n >= 77); b += (n >= 87); b += (n >= 99); b += (n >= 113);
    return b;
}

namespace pg8 {
constexpr int BM = 256, BK = 64, HALF = 128, HTB = HALF * BK * 2, STAGE_BYTES = 8 * HTB, NXCD = 8, WGM = 8;
__device__ __forceinline__ int lds_byte(int r, int c) { const int st = (r >> 4) * 2 + (c >> 5), rr = r & 15, cc = c & 31, ob = rr * 64 + cc * 2; return st * 1024 + (ob ^ (((ob >> 9) & 1) << 5)); }
__device__ __forceinline__ void stage_rc(int b, int& R, int& C) { const int st = b / 1024, sb = b % 1024, swz = sb ^ (((sb >> 9) & 1) << 5); R = (st >> 1) * 16 + swz / 64; C = (st & 1) * 32 + (swz % 64) / 2; }
__device__ __forceinline__ int perm32(int rho) { const int n = rho >> 4, i = rho & 15; return 8 * (i >> 2) + 4 * n + (i & 3); }

typedef int v4i_t __attribute__((ext_vector_type(4)));
typedef int v8i_t __attribute__((ext_vector_type(8)));
__device__ __forceinline__ v8i_t cat8(bf16x8 lo, bf16x8 hi) { return __builtin_shufflevector(__builtin_bit_cast(v4i_t, lo), __builtin_bit_cast(v4i_t, hi), 0, 1, 2, 3, 4, 5, 6, 7); }
__device__ __forceinline__ void glds16_s(const char* sbase, unsigned voff, unsigned ldsbase, int imm) { unsigned keep;
    asm volatile("s_mov_b32 %0, m0\n\ts_add_i32 m0, %3, %4\n\ts_nop 0\n\tglobal_load_lds_dwordx4 %1, %2\n\ts_mov_b32 m0, %0" : "=&s"(keep) : "v"(voff), "s"(sbase), "s"(ldsbase), "i"(imm) : "memory", "scc"); }
struct Unit { int pm, pn, z; };
struct Gemm { const bf16_t* A; const bf16_t* Bt; int lda, ldb, K; size_t zA, zB; int wave; };

struct StaticOrder {
    int nM, nN, nwg, G, c;
    __device__ void init(int M_, int N_, int G_, int c_) { nM = M_ / BM; nN = N_ / BM; nwg = nM * nN; G = G_; c = c_; }
    __device__ bool next(int i, Unit& u) const {
        const long L = (long)i * G + c; if (L >= nwg) return false;
        int wgid = (int)L; { const int q = nwg / NXCD, r = nwg % NXCD, xcd = wgid % NXCD, off = wgid / NXCD; wgid = (xcd < r ? xcd * (q + 1) : r * (q + 1) + (xcd - r) * q) + off; }
        const int nig = WGM * nN, gid = wgid / nig, fm = gid * WGM, gsz = (nM - fm) < WGM ? (nM - fm) : WGM;
        u.pm = fm + ((wgid % nig) % gsz); u.pn = (wgid % nig) / gsz; u.z = 0; return true;
    }
};
struct ZOrder2 {
    StaticOrder S;
    __device__ bool next(int i, Unit& u) const { if (!S.next(i >> 1, u)) return false; u.z = i & 1; return true; }
};
struct ZFixed {
    StaticOrder S; int z;
    __device__ bool next(int i, Unit& u) const { if (!S.next(i, u)) return false; u.z = z; return true; }
};

template <class Epi, class Sched, bool ALIGN_EPI, bool F8 = false>
__device__ __forceinline__ void gemm_phase(LAS unsigned char* lds, const Gemm g, const Sched& S, const Epi& E) {
    const int wid = __builtin_amdgcn_readfirstlane(g.wave), tid = opq((wid << 6) | lane_id()), lane = tid & 63, wr = wid >> 2, wc = wid & 3, fr = lane & 15, fq = lane >> 4;
    const int K = g.K, nt = K / BK;
    unsigned voffA[2], voffB[2];
#pragma unroll
    for (int i = 0; i < 2; ++i) { int R, C; stage_rc(tid * 16 + i * 8192, R, C); const int Rb = (R & ~31) + perm32(R & 31);
        voffA[i] = (unsigned)(R * g.lda + C) * 2u; voffB[i] = (unsigned)(Rb * g.ldb + C) * 2u; }
    const unsigned kstep = (unsigned)(BK * 2);
    const unsigned hstepA = (unsigned)HALF * g.lda * 2u, hstepB = (unsigned)HALF * g.ldb * 2u;
    const unsigned tstepA = 2u * hstepA, tstepB = 2u * hstepB;
    const unsigned ldsw = (unsigned)wid * 1024u;
    const unsigned lds_w32 = (unsigned)__builtin_amdgcn_readfirstlane((int)((unsigned)(uintptr_t)lds + ldsw));
    constexpr int KOFF = F8 ? 16 : 1024;
    const int aoff = lds_byte(wr * 64 + fr, F8 ? fq * 16 : fq * 8), boff = lds_byte(wc * 32 + fr, F8 ? fq * 16 : fq * 8);
#define PG8_SA(b, h) (((b) * 2 + (h)) * HTB)
#define PG8_SB(b, h) ((4 + (b) * 2 + (h)) * HTB)
#define PG8_STAGE_X(bufoff, rs, base, off, voff) do { _Pragma("unroll") for (int _i = 0; _i < 2; ++_i) { \
        if constexpr (F8) __builtin_amdgcn_raw_ptr_buffer_load_lds(rs, (LAS void*)(lds + (bufoff) + ldsw + _i * 8192), 16, (int)(voff)[_i], (int)(unsigned)(off), 0, 0); \
        else __builtin_amdgcn_global_load_lds((const unsigned*)((const char*)(base) + (size_t)((off) + (voff)[_i])), (LAS unsigned*)(lds + (bufoff) + ldsw + _i * 8192), 16, 0, 0); } } while (0)
#define PG8_STAGE_A(bufoff, off) PG8_STAGE_X(bufoff, rsA, g.A, off, voffA)
#define PG8_STAGE_B(bufoff, off) PG8_STAGE_X(bufoff, rsB, g.Bt, off, voffB)
#define PG8_LDA(dst, b, h) do { _Pragma("unroll") for (int m = 0; m < 4; ++m) _Pragma("unroll") for (int k = 0; k < 2; ++k) { const v4i_t f_ = *(const LAS v4i_t*)(lds + PG8_SA(b, h) + aoff + m * 2048 + k * KOFF); dst[m][4 * k] = f_[0]; dst[m][4 * k + 1] = f_[1]; dst[m][4 * k + 2] = f_[2]; dst[m][4 * k + 3] = f_[3]; } } while (0)
#define PG8_LDB(dst, b, h) do { _Pragma("unroll") for (int n = 0; n < 2; ++n) _Pragma("unroll") for (int k = 0; k < 2; ++k) { const v4i_t f_ = *(const LAS v4i_t*)(lds + PG8_SB(b, h) + boff + n * 2048 + k * KOFF); dst[n][4 * k] = f_[0]; dst[n][4 * k + 1] = f_[1]; dst[n][4 * k + 2] = f_[2]; dst[n][4 * k + 3] = f_[3]; } } while (0)
#define PG8_HALF(v, k) __builtin_bit_cast(bf16x8, (v4i_t){v[4 * (k)], v[4 * (k) + 1], v[4 * (k) + 2], v[4 * (k) + 3]})
#define PG8_MMA(ai, bj, At, Bt) do { __builtin_amdgcn_s_setprio(1); \
        if constexpr (F8) { _Pragma("unroll") for (int m = 0; m < 4; ++m) _Pragma("unroll") for (int n = 0; n < 2; ++n) \
            acc[ai][bj][m][n] = __builtin_amdgcn_mfma_scale_f32_16x16x128_f8f6f4(Bt[n], At[m], acc[ai][bj][m][n], 0, 0, 0, 0, 0, 0); }     \
        else { _Pragma("unroll") for (int m = 0; m < 4; ++m) _Pragma("unroll") for (int n = 0; n < 2; ++n) _Pragma("unroll") for (int k = 0; k < 2; ++k) \
            acc[ai][bj][m][n] = __builtin_amdgcn_mfma_f32_16x16x32_bf16(PG8_HALF(Bt[n], k), PG8_HALF(At[m], k), acc[ai][bj][m][n], 0, 0, 0); } \
        __builtin_amdgcn_s_setprio(0); } while (0)
#define PG8_WAIT_V(n) asm volatile("s_waitcnt vmcnt(" #n ")" ::: "memory")
#define PG8_WAIT_L(n) asm volatile("s_waitcnt lgkmcnt(" #n ")" ::: "memory")
#define PG8_BAR __builtin_amdgcn_s_barrier()
#define PG8_SCHED __builtin_amdgcn_sched_barrier(0)
    Unit cur, nxt; int ui = 0;
    if (!S.next(0, cur)) return;
    f32x4 acc[2][2][4][2];
#pragma unroll
    for (int a = 0; a < 2; ++a)
#pragma unroll
        for (int b = 0; b < 2; ++b)
#pragma unroll
            for (int m = 0; m < 4; ++m)
#pragma unroll
                for (int n = 0; n < 2; ++n) acc[a][b][m][n] = (f32x4){0.f, 0.f, 0.f, 0.f};
    v8i_t At[4], B0[2], B1[2];
    unsigned cA = (unsigned)cur.pm * tstepA + (unsigned)cur.z * (unsigned)g.zA, cB = (unsigned)cur.pn * tstepB + (unsigned)cur.z * (unsigned)g.zB;
    __amdgpu_buffer_rsrc_t rsA = __builtin_amdgcn_make_buffer_rsrc((void*)g.A, 0, 0x7fffffff, 0x00020000), rsB = __builtin_amdgcn_make_buffer_rsrc((void*)g.Bt, 0, 0x7fffffff, 0x00020000); (void)rsA; (void)rsB;
    PG8_STAGE_B(PG8_SB(0, 0), cB); PG8_STAGE_B(PG8_SB(0, 1), cB + hstepB); PG8_STAGE_A(PG8_SA(0, 0), cA); PG8_STAGE_A(PG8_SA(0, 1), cA + hstepA);
    if (wr == 1) PG8_BAR;
    PG8_WAIT_V(2); PG8_BAR;
    PG8_STAGE_B(PG8_SB(1, 0), cB + kstep); PG8_STAGE_A(PG8_SA(1, 0), cA + kstep); PG8_STAGE_B(PG8_SB(1, 1), cB + hstepB + kstep);
    PG8_WAIT_V(6); PG8_BAR;
    for (;;) {
        const bool has_next = S.next(ui + 1, nxt);
        const unsigned nA = has_next ? (unsigned)nxt.pm * tstepA + (unsigned)nxt.z * (unsigned)g.zA : cA;
        const unsigned nB = has_next ? (unsigned)nxt.pn * tstepB + (unsigned)nxt.z * (unsigned)g.zB : cB;
#pragma unroll 1
        for (int t = 0; t < nt; t += 2) {
            const bool last = (t == nt - 2);
            const unsigned a1 = cA + (unsigned)(t + 1) * kstep;
            const unsigned a2 = last ? nA : cA + (unsigned)(t + 2) * kstep; const unsigned b2 = last ? nB : cB + (unsigned)(t + 2) * kstep;
            const unsigned a3 = a2 + kstep; const unsigned b3 = b2 + kstep;
            PG8_LDB(B0, 0, 0); PG8_LDB(B1, 0, 1); PG8_SCHED; PG8_LDA(At, 0, 0); PG8_STAGE_A(PG8_SA(1, 1), a1 + hstepA);
            PG8_WAIT_V(8); PG8_WAIT_L(0); PG8_BAR; PG8_MMA(0, 0, At, B0); PG8_MMA(0, 1, At, B1); PG8_BAR; PG8_SCHED;
            PG8_LDA(At, 0, 1); PG8_STAGE_B(PG8_SB(0, 0), b2); PG8_STAGE_B(PG8_SB(0, 1), b2 + hstepB); PG8_STAGE_A(PG8_SA(0, 0), a2);
            PG8_WAIT_V(8); PG8_WAIT_L(0); PG8_BAR; PG8_MMA(1, 0, At, B0); PG8_MMA(1, 1, At, B1); PG8_BAR; PG8_SCHED;
            PG8_LDB(B0, 1, 0); PG8_LDB(B1, 1, 1); PG8_SCHED; PG8_LDA(At, 1, 0); PG8_STAGE_A(PG8_SA(0, 1), a2 + hstepA);
            PG8_WAIT_V(8); PG8_WAIT_L(0); PG8_BAR; PG8_MMA(0, 0, At, B0); PG8_MMA(0, 1, At, B1); PG8_BAR; PG8_SCHED;
            PG8_LDA(At, 1, 1); PG8_STAGE_B(PG8_SB(1, 0), b3); PG8_STAGE_B(PG8_SB(1, 1), b3 + hstepB); PG8_STAGE_A(PG8_SA(1, 0), a3);
            PG8_WAIT_V(8); PG8_WAIT_L(0); PG8_BAR; PG8_MMA(1, 0, At, B0); PG8_MMA(1, 1, At, B1); PG8_BAR; PG8_SCHED;
        }
        if constexpr (ALIGN_EPI) { if (wr == 0) PG8_BAR; }
        { const int l2_ = opq(lane_id()); E(acc, cur, wr, wc, l2_ & 15, l2_ >> 4); }
        if (!has_next) break;
#pragma unroll
        for (int a = 0; a < 2; ++a)
#pragma unroll
            for (int b = 0; b < 2; ++b)
#pragma unroll
                for (int m = 0; m < 4; ++m)
#pragma unroll
                    for (int n = 0; n < 2; ++n) acc[a][b][m][n] = (f32x4){0.f, 0.f, 0.f, 0.f};
        cur = nxt; cA = nA; cB = nB; ++ui;
        if constexpr (ALIGN_EPI) { if (wr == 1) PG8_BAR; }
    }
    PG8_WAIT_V(0);
    if constexpr (!ALIGN_EPI) { if (wr == 0) PG8_BAR; }
    PG8_BAR;
#undef PG8_SA
#undef PG8_SB
#undef PG8_STAGE_X
#undef PG8_STAGE_A
#undef PG8_STAGE_B
#undef PG8_LDA
#undef PG8_LDB
#undef PG8_MMA
#undef PG8_HALF
#undef PG8_WAIT_V
#undef PG8_WAIT_L
#undef PG8_BAR
#undef PG8_SCHED
}

template <int ACT> __device__ __forceinline__ float actf(float v) { if (ACT == 1) return v * sigm(v); if (ACT == 2) return sigm(v); return v; }
template <int ACT> __device__ __forceinline__ u32x4 pack8(f32x4 v0, f32x4 v1, float s) {
    u32x4 w; w.x = pk2(actf<ACT>(v0[0] * s), actf<ACT>(v0[1] * s)); w.y = pk2(actf<ACT>(v0[2] * s), actf<ACT>(v0[3] * s));
    w.z = pk2(actf<ACT>(v1[0] * s), actf<ACT>(v1[1] * s)); w.w = pk2(actf<ACT>(v1[2] * s), actf<ACT>(v1[3] * s)); return w;
}
struct EpiIn {
    bf16_t* PA; bf16_t* GT; const float* ssq; int mode; float oscale;
    template <int ACT> __device__ __forceinline__ void st(const f32x4 (&acc)[2][2][4][2], bf16_t* base, int ldc, int row0, int col0) const {
        float rs[2][4];
#pragma unroll
        for (int ai = 0; ai < 2; ++ai)
#pragma unroll
            for (int m = 0; m < 4; ++m) rs[ai][m] = ssq[row0 + ai * HALF + m * 16];
#pragma unroll
        for (int ai = 0; ai < 2; ++ai)
#pragma unroll
            for (int m = 0; m < 4; ++m) { const int row = row0 + ai * HALF + m * 16; const float r = rsqrtf(rs[ai][m] * (1.f / DM) + EPS) * oscale;
                bf16_t* rowp = base + (size_t)row * ldc + col0;
#pragma unroll
                for (int bj = 0; bj < 2; ++bj) *(u32x4*)(rowp + bj * HALF) = pack8<ACT>(acc[ai][bj][m][0], acc[ai][bj][m][1], r); }
    }
    __device__ __forceinline__ void operator()(const f32x4 (&acc)[2][2][4][2], const Unit& u, int wr, int wc, int fr, int fq) const {
        const int pn = (mode == 1) ? (u.pn < 18 ? u.pn + 8 : u.pn + 16) : (u.pn < 8 ? u.pn : u.pn + 18), row0 = u.pm * BM + wr * 64 + fr;
        if (pn >= 34) { st<2>(acc, GT, NG, row0, (pn - 34) * BM + wc * 32 + 8 * fq); }
        else { const int col0 = pn * BM + wc * 32 + 8 * fq;
            const bool silu = (pn >= 12 && pn < 16) || (pn >= 22 && pn < 26) || (pn >= 30);
            if (silu) st<1>(acc, PA, NA, row0, col0); else st<0>(acc, PA, NA, row0, col0); }
    }
};
struct EpiPlain {
    bf16_t* O; int ldc;
    __device__ __forceinline__ void operator()(const f32x4 (&acc)[2][2][4][2], const Unit& u, int wr, int wc, int fr, int fq) const {
        const int row0 = u.pm * BM + wr * 64 + fr, col0 = u.pn * BM + wc * 32 + 8 * fq;
#pragma unroll
        for (int ai = 0; ai < 2; ++ai)
#pragma unroll
            for (int m = 0; m < 4; ++m) { bf16_t* rowp = O + (size_t)(row0 + ai * HALF + m * 16) * ldc + col0;
#pragma unroll
                for (int bj = 0; bj < 2; ++bj) *(u32x4*)(rowp + bj * HALF) = pack8<0>(acc[ai][bj][m][0], acc[ai][bj][m][1], 1.f); }
    }
};
struct EpiMerge {
    const bf16_t* GT; bf16_t* MG; float oscale;
    __device__ __forceinline__ void operator()(const f32x4 (&acc)[2][2][4][2], const Unit& u, int wr, int wc, int fr, int fq) const {
        const int row0 = u.pm * BM + wr * 64 + fr, col0 = u.pn * BM + wc * 32 + 8 * fq, z = u.z;
#pragma unroll
        for (int ai = 0; ai < 2; ++ai)
#pragma unroll
            for (int bj = 0; bj < 2; ++bj) { const int col = col0 + bj * HALF;
                u32x4 gw[4], tw[4];
#pragma unroll
                for (int m = 0; m < 4; ++m) { const size_t row = (size_t)(row0 + ai * HALF + m * 16);
                    gw[m] = *(const u32x4*)(GT + row * NG + z * DM + col);
                    tw[m] = (z > 0) ? *(const u32x4*)(MG + row * DM + col) : (u32x4){0u, 0u, 0u, 0u}; }
#pragma unroll
                for (int m = 0; m < 4; ++m) { const size_t row = (size_t)(row0 + ai * HALF + m * 16);
                    const f32x4 a0 = acc[ai][bj][m][0] * oscale, a1 = acc[ai][bj][m][1] * oscale; u32x4 w;
                    w.x = pk2(a0[0] * bf_lo(gw[m].x) + bf_lo(tw[m].x), a0[1] * bf_hi(gw[m].x) + bf_hi(tw[m].x));
                    w.y = pk2(a0[2] * bf_lo(gw[m].y) + bf_lo(tw[m].y), a0[3] * bf_hi(gw[m].y) + bf_hi(tw[m].y));
                    w.z = pk2(a1[0] * bf_lo(gw[m].z) + bf_lo(tw[m].z), a1[1] * bf_hi(gw[m].z) + bf_hi(tw[m].z));
                    w.w = pk2(a1[2] * bf_lo(gw[m].w) + bf_lo(tw[m].w), a1[3] * bf_hi(gw[m].w) + bf_hi(tw[m].w));
                    *(u32x4*)(MG + row * DM + col) = w; } }
    }
};
struct EpiOut {
    const float* xin; float* X1; bf16_t* XB1; float* ssq;
    __device__ __forceinline__ void operator()(const f32x4 (&acc)[2][2][4][2], const Unit& u, int wr, int wc, int fr, int fq) const {
        const int row0 = u.pm * BM + wr * 64 + fr, col0 = u.pn * BM + wc * 32 + 8 * fq;
#pragma unroll
        for (int ai = 0; ai < 2; ++ai) { float s[4] = {0.f, 0.f, 0.f, 0.f};
#pragma unroll
            for (int bj = 0; bj < 2; ++bj) { f32x4 x0[4], x1[4];
#pragma unroll
                for (int m = 0; m < 4; ++m) { const size_t o = (size_t)(row0 + ai * HALF + m * 16) * DM + col0 + bj * HALF; x0[m] = *(const f32x4*)(xin + o); x1[m] = *(const f32x4*)(xin + o + 4); }
#pragma unroll
                for (int m = 0; m < 4; ++m) { const size_t o = (size_t)(row0 + ai * HALF + m * 16) * DM + col0 + bj * HALF;
                    const f32x4 v0 = x0[m] + acc[ai][bj][m][0], v1 = x1[m] + acc[ai][bj][m][1];
                    *(f32x4*)(X1 + o) = v0; *(f32x4*)(X1 + o + 4) = v1;
                    u32x4 w; w.x = pk2(v0[0], v0[1]); w.y = pk2(v0[2], v0[3]); w.z = pk2(v1[0], v1[1]); w.w = pk2(v1[2], v1[3]); *(u32x4*)(XB1 + o) = w;
                    s[m] += (v0[0] * v0[0] + v0[1] * v0[1]) + (v0[2] * v0[2] + v0[3] * v0[3]) + (v1[0] * v1[0] + v1[1] * v1[1]) + (v1[2] * v1[2] + v1[3] * v1[3]); } }
#pragma unroll
            for (int m = 0; m < 4; ++m) { float t = s[m]; t += __shfl_xor(t, 16); t += __shfl_xor(t, 32);
                if (fq == 0) atomicAdd(ssq + (row0 + ai * HALF + m * 16), t); } }
    }
};
struct EpiPle {
    const float* X1; const bf16_t* T; const float* ssq1; float* xout; bf16_t* XB; unsigned char* XB8; float* ssq2; bool wxb;
    __device__ __forceinline__ void operator()(const f32x4 (&acc)[2][2][4][2], const Unit& u, int wr, int wc, int fr, int fq) const {
        const int row0 = u.pm * BM + wr * 64 + fr, col0 = u.pn * BM + wc * 32 + 8 * fq;
        float rsv[2][4];
#pragma unroll
        for (int ai = 0; ai < 2; ++ai)
#pragma unroll
            for (int m = 0; m < 4; ++m) rsv[ai][m] = ssq1[row0 + ai * HALF + m * 16];
#pragma unroll
        for (int ai = 0; ai < 2; ++ai) { float s[4] = {0.f, 0.f, 0.f, 0.f};
#pragma unroll
            for (int bj = 0; bj < 2; ++bj)
#pragma unroll
              for (int mh = 0; mh < 2; ++mh) { f32x4 x0[2], x1[2]; u32x4 tw[2];
#pragma unroll
                for (int mm = 0; mm < 2; ++mm) { const int m = 2 * mh + mm; const size_t o = (size_t)(row0 + ai * HALF + m * 16) * DM + col0 + bj * HALF; x0[mm] = *(const f32x4*)(X1 + o); x1[mm] = *(const f32x4*)(X1 + o + 4); tw[mm] = *(const u32x4*)(T + o); }
#pragma unroll
                for (int mm = 0; mm < 2; ++mm) { const int m = 2 * mh + mm; const size_t o = (size_t)(row0 + ai * HALF + m * 16) * DM + col0 + bj * HALF;
                    const float rs = rsqrtf(rsv[ai][m] * (1.f / DM) + EPS);
                    const f32x4 a0 = acc[ai][bj][m][0], a1 = acc[ai][bj][m][1]; f32x4 v0 = x0[mm], v1 = x1[mm];
                    v0[0] += sigm(a0[0] * rs) * bf_lo(tw[mm].x); v0[1] += sigm(a0[1] * rs) * bf_hi(tw[mm].x); v0[2] += sigm(a0[2] * rs) * bf_lo(tw[mm].y); v0[3] += sigm(a0[3] * rs) * bf_hi(tw[mm].y);
                    v1[0] += sigm(a1[0] * rs) * bf_lo(tw[mm].z); v1[1] += sigm(a1[1] * rs) * bf_hi(tw[mm].z); v1[2] += sigm(a1[2] * rs) * bf_lo(tw[mm].w); v1[3] += sigm(a1[3] * rs) * bf_hi(tw[mm].w);
                    *(f32x4*)(xout + o) = v0; *(f32x4*)(xout + o + 4) = v1;
                    if (wxb) { u32x4 w; w.x = pk2(v0[0], v0[1]); w.y = pk2(v0[2], v0[3]); w.z = pk2(v1[0], v1[1]); w.w = pk2(v1[2], v1[3]); *(u32x4*)(XB + o) = w;
                        int q0 = 0, q1 = 0; q0 = __builtin_amdgcn_cvt_pk_fp8_f32(v0[0] * 8.f, v0[1] * 8.f, q0, false); q0 = __builtin_amdgcn_cvt_pk_fp8_f32(v0[2] * 8.f, v0[3] * 8.f, q0, true);
                        q1 = __builtin_amdgcn_cvt_pk_fp8_f32(v1[0] * 8.f, v1[1] * 8.f, q1, false); q1 = __builtin_amdgcn_cvt_pk_fp8_f32(v1[2] * 8.f, v1[3] * 8.f, q1, true);
                        *(u32x2*)(XB8 + o) = (u32x2){(unsigned)q0, (unsigned)q1}; }
                    s[m] += (v0[0] * v0[0] + v0[1] * v0[1]) + (v0[2] * v0[2] + v0[3] * v0[3]) + (v1[0] * v1[0] + v1[1] * v1[1]) + (v1[2] * v1[2] + v1[3] * v1[3]); } }
#pragma unroll
            for (int m = 0; m < 4; ++m) { float t = s[m]; t += __shfl_xor(t, 16); t += __shfl_xor(t, 32);
                if (fq == 0) atomicAdd(ssq2 + (row0 + ai * HALF + m * 16), t); } }
    }
};
}

template <bool F8> __device__ __forceinline__ void transpose_item(const float* W, int K, int N, int ld, void* WTv, const float* kscale, float wscale, LAS float* scr, int item, int lane_) {
    const int lane = opq(lane_);
    const int nblk = N / 64, kb = item / nblk, nb = item % nblk, k0 = 64 * kb, n0 = 64 * nb;
    float v[64];
#pragma unroll
    for (int kk = 0; kk < 64; ++kk) v[kk] = W[(size_t)(k0 + kk) * ld + n0 + lane];
#pragma unroll
    for (int kk = 0; kk < 64; ++kk) { const float sc = (kscale ? kscale[k0 + kk] : 1.f) * wscale; scr[kk * 65 + lane] = v[kk] * sc; }
    if constexpr (F8) {
        unsigned char* WT = (unsigned char*)WTv; const int c = lane & 3;
#pragma unroll
        for (int j = 0; j < 4; ++j) { const int n = (lane >> 2) + 16 * j; const LAS float* s = scr + (16 * c) * 65 + n; int q[4];
#pragma unroll
            for (int d = 0; d < 4; ++d) { int w = 0; w = __builtin_amdgcn_cvt_pk_fp8_f32(s[(4 * d) * 65], s[(4 * d + 1) * 65], w, false); w = __builtin_amdgcn_cvt_pk_fp8_f32(s[(4 * d + 2) * 65], s[(4 * d + 3) * 65], w, true); q[d] = w; }
            *(u32x4*)(WT + (size_t)(n0 + n) * K + k0 + 16 * c) = (u32x4){(unsigned)q[0], (unsigned)q[1], (unsigned)q[2], (unsigned)q[3]}; }
    } else {
        bf16_t* WT = (bf16_t*)WTv; const int c = lane & 7;
#pragma unroll
        for (int j = 0; j < 8; ++j) { const int n = (lane >> 3) + 8 * j; const LAS float* s = scr + (8 * c) * 65 + n;
            u32x4 o; o.x = pk2(s[0 * 65], s[1 * 65]); o.y = pk2(s[2 * 65], s[3 * 65]); o.z = pk2(s[4 * 65], s[5 * 65]); o.w = pk2(s[6 * 65], s[7 * 65]);
            *(u32x4*)(WT + (size_t)(n0 + n) * K + k0 + 8 * c) = o; }
    }
}
template <bool F8 = false> __device__ __forceinline__ void transpose_matrix(const float* W, int K, int N, int ld, void* WT, const float* kscale, float wscale, LAS float* scr, int gw, int NGW, int lane) {
    const int nitems = (K / 64) * (N / 64);
    for (int it = gw; it < nitems; it += NGW) transpose_item<F8>(W, K, N, ld, WT, kscale, wscale, scr, it, lane);
}

struct Args { const float* in[19]; float* out; unsigned char* ws; int ph_lo, ph_hi; };
typedef const __attribute__((address_space(4))) Args* KArgs;
struct Ptrs {
    __device__ __forceinline__ void reload(KArgs a) {
        x = a->in[0]; p = a->in[1]; rpe = a->in[2]; norm_g = a->in[3]; w_in = a->in[4]; sinks = a->in[5]; conv_w = a->in[6]; conv_b = a->in[7]; w_r = a->in[8]; b_r = a->in[9]; w_i = a->in[10];
        b_i = a->in[11]; lam = a->in[12]; w_br = a->in[13]; w_out = a->in[14]; ple_g = a->in[15]; w_pg = a->in[16]; w_pp = a->in[17]; fin_g = a->in[18]; out = a->out; ws = a->ws; }
    const float *x, *p, *rpe, *norm_g, *w_in, *sinks, *conv_w, *conv_b, *w_r, *b_r, *w_i, *b_i, *lam, *w_br, *w_out, *ple_g, *w_pg, *w_pp, *fin_g;
    float* out; unsigned char* ws; int wave;
#define WSP(NAME, TYPE, OFF) __device__ __forceinline__ TYPE* NAME() const { return (TYPE*)(ws + (OFF)); }
    WSP(WIN8, unsigned char, OFF_WIN8) WSP(WINB, bf16_t, OFF_WINB) WSP(XB8, unsigned char, OFF_XB8) WSP(WBR, bf16_t, OFF_WBR) WSP(WOUT, bf16_t, OFF_WOUT) WSP(WPG, bf16_t, OFF_WPG) WSP(WPP, bf16_t, OFF_WPP) WSP(WR, bf16_t, OFF_WR) WSP(WI, bf16_t, OFF_WI)
    WSP(XB, bf16_t, OFF_XB) WSP(VTA, bf16_t, OFF_VTA) WSP(VTB, bf16_t, OFF_VTB) WSP(PA, bf16_t, OFF_PA) WSP(MG, bf16_t, OFF_MG) WSP(XB1, bf16_t, OFF_XB1) WSP(GT, bf16_t, OFF_GT)
    WSP(Y8, unsigned char, OFF_Y8) WSP(YC, bf16_t, OFF_YC) WSP(WBR8, unsigned char, OFF_WBR8) WSP(T, bf16_t, OFF_T) WSP(HL, bf16_t, OFF_HL) WSP(CA, bf16_t, OFF_CA) WSP(PB, bf16_t, OFF_PB) WSP(KM, bf16_t, OFF_KM)
    WSP(X1, float, OFF_X1) WSP(SSQ, float, OFF_SSQ) WSP(CHA, float, OFF_CHA) WSP(CHH, float, OFF_CHH)
    WSP(SELCNT, unsigned, OFF_SELCNT) WSP(LIST, unsigned, OFF_LIST) WSP(PO, bf16_t, OFF_PO) WSP(ML, float, OFF_ML)
#undef WSP
};

__device__ __forceinline__ void kmean_item(LAS unsigned char* lds, const Ptrs& P, int it) {
    const int tid = opq((P.wave << 6) | lane_id()), b = it >> 7, h = (it >> 4) & 7, n = it & 15;
    const int rg = tid >> 4, c8 = tid & 15;
    float s0 = 0.f, s1 = 0.f, s2 = 0.f, s3 = 0.f, s4 = 0.f, s5 = 0.f, s6 = 0.f, s7 = 0.f;
#pragma unroll
    for (int i = 0; i < 8; ++i) { const int row = rg + 32 * i;
        const u32x4 w = *(const u32x4*)(P.PA() + (size_t)(b * SEQ + n * 256 + row) * NA + C_KA + h * 128 + c8 * 8);
        s0 += bf_lo(w.x); s1 += bf_hi(w.x); s2 += bf_lo(w.y); s3 += bf_hi(w.y); s4 += bf_lo(w.z); s5 += bf_hi(w.z); s6 += bf_lo(w.w); s7 += bf_hi(w.w); }
    LAS float* red = (LAS float*)lds;
    LAS float* rp = red + rg * 128 + c8 * 8;
    rp[0] = s0; rp[1] = s1; rp[2] = s2; rp[3] = s3; rp[4] = s4; rp[5] = s5; rp[6] = s6; rp[7] = s7;
    __syncthreads();
    if (tid < 128) { float s = 0.f;
#pragma unroll 8
        for (int r = 0; r < 32; ++r) s += red[r * 128 + tid];
        P.KM()[(size_t)it * 128 + tid] = (bf16_t)(pk2(s * (1.f / 256.f), 0.f) & 0xffffu); }
    __syncthreads();
}
__device__ __forceinline__ void vtrans_item(LAS unsigned char* scr, const Ptrs& P, int it, int lane_) {
    const int lane = opq(lane_);
    int b, tt, colbase; bf16_t* dst0;
    if (it < 4096) { b = it >> 10; const int r = it & 1023; tt = r >> 4; const int ct = r & 15; colbase = C_VA + ct * 64; dst0 = P.VTA() + ((size_t)(b * 1024 + ct * 64) * SEQ + tt * 64); }
    else { it -= 4096; b = it >> 8; const int r = it & 255; tt = r >> 2; const int ct = r & 3; colbase = C_VB + ct * 64; dst0 = P.VTB() + ((size_t)(b * 256 + ct * 64) * SEQ + tt * 64); }
#pragma unroll
    for (int i = 0; i < 8; ++i) { const int row = i * 8 + (lane >> 3), c8 = lane & 7;
        const u32x4 w = *(const u32x4*)(P.PA() + (size_t)(b * SEQ + tt * 64 + row) * NA + colbase + c8 * 8);
        *(LAS u32x4*)(scr + row * 144 + c8 * 16) = w; }
#pragma unroll
    for (int i = 0; i < 8; ++i) { const int c = (lane >> 3) + 8 * i, tg = lane & 7; unsigned e[8];
#pragma unroll
        for (int k = 0; k < 8; ++k) e[k] = *(const LAS unsigned short*)(scr + (tg * 8 + k) * 144 + c * 2);
        u32x4 o; o.x = e[0] | (e[1] << 16); o.y = e[2] | (e[3] << 16); o.z = e[4] | (e[5] << 16); o.w = e[6] | (e[7] << 16);
        *(u32x4*)(dst0 + (size_t)c * SEQ + tg * 8) = o; }
}
__device__ __forceinline__ void lru_local_phase(LAS unsigned char* lds, const Ptrs& P, int l, int bx, int G) {
    const int tid = opq((P.wave << 6) | lane_id()), lane = tid & 63, wid = __builtin_amdgcn_readfirstlane(tid >> 6);
    constexpr int NIT = BATCH * 64 * 8;
    u32x4 xw[4][2];
#define LRU_LOAD(itx) do { const int b_ = (itx) >> 9, c_ = ((itx) >> 3) & 63, n_ = (itx) & 7; \
        _Pragma("unroll") for (int w = 0; w < 4; ++w) { int tt_ = c_ * 64 + (tid >> 3) - 3 + w; tt_ = tt_ < 0 ? 0 : tt_; \
            const bf16_t* src_ = P.PA() + (size_t)(b_ * SEQ + tt_) * NA + C_XC + n_ * 128 + (tid & 7) * 16; \
            xw[w][0] = *(const u32x4*)src_; xw[w][1] = *(const u32x4*)(src_ + 8); } } while (0)
    if (bx < NIT) LRU_LOAD(bx);
    int n_cur = -1; bf16x8 br[4], bi[4]; float brv = 0.f, biv = 0.f, c8sp = 0.f; f32x4 cbv[4], cwv[4][4];
#pragma unroll 1
    for (int it = bx; it < NIT; it += G) {
    const int b = it >> 9, c = (it >> 3) & 63, n = it & 7, t0 = c * 64, ch0 = n * 128;
    const int col = lane & 15, quad = lane >> 4, d0 = 16 * wid, ch = ch0 + d0 + col;
    if (n != n_cur) {
        n_cur = n;
        const size_t wofs = ((size_t)(l * 8 + n) * 128 + d0 + col) * 128 + quad * 8;
#pragma unroll
        for (int ks = 0; ks < 4; ++ks) { br[ks] = *(const bf16x8*)(P.WR() + wofs + ks * 32); bi[ks] = *(const bf16x8*)(P.WI() + wofs + ks * 32); }
        brv = P.b_r[l * 1024 + ch]; biv = P.b_i[l * 1024 + ch]; c8sp = -8.f * log1pf(__expf(-P.lam[l * 1024 + ch]));
        const int chb_ = ch0 + (tid & 7) * 16;
#pragma unroll
        for (int q = 0; q < 4; ++q) cbv[q] = *(const f32x4*)(P.conv_b + l * 1024 + chb_ + 4 * q);
#pragma unroll
        for (int w = 0; w < 4; ++w)
#pragma unroll
            for (int q = 0; q < 4; ++q) cwv[w][q] = *(const f32x4*)(P.conv_w + (size_t)(l * 4 + w) * 1024 + chb_ + 4 * q);
    }
    LAS unsigned char* convb = lds;
    LAS float* convf = (LAS float*)(lds + 17408);
    LAS unsigned char* hlS = lds + 51200;
    LAS unsigned char* caS = lds + 68608;
    {
        const int t = tid >> 3, cg8 = tid & 7, chb = ch0 + cg8 * 16;
        float a[16];
#pragma unroll
        for (int q = 0; q < 4; ++q) { const f32x4 v = cbv[q]; a[4 * q] = v[0]; a[4 * q + 1] = v[1]; a[4 * q + 2] = v[2]; a[4 * q + 3] = v[3]; }
#pragma unroll
        for (int w = 0; w < 4; ++w) { const int tt = t0 + t - 3 + w; const float msk = tt >= 0 ? 1.f : 0.f;
#pragma unroll
            for (int hh = 0; hh < 2; ++hh) { const u32x4 xv = xw[w][hh]; const f32x4 w0 = cwv[w][2 * hh] * msk, w1 = cwv[w][2 * hh + 1] * msk;
                a[8 * hh + 0] += w0[0] * bf_lo(xv.x); a[8 * hh + 1] += w0[1] * bf_hi(xv.x); a[8 * hh + 2] += w0[2] * bf_lo(xv.y); a[8 * hh + 3] += w0[3] * bf_hi(xv.y);
                a[8 * hh + 4] += w1[0] * bf_lo(xv.z); a[8 * hh + 5] += w1[1] * bf_hi(xv.z); a[8 * hh + 6] += w1[2] * bf_lo(xv.w); a[8 * hh + 7] += w1[3] * bf_hi(xv.w); } }
#pragma unroll
        for (int q = 0; q < 4; ++q) *(LAS f32x4*)(convf + t * 132 + cg8 * 16 + 4 * q) = (f32x4){a[4 * q], a[4 * q + 1], a[4 * q + 2], a[4 * q + 3]};
#pragma unroll
        for (int hh = 0; hh < 2; ++hh) { u32x4 o; o.x = pk2(a[8 * hh], a[8 * hh + 1]); o.y = pk2(a[8 * hh + 2], a[8 * hh + 3]); o.z = pk2(a[8 * hh + 4], a[8 * hh + 5]); o.w = pk2(a[8 * hh + 6], a[8 * hh + 7]);
            *(LAS u32x4*)(convb + t * 272 + cg8 * 32 + hh * 16) = o; }
    }
    __syncthreads();
    if (it + G < NIT) LRU_LOAD(it + G);
    f32x4 accr[4], acci[4];
    {
#pragma unroll
        for (int m = 0; m < 4; ++m) { accr[m] = (f32x4){0.f, 0.f, 0.f, 0.f}; acci[m] = (f32x4){0.f, 0.f, 0.f, 0.f};
#pragma unroll
            for (int ks = 0; ks < 4; ++ks) { const bf16x8 av = *(const LAS bf16x8*)(convb + (m * 16 + col) * 272 + (ks * 32 + quad * 8) * 2);
                accr[m] = __builtin_amdgcn_mfma_f32_16x16x32_bf16(av, br[ks], accr[m], 0, 0, 0);
                acci[m] = __builtin_amdgcn_mfma_f32_16x16x32_bf16(av, bi[ks], acci[m], 0, 0, 0); } }
    }
    {
        float Ac = 1.f, Hc = 0.f;
#pragma unroll
        for (int m = 0; m < 4; ++m) {
            float hl[4], Pl[4]; float h = 0.f, Pp = 1.f;
#pragma unroll
            for (int jj = 0; jj < 4; ++jj) { const int tok = m * 16 + quad * 4 + jj;
                const float r = sigm(accr[m][jj] + brv), ig = sigm(acci[m][jj] + biv);
                const float la = c8sp * r, av = __expf(la);
                const float bm = __builtin_amdgcn_sqrtf(fmaxf(1.f - __expf(2.f * la), 0.f));
                const float bb = bm * ig * convf[tok * 132 + d0 + col];
                h = av * h + bb; Pp *= av; hl[jj] = h; Pl[jj] = Pp; }
            const float A0 = __shfl(Pp, col), A1 = __shfl(Pp, col + 16), A2 = __shfl(Pp, col + 32), A3 = __shfl(Pp, col + 48);
            const float H0 = __shfl(h, col), H1 = __shfl(h, col + 16), H2 = __shfl(h, col + 32), H3 = __shfl(h, col + 48);
            float Ain = 1.f, Hin = 0.f;
            if (quad > 0) { Hin = H0; Ain = A0; }
            if (quad > 1) { Hin = A1 * Hin + H1; Ain *= A1; }
            if (quad > 2) { Hin = A2 * Hin + H2; Ain *= A2; }
            const float At = A0 * A1 * A2 * A3, Ht = ((H0 * A1 + H1) * A2 + H2) * A3 + H3;
            const float Hstart = Ain * Hc + Hin, Pstart = Ac * Ain;
#pragma unroll
            for (int jj = 0; jj < 4; ++jj) { const int tok = m * 16 + quad * 4 + jj;
                *(LAS unsigned short*)(hlS + tok * 272 + (d0 + col) * 2) = (unsigned short)(pk2(Pl[jj] * Hstart + hl[jj], 0.f) & 0xffffu);
                *(LAS unsigned short*)(caS + tok * 272 + (d0 + col) * 2) = (unsigned short)(pk2(Pstart * Pl[jj], 0.f) & 0xffffu); }
            Hc = At * Hc + Ht; Ac *= At;
        }
        if (quad == 0) { P.CHA()[(size_t)(b * 64 + c) * 1024 + ch] = Ac; P.CHH()[(size_t)(b * 64 + c) * 1024 + ch] = Hc; }
    }
    __syncthreads();
    {
        const int t = tid >> 3, cg8 = tid & 7; const size_t o = (size_t)(b * SEQ + t0 + t) * 1024 + ch0 + cg8 * 16;
#pragma unroll
        for (int hh = 0; hh < 2; ++hh) { *(u32x4*)(P.HL() + o + 8 * hh) = *(const LAS u32x4*)(hlS + t * 272 + cg8 * 32 + hh * 16); *(u32x4*)(P.CA() + o + 8 * hh) = *(const LAS u32x4*)(caS + t * 272 + cg8 * 32 + hh * 16); }
    }
    }
#undef LRU_LOAD
}

__device__ __forceinline__ void lru_fix_item(const Ptrs& P, int it) {
    const int tid = opq((P.wave << 6) | lane_id()), b = it >> 6, c = it & 63, tg = tid >> 7, c8 = tid & 127;
    f32x4 H0 = {0.f, 0.f, 0.f, 0.f}, H1 = {0.f, 0.f, 0.f, 0.f};
    int cc = 0;
#pragma unroll 1
    for (; cc + 8 <= c; cc += 8) {
        f32x4 a0[8], a1[8], h0[8], h1[8];
#pragma unroll
        for (int u = 0; u < 8; ++u) { const size_t o = (size_t)(b * 64 + cc + u) * 1024 + c8 * 8;
            a0[u] = *(const f32x4*)(P.CHA() + o); a1[u] = *(const f32x4*)(P.CHA() + o + 4); h0[u] = *(const f32x4*)(P.CHH() + o); h1[u] = *(const f32x4*)(P.CHH() + o + 4); }
#pragma unroll
        for (int u = 0; u < 8; ++u) { H0 = a0[u] * H0 + h0[u]; H1 = a1[u] * H1 + h1[u]; }
    }
    for (; cc < c; ++cc) { const size_t o = (size_t)(b * 64 + cc) * 1024 + c8 * 8;
        const f32x4 a0 = *(const f32x4*)(P.CHA() + o), a1 = *(const f32x4*)(P.CHA() + o + 4), h0 = *(const f32x4*)(P.CHH() + o), h1 = *(const f32x4*)(P.CHH() + o + 4);
        H0 = a0 * H0 + h0; H1 = a1 * H1 + h1; }
#pragma unroll 4
    for (int k = 0; k < 16; ++k) { const size_t row = (size_t)(b * SEQ + c * 64 + tg + 4 * k);
        const u32x4 hw = *(const u32x4*)(P.HL() + row * 1024 + c8 * 8), cw = *(const u32x4*)(P.CA() + row * 1024 + c8 * 8), gw = *(const u32x4*)(P.PA() + row * NA + C_GC + c8 * 8);
        u32x4 o;
        o.x = pk2((bf_lo(hw.x) + bf_lo(cw.x) * H0[0]) * bf_lo(gw.x), (bf_hi(hw.x) + bf_hi(cw.x) * H0[1]) * bf_hi(gw.x));
        o.y = pk2((bf_lo(hw.y) + bf_lo(cw.y) * H0[2]) * bf_lo(gw.y), (bf_hi(hw.y) + bf_hi(cw.y) * H0[3]) * bf_hi(gw.y));
        o.z = pk2((bf_lo(hw.z) + bf_lo(cw.z) * H1[0]) * bf_lo(gw.z), (bf_hi(hw.z) + bf_hi(cw.z) * H1[1]) * bf_hi(gw.z));
        o.w = pk2((bf_lo(hw.w) + bf_lo(cw.w) * H1[2]) * bf_lo(gw.w), (bf_hi(hw.w) + bf_hi(cw.w) * H1[3]) * bf_hi(gw.w));
        *(u32x4*)(P.YC() + row * 1024 + c8 * 8) = o; }
}

#define SOFTMAX_TILE(p0, p1, m, l, NO, o, pw) do { \
    float rm_ = fmaxf(p0[0], p1[0]); \
    _Pragma("unroll") for (int r = 1; r < 16; ++r) rm_ = fmaxf(rm_, fmaxf(p0[r], p1[r])); \
    rm_ = fmaxf(rm_, __shfl_xor(rm_, 32)); \
    if (__ballot(rm_ > m + 8.f) != 0ull) {        \
        const float mn_ = fmaxf(m, rm_); const float al_ = __builtin_amdgcn_exp2f(m - mn_); m = mn_; l *= al_; \
        _Pragma("unroll") for (int d_ = 0; d_ < NO; ++d_) o[d_] *= al_; } \
    float ps_ = 0.f; \
    _Pragma("unroll") for (int r = 0; r < 16; ++r) { p0[r] = __builtin_amdgcn_exp2f(p0[r] - m); p1[r] = __builtin_amdgcn_exp2f(p1[r] - m); ps_ += p0[r] + p1[r]; } \
    l += ps_; \
    pw[0] = (u32x4){pk2(p0[0], p0[1]), pk2(p0[2], p0[3]), pk2(p0[4], p0[5]), pk2(p0[6], p0[7])}; \
    pw[1] = (u32x4){pk2(p0[8], p0[9]), pk2(p0[10], p0[11]), pk2(p0[12], p0[13]), pk2(p0[14], p0[15])}; \
    pw[2] = (u32x4){pk2(p1[0], p1[1]), pk2(p1[2], p1[3]), pk2(p1[4], p1[5]), pk2(p1[6], p1[7])}; \
    pw[3] = (u32x4){pk2(p1[8], p1[9]), pk2(p1[10], p1[11]), pk2(p1[12], p1[13]), pk2(p1[14], p1[15])}; } while (0)

__device__ __forceinline__ void moba_load_q(bf16x8 (&qr)[8], const Ptrs& P, size_t qrow, int h, int hi) {
#pragma unroll
    for (int ks = 0; ks < 8; ++ks) qr[ks] = *(const bf16x8*)(P.PA() + qrow * NA + C_QA + h * 128 + ks * 16 + hi * 8);
}
__device__ __forceinline__ void moba_list_item(const Ptrs& P, int bh, int j) {
    const int tid = opq((P.wave << 6) | lane_id()), lane = tid & 63, wid = __builtin_amdgcn_readfirstlane(tid >> 6), r32 = lane & 31, hi = lane >> 5;
    const int b = bh >> 3, h = bh & 7, t = j * 256 + 32 * wid + r32;
    bf16x8 qr[8]; moba_load_q(qr, P, (size_t)(b * SEQ + t), h, hi);
    f32x16 ga = {};
#pragma unroll
    for (int ks = 0; ks < 8; ++ks) { const bf16x8 kf = *(const bf16x8*)(P.KM() + ((size_t)(bh * 16 + (r32 & 15))) * 128 + ks * 16 + hi * 8);
        ga = __builtin_amdgcn_mfma_f32_32x32x16_bf16(kf, qr[ks], ga, 0, 0, 0); }
    float g[16];
#pragma unroll
    for (int e = 0; e < 8; ++e) { const float mine = ga[e], oth = __shfl_xor(mine, 32);
        const float lo = hi ? oth : mine, hh = hi ? mine : oth;
        g[(e & 3) + 8 * (e >> 2)] = lo; g[4 + (e & 3) + 8 * (e >> 2)] = hh; }
    const float NI = -3.0e38f;
    unsigned sel = 0u;
#pragma unroll
    for (int pass = 0; pass < 3; ++pass) { float best = NI; int bi = -1;
#pragma unroll
        for (int n = 0; n < 16; ++n) { const bool ok = (n < j) && (((sel >> n) & 1u) == 0u) && (g[n] > best); best = ok ? g[n] : best; bi = ok ? n : bi; }
        if (bi >= 0) sel |= 1u << bi; }
    for (int n = 0; n < j; ++n) {
        const bool sb = (((sel >> n) & 1u) != 0u) && (hi == 0);
        const unsigned long long mk = __ballot(sb);
        if (mk != 0ull) {
            unsigned base = 0u;
            if (lane == 0) base = atomicAdd(P.SELCNT() + bh * 16 + n, (unsigned)__popcll(mk));
            base = (unsigned)__builtin_amdgcn_readfirstlane((int)base);
            if (sb) { const unsigned pos = base + (unsigned)__popcll(mk & ((1ull << lane) - 1ull)); const unsigned k = (unsigned)__popc(sel & ((1u << n) - 1u));
                if (pos < 4096u) P.LIST()[(size_t)(bh * 16 + n) * 4096 + pos] = (unsigned)t | (k << 12); }
        }
    }
}
__device__ __forceinline__ void moba_kv_item(LAS unsigned char* lds, const Ptrs& P, int bh, int n, int beg, int end) {
    const int tid = opq((P.wave << 6) | lane_id()), lane = tid & 63, wid = __builtin_amdgcn_readfirstlane(tid >> 6), r32 = lane & 31, hi = lane >> 5;
    const int b = bh >> 3, h = bh & 7;
    const float SC = 0.08838834764831845f * LOG2E;
    LAS unsigned char* kb = lds; LAS unsigned char* vb = lds + 69632; LAS float* lut = (LAS float*)(lds + 136192);
    if (tid < 129) lut[tid] = P.rpe[t5_bucket(tid) * 24 + h] * LOG2E;
    const float cbias = P.rpe[31 * 24 + h] * LOG2E;
    {   const int kr = tid >> 4, kc8 = tid & 15, vd = tid >> 5, vk8 = tid & 31;
        u32x4 rg[8], rv[8];
#pragma unroll
        for (int i = 0; i < 8; ++i) rg[i] = *(const u32x4*)(P.PA() + (size_t)(b * SEQ + n * 256 + kr + 32 * i) * NA + C_KA + h * 128 + kc8 * 8);
#pragma unroll
        for (int i = 0; i < 8; ++i) rv[i] = *(const u32x4*)(P.VTA() + ((size_t)(bh * 128 + vd + 16 * i)) * SEQ + n * 256 + vk8 * 8);
#pragma unroll
        for (int i = 0; i < 8; ++i) *(LAS u32x4*)(kb + (kr + 32 * i) * 272 + kc8 * 16) = rg[i];
#pragma unroll
        for (int i = 0; i < 8; ++i) { *(LAS u32x2*)(vb + (vd + 16 * i) * 520 + vk8 * 16) = (u32x2){rv[i].x, rv[i].y}; *(LAS u32x2*)(vb + (vd + 16 * i) * 520 + vk8 * 16 + 8) = (u32x2){rv[i].z, rv[i].w}; }
    }
    __syncthreads();
    const int ntile = (end - beg + 31) >> 5;
    const unsigned* list = P.LIST() + (size_t)(bh * 16 + n) * 4096;
    bf16x8 qn[8]; unsigned en = 0u; bool vn = false;
    if (wid < ntile) { const int idx = beg + wid * 32 + r32; vn = idx < end; en = list[vn ? idx : beg]; moba_load_q(qn, P, (size_t)(b * SEQ + (int)(en & 4095u)), h, hi); }
#pragma unroll 1
    for (int qt = wid; qt < ntile; qt += 8) {
        const bool valid = vn; const unsigned e = en;
        const int t = (int)(e & 4095u), k = (int)(e >> 12);
        bf16x8 qr[8];
#pragma unroll
        for (int ks = 0; ks < 8; ++ks) qr[ks] = qn[ks];
        if (qt + 8 < ntile) { const int idx = beg + (qt + 8) * 32 + r32; vn = idx < end; en = list[vn ? idx : beg]; moba_load_q(qn, P, (size_t)(b * SEQ + (int)(en & 4095u)), h, hi); }
        float m = NEGF, l = 0.f; f32x16 o[4]; o[0] = f32x16{}; o[1] = f32x16{}; o[2] = f32x16{}; o[3] = f32x16{};
        const bool allfar = (__ballot(t < n * 256 + 383) == 0ull);
#pragma unroll 1
        for (int kvt = 0; kvt < 4; ++kvt) {
            f32x16 p0 = {}, p1 = {};
#pragma unroll
            for (int ks = 0; ks < 8; ++ks) { const bf16x8 k0 = *(const LAS bf16x8*)(kb + (kvt * 64 + r32) * 272 + ks * 32 + hi * 16), k1 = *(const LAS bf16x8*)(kb + (kvt * 64 + 32 + r32) * 272 + ks * 32 + hi * 16);
                p0 = __builtin_amdgcn_mfma_f32_32x32x16_bf16(k0, qr[ks], p0, 0, 0, 0); p1 = __builtin_amdgcn_mfma_f32_32x32x16_bf16(k1, qr[ks], p1, 0, 0, 0); }
            if (allfar) {
#pragma unroll
                for (int r = 0; r < 16; ++r) { p0[r] = p0[r] * SC + cbias; p1[r] = p1[r] * SC + cbias; }
            } else {
                const int dbase = t - n * 256 - 64 * kvt;
#pragma unroll
                for (int g4 = 0; g4 < 4; ++g4) {
#pragma unroll
                    for (int e4 = 0; e4 < 4; ++e4) { const int r = 4 * g4 + e4; const int d0 = dbase - crow(r, hi), d1 = d0 - 32;
                        p0[r] = p0[r] * SC + lut[min(max(d0, 0), 128)]; p1[r] = p1[r] * SC + lut[min(max(d1, 0), 128)]; }
                    __builtin_amdgcn_sched_barrier(0);
                }
            }
            u32x4 pw[4];
            SOFTMAX_TILE(p0, p1, m, l, 4, o, pw);
#pragma unroll
            for (int sl = 0; sl < 4; ++sl)
#pragma unroll
                for (int dt = 0; dt < 4; ++dt) { const LAS unsigned char* vp = vb + (dt * 32 + r32) * 520 + (kvt * 64 + 16 * sl + 4 * hi) * 2;
                    const u32x2 lo = *(const LAS u32x2*)vp, hh = *(const LAS u32x2*)(vp + 16);
                    const u32x4 vf = {lo.x, lo.y, hh.x, hh.y};
                    o[dt] = __builtin_amdgcn_mfma_f32_32x32x16_bf16(__builtin_bit_cast(bf16x8, vf), __builtin_bit_cast(bf16x8, pw[sl]), o[dt], 0, 0, 0); }
        }
        const float lt = l + __shfl_xor(l, 32); const float inv = __builtin_amdgcn_rcpf(lt);
        if (valid) {
            const size_t slot = ((size_t)bh * SEQ + t) * 3 + k;
            if (hi == 0) *(f32x2*)(P.ML() + slot * 2) = (f32x2){m, lt};
            bf16_t* po = P.PO() + slot * 128;
#pragma unroll
            for (int dt = 0; dt < 4; ++dt)
#pragma unroll
                for (int g4 = 0; g4 < 4; ++g4) { const int d = 32 * dt + 8 * g4 + 4 * hi;
                    *(u32x2*)(po + d) = (u32x2){pk2(o[dt][4 * g4] * inv, o[dt][4 * g4 + 1] * inv), pk2(o[dt][4 * g4 + 2] * inv, o[dt][4 * g4 + 3] * inv)}; }
        }
    }
    __syncthreads();
}
__device__ __forceinline__ void moba_own_item(LAS unsigned char* lds, const Ptrs& P, int b, int h, int j) {
    const int tid = opq((P.wave << 6) | lane_id()), lane = tid & 63, wid = __builtin_amdgcn_readfirstlane(tid >> 6), r32 = lane & 31, hi = lane >> 5;
    const float SC = 0.08838834764831845f * LOG2E;
    LAS unsigned char* kb = lds; LAS unsigned char* vb = lds + 69632; LAS float* lut = (LAS float*)(lds + 136192);
    if (tid < 129) lut[tid] = P.rpe[t5_bucket(tid) * 24 + h] * LOG2E;
    const int bh = b * 8 + h;
    const int q_local = 32 * wid + r32, t = j * 256 + q_local; const size_t qrow = (size_t)(b * SEQ + t);
    bf16x8 qr[8]; moba_load_q(qr, P, qrow, h, hi);
    {   const int kr = tid >> 4, kc8 = tid & 15, vd = tid >> 5, vk8 = tid & 31;
        u32x4 rg[8], rv[8];
#pragma unroll
        for (int i = 0; i < 8; ++i) rg[i] = *(const u32x4*)(P.PA() + (size_t)(b * SEQ + j * 256 + kr + 32 * i) * NA + C_KA + h * 128 + kc8 * 8);
#pragma unroll
        for (int i = 0; i < 8; ++i) rv[i] = *(const u32x4*)(P.VTA() + ((size_t)(bh * 128 + vd + 16 * i)) * SEQ + j * 256 + vk8 * 8);
#pragma unroll
        for (int i = 0; i < 8; ++i) *(LAS u32x4*)(kb + (kr + 32 * i) * 272 + kc8 * 16) = rg[i];
#pragma unroll
        for (int i = 0; i < 8; ++i) { *(LAS u32x2*)(vb + (vd + 16 * i) * 520 + vk8 * 16) = (u32x2){rv[i].x, rv[i].y}; *(LAS u32x2*)(vb + (vd + 16 * i) * 520 + vk8 * 16 + 8) = (u32x2){rv[i].z, rv[i].w}; }
    }
    const int nsel = j < 3 ? j : 3;
    const size_t slot0 = ((size_t)bh * SEQ + t) * 3;
    float mk[3], lk[3];
#pragma unroll
    for (int k = 0; k < 3; ++k) { mk[k] = NEGF; lk[k] = 0.f;
        if (k < nsel) { const f32x2 v = *(const f32x2*)(P.ML() + (slot0 + k) * 2); mk[k] = v[0]; lk[k] = v[1]; } }
    __syncthreads();
    float m = NEGF, l = 0.f; f32x16 o[4]; o[0] = f32x16{}; o[1] = f32x16{}; o[2] = f32x16{}; o[3] = f32x16{};
    const int ntt = ((32 * wid + 31) >> 6) + 1;
#pragma unroll 1
    for (int tt = 0; tt < ntt; ++tt) {
        f32x16 p0 = {}, p1 = {};
#pragma unroll
        for (int ks = 0; ks < 8; ++ks) { const bf16x8 k0 = *(const LAS bf16x8*)(kb + (tt * 64 + r32) * 272 + ks * 32 + hi * 16), k1 = *(const LAS bf16x8*)(kb + (tt * 64 + 32 + r32) * 272 + ks * 32 + hi * 16);
            p0 = __builtin_amdgcn_mfma_f32_32x32x16_bf16(k0, qr[ks], p0, 0, 0, 0); p1 = __builtin_amdgcn_mfma_f32_32x32x16_bf16(k1, qr[ks], p1, 0, 0, 0); }
        const int dbase = q_local - 64 * tt;
#pragma unroll
        for (int g4 = 0; g4 < 4; ++g4) {
#pragma unroll
            for (int e4 = 0; e4 < 4; ++e4) { const int r = 4 * g4 + e4; const int d0 = dbase - crow(r, hi), d1 = d0 - 32;
                const float b0 = lut[min(max(d0, 0), 128)], b1 = lut[min(max(d1, 0), 128)];
                p0[r] = (d0 >= 0) ? p0[r] * SC + b0 : NEGF; p1[r] = (d1 >= 0) ? p1[r] * SC + b1 : NEGF; }
            __builtin_amdgcn_sched_barrier(0);
        }
        u32x4 pw[4];
        SOFTMAX_TILE(p0, p1, m, l, 4, o, pw);
#pragma unroll
        for (int sl = 0; sl < 4; ++sl)
#pragma unroll
            for (int dt = 0; dt < 4; ++dt) { const LAS unsigned char* vp = vb + (dt * 32 + r32) * 520 + (tt * 64 + 16 * sl + 4 * hi) * 2;
                const u32x2 lo = *(const LAS u32x2*)vp, hh = *(const LAS u32x2*)(vp + 16);
                const u32x4 vf = {lo.x, lo.y, hh.x, hh.y};
                o[dt] = __builtin_amdgcn_mfma_f32_32x32x16_bf16(__builtin_bit_cast(bf16x8, vf), __builtin_bit_cast(bf16x8, pw[sl]), o[dt], 0, 0, 0); }
    }
    float lown = l + __shfl_xor(l, 32);
    float Mx = m;
#pragma unroll
    for (int k = 0; k < 3; ++k) if (k < nsel) Mx = fmaxf(Mx, mk[k]);
    const float wo = __builtin_amdgcn_exp2f(m - Mx); float L = lown * wo;
#pragma unroll
    for (int dt = 0; dt < 4; ++dt) o[dt] *= wo;
#pragma unroll
    for (int k = 0; k < 3; ++k) if (k < nsel) { const float wk = lk[k] * __builtin_amdgcn_exp2f(mk[k] - Mx); L += wk;
        const bf16_t* po = P.PO() + (slot0 + k) * 128;
#pragma unroll
        for (int dt = 0; dt < 4; ++dt)
#pragma unroll
            for (int g4 = 0; g4 < 4; ++g4) { const u32x2 w = *(const u32x2*)(po + 32 * dt + 8 * g4 + 4 * hi);
                o[dt][4 * g4] += wk * bf_lo(w.x); o[dt][4 * g4 + 1] += wk * bf_hi(w.x); o[dt][4 * g4 + 2] += wk * bf_lo(w.y); o[dt][4 * g4 + 3] += wk * bf_hi(w.y); } }
    const float inv = __builtin_amdgcn_rcpf(L);
#pragma unroll
    for (int dt = 0; dt < 4; ++dt)
#pragma unroll
        for (int g4 = 0; g4 < 4; ++g4) { const int d = 32 * dt + 8 * g4 + 4 * hi;
            const u32x2 gw = *(const u32x2*)(P.PA() + qrow * NA + C_GA + h * 128 + d);
            const float i64 = inv * 16.f; int w8 = 0;
            w8 = __builtin_amdgcn_cvt_pk_fp8_f32(o[dt][4 * g4] * i64 * bf_lo(gw.x), o[dt][4 * g4 + 1] * i64 * bf_hi(gw.x), w8, false); w8 = __builtin_amdgcn_cvt_pk_fp8_f32(o[dt][4 * g4 + 2] * i64 * bf_lo(gw.y), o[dt][4 * g4 + 3] * i64 * bf_hi(gw.y), w8, true);
            *(unsigned*)(P.Y8() + qrow * 2048 + h * 128 + d) = (unsigned)w8; }
    __syncthreads();
}
__device__ const unsigned char MOBA_SCHED[8][3] = {{0 + 32, 9, 255}, {0 + 16 + 32, 10, 13}, {4, 11, 12}, {1 + 32, 8, 14}, {1 + 16 + 32, 7, 255}, {5, 3 + 32, 255}, {2 + 32, 6, 255}, {2 + 16 + 32, 3 + 16 + 32, 255}};

__device__ __forceinline__ void swa_item(LAS unsigned char* lds, const Ptrs& P, int l, int b, int hk, int qblk) {
    const int tid = opq((P.wave << 6) | lane_id()), lane = tid & 63, wid = __builtin_amdgcn_readfirstlane(tid >> 6), r32 = lane & 31, hi = lane >> 5;
    const float SC = 0.125f * LOG2E;
    LAS unsigned char* kb = lds; LAS unsigned char* vb = lds + 36864; LAS float* lut = (LAS float*)(lds + 70144);
    const int kvbase = qblk * 128 - 128;
#pragma unroll
    for (int i = 0; i < 4; ++i) { const int r = (tid >> 3) + 64 * i, c8 = tid & 7, kv = kvbase + r;
        u32x4 w = {0u, 0u, 0u, 0u};
        if (kv >= 0) w = *(const u32x4*)(P.PA() + (size_t)(b * SEQ + kv) * NA + C_KB + hk * 64 + c8 * 8);
        *(LAS u32x4*)(kb + r * 144 + c8 * 16) = w; }
#pragma unroll
    for (int i = 0; i < 4; ++i) { const int d = (tid >> 5) + 16 * i, k8 = tid & 31, kv = kvbase + k8 * 8;
        u32x4 w = {0u, 0u, 0u, 0u};
        if (kv >= 0) w = *(const u32x4*)(P.VTB() + ((size_t)((b * 4 + hk) * 64 + d)) * SEQ + kv);
        *(LAS u32x2*)(vb + d * 520 + k8 * 16) = (u32x2){w.x, w.y}; *(LAS u32x2*)(vb + d * 520 + k8 * 16 + 8) = (u32x2){w.z, w.w}; }
    { const int g = tid >> 7, dist = tid & 127; lut[tid] = P.rpe[t5_bucket(dist) * 24 + 8 + hk * 4 + g] * LOG2E; }
    const int g = wid >> 1, hq = hk * 4 + g;
    const float sink2 = P.sinks[l * 16 + hq] * LOG2E;
    bf16x8 qrs[2][4];
#pragma unroll
    for (int qs = 0; qs < 2; ++qs)
#pragma unroll
        for (int ks = 0; ks < 4; ++ks) qrs[qs][ks] = *(const bf16x8*)(P.PA() + (size_t)(b * SEQ + qblk * 128 + 32 * (2 * (wid & 1) + qs) + r32) * NA + C_QB + hq * 64 + ks * 16 + hi * 8);
    __syncthreads();
#pragma unroll
    for (int qs = 0; qs < 2; ++qs) {
        const int qq = 2 * (wid & 1) + qs, q_local = 32 * qq + r32; const size_t qrow = (size_t)(b * SEQ + qblk * 128 + q_local);
        bf16x8 qr[4];
#pragma unroll
        for (int ks = 0; ks < 4; ++ks) qr[ks] = qrs[qs][ks];
        float m = NEGF, lsum = 0.f; f32x16 o[2]; o[0] = f32x16{}; o[1] = f32x16{};
        const int tk_hi = (32 * qq + 159) >> 6, tk_lo = (32 * qq + 1) >> 6;
#pragma unroll 1
        for (int tk = tk_hi; tk >= tk_lo; --tk) {
            f32x16 p0 = {}, p1 = {};
#pragma unroll
            for (int ks = 0; ks < 4; ++ks) { const bf16x8 k0 = *(const LAS bf16x8*)(kb + (tk * 64 + r32) * 144 + ks * 32 + hi * 16), k1 = *(const LAS bf16x8*)(kb + (tk * 64 + 32 + r32) * 144 + ks * 32 + hi * 16);
                p0 = __builtin_amdgcn_mfma_f32_32x32x16_bf16(k0, qr[ks], p0, 0, 0, 0); p1 = __builtin_amdgcn_mfma_f32_32x32x16_bf16(k1, qr[ks], p1, 0, 0, 0); }
            const int dbase = 128 + q_local - tk * 64;
#pragma unroll
            for (int r = 0; r < 16; ++r) { const int d0 = dbase - crow(r, hi), d1 = d0 - 32;
                const int rb0 = tk * 64 + crow(r, hi), rb1 = rb0 + 32;
                const bool v0 = (d0 >= 0) && (d0 < 128) && (qblk > 0 || rb0 >= 128), v1 = (d1 >= 0) && (d1 < 128) && (qblk > 0 || rb1 >= 128);
                const float b0 = lut[g * 128 + (d0 & 127)], b1 = lut[g * 128 + (d1 & 127)];
                p0[r] = v0 ? p0[r] * SC + b0 : NEGF; p1[r] = v1 ? p1[r] * SC + b1 : NEGF; }
            u32x4 pw[4];
            SOFTMAX_TILE(p0, p1, m, lsum, 2, o, pw);
#pragma unroll
            for (int dt = 0; dt < 2; ++dt)
#pragma unroll
                for (int s = 0; s < 4; ++s) { const LAS unsigned char* vp = vb + (dt * 32 + r32) * 520 + (tk * 64 + 16 * s + 4 * hi) * 2;
                    const u32x2 lo = *(const LAS u32x2*)vp, hh = *(const LAS u32x2*)(vp + 16);
                    const u32x4 vf = {lo.x, lo.y, hh.x, hh.y};
                    o[dt] = __builtin_amdgcn_mfma_f32_32x32x16_bf16(__builtin_bit_cast(bf16x8, vf), __builtin_bit_cast(bf16x8, pw[s]), o[dt], 0, 0, 0); }
        }
        const float lt = lsum + __shfl_xor(lsum, 32) + __builtin_amdgcn_exp2f(sink2 - m); const float inv = __builtin_amdgcn_rcpf(lt);
#pragma unroll
        for (int dt = 0; dt < 2; ++dt)
#pragma unroll
            for (int g4 = 0; g4 < 4; ++g4) { const int d = 32 * dt + 8 * g4 + 4 * hi;
                const u32x2 gw = *(const u32x2*)(P.PA() + qrow * NA + C_GB + hq * 64 + d);
                const float i64 = inv * 16.f; int w8 = 0;
                w8 = __builtin_amdgcn_cvt_pk_fp8_f32(o[dt][4 * g4] * i64 * bf_lo(gw.x), o[dt][4 * g4 + 1] * i64 * bf_hi(gw.x), w8, false); w8 = __builtin_amdgcn_cvt_pk_fp8_f32(o[dt][4 * g4 + 2] * i64 * bf_lo(gw.y), o[dt][4 * g4 + 3] * i64 * bf_hi(gw.y), w8, true);
                *(unsigned*)(P.Y8() + qrow * 2048 + 1024 + hq * 64 + d) = (unsigned)w8; }
    }
    __syncthreads();
}

#define XB_TMO      128
#define XB_XCNT(j)  (256  + 64 * (j))
#define XB_XSUB(j)  (1280 + 64 * (j))
#define XB_XGEN(j)  (2304 + 64 * (j))
#define XB_TOP      3328
#define XB_TOPGEN   3392
#define XCD_BAR_WORDS 3456
#define XB_SPIN_CAP (1u << 18)

__device__ __forceinline__ unsigned xb_ld(unsigned* p)              { return __hip_atomic_load(p, __ATOMIC_RELAXED, __HIP_MEMORY_SCOPE_AGENT); }
__device__ __forceinline__ unsigned xb_add(unsigned* p, unsigned v) { return __hip_atomic_fetch_add(p, v, __ATOMIC_RELAXED, __HIP_MEMORY_SCOPE_AGENT); }
__device__ __forceinline__ unsigned xb_xcc_id() { return (unsigned)__builtin_amdgcn_s_getreg((3 << 11) | 20) & 0xFu; }
#define XB_SPIN(cond, bar) do { unsigned _sp = 0; while (cond) { __builtin_amdgcn_s_sleep(1); \
    if ((++_sp & 255u) == 0u) { if (xb_ld(&(bar)[XB_TMO])) break; if (_sp > XB_SPIN_CAP) { atomicAdd(&(bar)[XB_TMO], 1u); break; } } } } while (0)

struct XcdBarrier {
    unsigned* bar; unsigned x; int wave;
    volatile LAS unsigned* st;
};

__device__ __forceinline__ XcdBarrier xcd_barrier_post(unsigned* bar, volatile LAS unsigned* st, int wave) {
    XcdBarrier b; b.bar = bar; b.x = xb_xcc_id(); b.st = st; b.wave = wave;
    if (wave == 0 && lane_id() == 0) (void)xb_add(&bar[XB_XCNT(b.x)], 1u);
    return b;
}
__device__ __forceinline__ void xcd_barrier_complete(unsigned* bar, unsigned x, unsigned& nloc, unsigned& nx) {
    const unsigned G = gridDim.x * gridDim.y * gridDim.z;
    unsigned sum, cnt, mine, sp = 0u;
    for (;;) {
        sum = 0u; cnt = 0u; mine = 0u;
#pragma unroll
        for (unsigned j = 0; j < 16; ++j) { const unsigned c = xb_ld(&bar[XB_XCNT(j)]); sum += c; cnt += (c > 0u) ? 1u : 0u; mine = (j == x) ? c : mine; }
        if (sum == G) break;
        __builtin_amdgcn_s_sleep(1);
        if ((++sp & 255u) == 0u) { if (xb_ld(&bar[XB_TMO])) break; if (sp > XB_SPIN_CAP) { atomicAdd(&bar[XB_TMO], 1u); break; } }
    }
    nloc = mine > 0u ? mine : 1u; nx = cnt > 0u ? cnt : 1u;
}

__device__ __forceinline__ void xcd_barrier(const XcdBarrier& b) {
    asm volatile("s_waitcnt vmcnt(0)" ::: "memory");
    __syncthreads();
    if (b.wave == 0 && lane_id() == 0) {
        unsigned* bar = launder_s(b.bar);
        __builtin_amdgcn_s_waitcnt(0);
        unsigned nloc = b.st[0], nx = b.st[1];
        if (nloc == 0u) { xcd_barrier_complete(bar, b.x, nloc, nx); b.st[0] = nloc; b.st[1] = nx; }
        const unsigned old = xb_add(&bar[XB_XSUB(b.x)], 1u);
        const unsigned gen = old / nloc;
        if (old + 1u == (gen + 1u) * nloc) {
            __builtin_amdgcn_fence(__ATOMIC_RELEASE, "agent");
            asm volatile("s_waitcnt vmcnt(0)" ::: "memory");
            const unsigned og = xb_add(&bar[XB_TOP], 1u);
            const unsigned tg = og / nx;
            if (og + 1u == (tg + 1u) * nx) xb_add(&bar[XB_TOPGEN], 1u);
            else XB_SPIN(xb_ld(&bar[XB_TOPGEN]) == tg, bar);
            __builtin_amdgcn_fence(__ATOMIC_ACQUIRE, "agent");
            xb_add(&bar[XB_XGEN(b.x)], 1u);
            asm volatile("s_waitcnt vmcnt(0)" ::: "memory");
        } else {
            XB_SPIN(xb_ld(&bar[XB_XGEN(b.x)]) == gen, bar);
            __builtin_amdgcn_fence(__ATOMIC_ACQUIRE, "agent");
            asm volatile("s_waitcnt vmcnt(0)" ::: "memory");
        }
    }
    __syncthreads();
}

template <int l> __device__ __forceinline__ void layer_phases(LAS unsigned char* lds, Ptrs& P, const XcdBarrier& xbar, KArgs kargs, const int lo, const int hi, const int lane0, const int wave, const int G0, const int bx0) {
#define PHASE_BEGIN() P.reload(launder_s(kargs)); const int G = sopq(G0), bx = sopq(bx0); const int lane = opq(lane_id()); const int gw = bx * 8 + wave, NGW = G * 8; (void)gw; (void)NGW; (void)lane
#define IN(k) (lo <= (k) && (k) < hi)
#define SEAM(k) do { if (IN(k) && IN((k) + 1)) xcd_barrier(xbar); } while (0)
        constexpr int pb = 1 + 8 * l;
        if (IN(pb)) {
            PHASE_BEGIN();
#ifndef NO_P1
            { pg8::Gemm g{(const bf16_t*)P.XB8(), (const bf16_t*)(P.WIN8() + (size_t)l * N8 * DM), DM / 2, DM / 2, DM / 2, 0, 0, P.wave}; pg8::StaticOrder S; S.init(M, N8, G, bx);
              pg8::EpiIn E{P.PA(), P.GT(), P.SSQ() + (size_t)(2 * l) * M, 1, 1.f / 512.f};
              pg8::gemm_phase<pg8::EpiIn, pg8::StaticOrder, true, true>(lds, g, S, E); }
            { pg8::Gemm g{P.XB(), P.WINB() + (size_t)l * NB16 * DM, DM, DM, DM, 0, 0, P.wave}; pg8::StaticOrder S; S.init(M, NB16, G, bx);
              pg8::EpiIn E{P.PA(), P.GT(), P.SSQ() + (size_t)(2 * l) * M, 2, 1.f};
              pg8::gemm_phase<pg8::EpiIn, pg8::StaticOrder, true, false>(lds, g, S, E); }
#endif
        }
        SEAM(pb);
        if (IN(pb + 1)) {
            PHASE_BEGIN();
#ifndef NO_P2A
#ifndef REP_P2A
#define REP_P2A 1
#endif
            for (int rep = 0; rep < REP_P2A; ++rep) {
            if (bx == 0) { const int t_ = (P.wave << 6) | lane_id(); P.SELCNT()[t_] = 0u; if (t_ < 32) P.SELCNT()[512 + t_] = 0u; }
#ifndef REP_KM
#define REP_KM 1
#endif
#ifndef REP_VT
#define REP_VT 1
#endif
#ifndef REP_LRU
#define REP_LRU 1
#endif
            for (int r2 = 0; r2 < REP_KM; ++r2)
            for (int it = bx; it < BATCH * 8 * 16; it += G) kmean_item(lds, P, it);
            for (int r2 = 0; r2 < REP_VT; ++r2)
            for (int it = gw; it < 5120; it += NGW) vtrans_item(lds + wave * 9216, P, it, lane);
            __syncthreads();
            for (int r2 = 0; r2 < REP_LRU; ++r2)
            lru_local_phase(lds, P, l, bx, G);
            __syncthreads(); }
#endif
        }
        SEAM(pb + 1);
        if (IN(pb + 2)) {
            PHASE_BEGIN();
            for (int it = bx; it < 512; it += G) { const int j = it & 15; if (j > 0) moba_list_item(P, it >> 4, j); }
            for (int it = bx; it < 256; it += G) lru_fix_item(P, it);
            for (int it = bx; it < 512; it += G) swa_item(lds, P, l, it >> 7, (it >> 5) & 3, it & 31);
        }
        SEAM(pb + 2);
        if (IN(pb + 3)) {
            PHASE_BEGIN();
#ifndef REP_KV
#define REP_KV 1
#endif
            for (int it = bx; it < 256; it += G) { const int bh = it >> 3;
                int pre[16]; pre[0] = 0;
#pragma unroll
                for (int n = 0; n < 15; ++n) { int c = (int)P.SELCNT()[bh * 16 + n]; c = c < 4096 ? c : 4096; pre[n + 1] = pre[n] + ((c + 511) >> 9); }
                const int total = __builtin_amdgcn_readfirstlane(pre[15]);
                volatile LAS int* qw = (volatile LAS int*)(lds + LDS_BYTES - 128);
                for (;;) {
                    if (P.wave == 0 && lane_id() == 0) qw[0] = (int)atomicAdd(P.SELCNT() + 512 + bh, 1u);
                    __syncthreads();
                    const int u = __builtin_amdgcn_readfirstlane(qw[0]);
                    __syncthreads();
                    if (u >= total) break;
                    int n = 0;
#pragma unroll
                    for (int k = 1; k < 15; ++k) n += (u >= pre[k]) ? 1 : 0;
                    int pn_ = 0;
#pragma unroll
                    for (int k = 0; k < 15; ++k) pn_ = (k == n) ? pre[k] : pn_;
                    int cnt = (int)P.SELCNT()[bh * 16 + n]; cnt = cnt < 4096 ? cnt : 4096; cnt = __builtin_amdgcn_readfirstlane(cnt);
                    const int beg = (u - pn_) << 9, end = (beg + 512 < cnt) ? beg + 512 : cnt;
                    moba_kv_item(lds, P, bh, n, beg, end);
                } }
        }
        SEAM(pb + 3);
        if (IN(pb + 4)) {
            PHASE_BEGIN();
#ifndef REP_OWN
#define REP_OWN 1
#endif
            for (int rep = 0; rep < REP_OWN; ++rep)
            for (int it = bx; it < 256; it += G) { const int bh = it >> 3, sb = it & 7;
                moba_own_item(lds, P, bh >> 3, bh & 7, 15 - sb);
                moba_own_item(lds, P, bh >> 3, bh & 7, sb); }
        }
        SEAM(pb + 4);
        if (IN(pb + 5)) {
            PHASE_BEGIN();
#ifndef NO_P3
            { pg8::Gemm g{(const bf16_t*)P.Y8(), (const bf16_t*)(P.WBR8() + (size_t)l * 2 * DM * 1024), 1024, 512, 512, (size_t)1024, (size_t)DM * 1024, P.wave}; pg8::ZOrder2 S; S.S.init(M, DM, G, bx);
              pg8::EpiMerge E{P.GT(), P.MG(), 1.f / 512.f};
              pg8::gemm_phase<pg8::EpiMerge, pg8::ZOrder2, true, true>(lds, g, S, E); }
            { pg8::Gemm g{P.YC(), P.WBR() + (size_t)(l * 3 + 2) * DM * 1024, 1024, 1024, 1024, 0, 0, P.wave}; pg8::ZFixed S; S.S.init(M, DM, G, bx); S.z = 2;
              pg8::EpiMerge E{P.GT(), P.MG(), 1.f};
              pg8::gemm_phase<pg8::EpiMerge, pg8::ZFixed, true, false>(lds, g, S, E); }
#endif
        }
        SEAM(pb + 5);
        if (IN(pb + 6)) {
            PHASE_BEGIN();
            { pg8::Gemm g{P.MG(), P.WOUT() + (size_t)l * DM * DM, DM, DM, DM, 0, 0, P.wave}; pg8::StaticOrder S; S.init(M, DM, G, bx);
              pg8::EpiOut E{l == 0 ? P.x : P.out, P.X1(), P.XB1(), P.SSQ() + (size_t)(1 + 2 * l) * M};
#ifndef NO_P4
              pg8::gemm_phase<pg8::EpiOut, pg8::StaticOrder, true>(lds, g, S, E);
#endif
            }
            { pg8::Gemm g{P.PB() + (size_t)l * M * PLE, P.WPP() + (size_t)l * DM * PLE, PLE, PLE, PLE, 0, 0, P.wave}; pg8::StaticOrder S; S.init(M, DM, G, bx);
              pg8::EpiPlain E{P.T(), DM};
#ifndef NO_P4T
              pg8::gemm_phase<pg8::EpiPlain, pg8::StaticOrder, true>(lds, g, S, E);
#endif
            }
        }
        SEAM(pb + 6);
        if (IN(pb + 7)) {
            PHASE_BEGIN();
            pg8::Gemm g{P.XB1(), P.WPG() + (size_t)l * DM * DM, DM, DM, DM, 0, 0, P.wave}; pg8::StaticOrder S; S.init(M, DM, G, bx);
            pg8::EpiPle E{P.X1(), P.T(), P.SSQ() + (size_t)(1 + 2 * l) * M, P.out, P.XB(), P.XB8(), P.SSQ() + (size_t)(2 + 2 * l) * M, l + 1 < DEPTH};
#ifndef NO_P5
            pg8::gemm_phase<pg8::EpiPle, pg8::StaticOrder, true>(lds, g, S, E);
#endif
        }
        SEAM(pb + 7);

#undef IN
#undef SEAM
#undef PHASE_BEGIN
}

constexpr int NPH = 18;

__global__ void __launch_bounds__(NTHR, 2) fwd_kernel(Args args) {
    extern __shared__ __attribute__((aligned(16))) unsigned char lds_raw[];
    LAS unsigned char* lds = (LAS unsigned char*)lds_raw;
    cg::grid_group grid = cg::this_grid();
    const int tid = threadIdx.x, lane0 = tid & 63, wave = __builtin_amdgcn_readfirstlane(tid >> 6);
    const int G0 = gridDim.x, bx0 = blockIdx.x;
#define PHASE_BEGIN() P.reload(launder_s(kargs)); const int G = sopq(G0), bx = sopq(bx0); const int lane = opq(lane_id()); const int gw = bx * 8 + wave, NGW = G * 8; (void)gw; (void)NGW; (void)lane
    unsigned char* ws = args.ws;
    Ptrs P;
    KArgs kargs = (KArgs)__builtin_amdgcn_kernarg_segment_ptr();
    P.wave = wave;
    const int lo = args.ph_lo, hi = args.ph_hi;
    volatile LAS unsigned* bst = (volatile LAS unsigned*)(lds + LDS_BYTES - 64);
    if (tid < 2) bst[tid] = 0u;
    __syncthreads();
    const XcdBarrier xbar = xcd_barrier_post((unsigned*)(ws + OFF_BAR), bst, wave);
    if (hi > 1000) grid.sync();
#define IN(k) (lo <= (k) && (k) < hi)
#define SEAM(k) do { if (IN(k) && IN((k) + 1)) xcd_barrier(xbar); } while (0)

#ifndef REP_P0
#define REP_P0 1
#endif
    if (IN(0)) for (int rep0 = 0; rep0 < REP_P0; ++rep0) {
        PHASE_BEGIN();
        LAS float* scr = (LAS float*)(lds + wave * 16640);
        for (int l = 0; l < DEPTH; ++l) {
            { const float* wl = P.w_in + (size_t)l * DM * NIN; const float* ng = P.norm_g + l * DM;
              unsigned char* w8 = P.WIN8() + (size_t)l * N8 * DM; bf16_t* wb = P.WINB() + (size_t)l * NB16 * DM;
              transpose_matrix<true>(wl + 2048, DM, 4608, NIN, w8, ng, 64.f, scr, gw, NGW, lane);
              transpose_matrix<true>(wl + 8704, DM, 6144, NIN, w8 + (size_t)4608 * DM, ng, 64.f, scr, gw, NGW, lane);
              transpose_matrix(wl, DM, 2048, NIN, wb, ng, 1.f, scr, gw, NGW, lane);
              transpose_matrix(wl + 6656, DM, 2048, NIN, wb + (size_t)2048 * DM, ng, 1.f, scr, gw, NGW, lane); }
            for (int z = 0; z < 2; ++z) transpose_matrix<true>(P.w_br + (size_t)(l * 3 + z) * 1024 * DM, 1024, DM, DM, P.WBR8() + (size_t)(l * 2 + z) * DM * 1024, nullptr, 32.f, scr, gw, NGW, lane);
            transpose_matrix(P.w_br + (size_t)(l * 3 + 2) * 1024 * DM, 1024, DM, DM, P.WBR() + (size_t)(l * 3 + 2) * DM * 1024, nullptr, 1.f, scr, gw, NGW, lane);
            transpose_matrix(P.w_out + (size_t)l * DM * DM, DM, DM, DM, P.WOUT() + (size_t)l * DM * DM, nullptr, 1.f, scr, gw, NGW, lane);
            transpose_matrix(P.w_pg + (size_t)l * DM * DM, DM, DM, DM, P.WPG() + (size_t)l * DM * DM, P.ple_g + l * DM, 1.f, scr, gw, NGW, lane);
            transpose_matrix(P.w_pp + (size_t)l * PLE * DM, PLE, DM, DM, P.WPP() + (size_t)l * DM * PLE, nullptr, 1.f, scr, gw, NGW, lane);
            for (int n = 0; n < 8; ++n) {
                transpose_matrix(P.w_r + (size_t)(l * 8 + n) * 16384, 128, 128, 128, P.WR() + (size_t)(l * 8 + n) * 16384, nullptr, 1.f, scr, gw, NGW, lane);
                transpose_matrix(P.w_i + (size_t)(l * 8 + n) * 16384, 128, 128, 128, P.WI() + (size_t)(l * 8 + n) * 16384, nullptr, 1.f, scr, gw, NGW, lane);
            }
        }
        for (int mrow = gw; mrow < M; mrow += NGW) {
            const f32x4* xr = (const f32x4*)(P.x + (size_t)mrow * DM) + lane; u32x2* ob = (u32x2*)(P.XB() + (size_t)mrow * DM) + lane; unsigned* o8 = (unsigned*)(P.XB8() + (size_t)mrow * DM) + lane; float s = 0.f;
#pragma unroll
            for (int jv = 0; jv < 8; ++jv) { const f32x4 v = xr[64 * jv]; s += (v[0] * v[0] + v[1] * v[1]) + (v[2] * v[2] + v[3] * v[3]); ob[64 * jv] = (u32x2){pk2(v[0], v[1]), pk2(v[2], v[3])};
                int q = 0; q = __builtin_amdgcn_cvt_pk_fp8_f32(v[0] * 8.f, v[1] * 8.f, q, false); q = __builtin_amdgcn_cvt_pk_fp8_f32(v[2] * 8.f, v[3] * 8.f, q, true); o8[64 * jv] = (unsigned)q; }
            s = wave_sum(s);
            if (lane == 0) P.SSQ()[mrow] = s;
        }
        for (size_t i = (size_t)bx * NTHR + tid; i < (size_t)DEPTH * M * PLE / 8; i += (size_t)G * NTHR) {
            const f32x4 v0 = *(const f32x4*)(P.p + i * 8), v1 = *(const f32x4*)(P.p + i * 8 + 4);
            *(u32x4*)(P.PB() + i * 8) = (u32x4){pk2(v0[0], v0[1]), pk2(v0[2], v0[3]), pk2(v1[0], v1[1]), pk2(v1[2], v1[3])}; }
        for (int i = bx * NTHR + tid; i < 4 * M; i += G * NTHR) P.SSQ()[M + i] = 0.f;
    }
    SEAM(0);

    layer_phases<0>(lds, P, xbar, kargs, lo, hi, lane0, wave, G0, bx0);
    layer_phases<1>(lds, P, xbar, kargs, lo, hi, lane0, wave, G0, bx0);
    if (IN(17)) {
        PHASE_BEGIN();
        for (int mrow = gw; mrow < M; mrow += NGW) {
            const float rs = rsqrtf(P.SSQ()[(size_t)4 * M + mrow] * (1.f / DM) + EPS);
            f32x4* xr = (f32x4*)(P.out + (size_t)mrow * DM) + lane; const f32x4* gr = (const f32x4*)P.fin_g + lane;
#pragma unroll
            for (int jv = 0; jv < 8; ++jv) { const f32x4 v = xr[64 * jv], gg = gr[64 * jv]; xr[64 * jv] = v * rs * gg; }
        }
    }
#undef IN
#undef SEAM
}

extern "C" void kernel_launch(void* const* d_in, const int* in_sizes, int n_in, void* d_out, int out_size, void* d_ws, size_t ws_size, hipStream_t stream) {
    static int grid = 0;
    if (grid == 0) {
        if (n_in != 19 || out_size != M * DM || ws_size < WS_END) { fprintf(stderr, "kernel_launch: unexpected problem (n_in %d, out %d, ws %zu < %zu)\n", n_in, out_size, ws_size, (size_t)WS_END); grid = -1; return; }
        int dev = 0, cus = 0, per_cu = 0;
        (void)hipGetDevice(&dev); (void)hipDeviceGetAttribute(&cus, hipDeviceAttributeMultiprocessorCount, dev);
        (void)hipFuncSetAttribute((const void*)fwd_kernel, hipFuncAttributeMaxDynamicSharedMemorySize, LDS_BYTES);
        if (hipOccupancyMaxActiveBlocksPerMultiprocessor(&per_cu, (const void*)fwd_kernel, NTHR, LDS_BYTES) != hipSuccess || per_cu < 1) per_cu = 1;
        (void)hipGetLastError();
        grid = cus > 0 ? cus : 256;
    }
    if (grid < 0) return;
    (void)hipMemsetAsync((unsigned char*)d_ws + OFF_BAR, 0, BAR_BYTES, stream);
    Args a{};
    for (int i = 0; i < 19; ++i) a.in[i] = (const float*)d_in[i];
    a.out = (float*)d_out; a.ws = (unsigned char*)d_ws; a.ph_lo = 0; a.ph_hi = NPH;
    void* params[] = {&a};
    hipError_t e = hipLaunchCooperativeKernel((const void*)fwd_kernel, dim3(grid), dim3(NTHR), params, LDS_BYTES, stream);
    if (e != hipSuccess) fprintf(stderr, "cooperative launch failed: %s (grid %d)\n", hipGetErrorString(e), grid);
}
```

```cpp
#include <hip/hip_runtime.h>
#include <hip/hip_cooperative_groups.h>
#include <cstdio>
#include <cstdint>
namespace cg = cooperative_groups;

#define LAS __attribute__((address_space(3)))
typedef unsigned short bf16_t;
typedef short bf16x8 __attribute__((ext_vector_type(8)));
typedef float f32x4 __attribute__((ext_vector_type(4)));
typedef float f32x2 __attribute__((ext_vector_type(2)));
typedef float f32x16 __attribute__((ext_vector_type(16)));
typedef unsigned u32x4 __attribute__((ext_vector_type(4)));
typedef unsigned u32x2 __attribute__((ext_vector_type(2)));
typedef __bf16 bf16x2_t __attribute__((ext_vector_type(2)));

constexpr int BATCH = 4, SEQ = 4096, DM = 2048, M = BATCH * SEQ, DEPTH = 2, PLE = 256;
constexpr int NIN = 14848, NA = 8704, NG = 6144;
constexpr int C_QA = 0, C_KA = 1024, C_VA = 2048, C_GA = 3072, C_QB = 4096, C_KB = 5120, C_VB = 5376, C_GB = 5632, C_XC = 6656, C_GC = 7680;
constexpr float EPS = 1e-6f, LOG2E = 1.4426950408889634f, NEGF = -1e30f;

constexpr size_t SZ_WIN = (size_t)DEPTH * NIN * DM * 2, SZ_WBR = (size_t)DEPTH * 3 * DM * 1024 * 2, SZ_WSQ = (size_t)DEPTH * DM * DM * 2;
constexpr size_t SZ_WPP = (size_t)DEPTH * DM * PLE * 2, SZ_WRI = (size_t)DEPTH * 8 * 128 * 128 * 2;
constexpr int N8 = 10752, NB16 = 4096;
constexpr size_t OFF_WIN = 0, OFF_WIN8 = OFF_WIN, OFF_WINB = OFF_WIN8 + (size_t)DEPTH * N8 * DM, OFF_XB8 = OFF_WINB + (size_t)DEPTH * NB16 * DM * 2, OFF_WBR = OFF_WIN + SZ_WIN, OFF_WOUT = OFF_WBR + SZ_WBR, OFF_WPG = OFF_WOUT + SZ_WSQ, OFF_WPP = OFF_WPG + SZ_WSQ;
constexpr size_t OFF_WR = OFF_WPP + SZ_WPP, OFF_WI = OFF_WR + SZ_WRI;
constexpr size_t OFF_XB = OFF_WI + SZ_WRI;
constexpr size_t OFF_VTA = OFF_XB, OFF_VTB = OFF_XB + (size_t)BATCH * 1024 * SEQ * 2;
constexpr size_t OFF_PA = OFF_XB + (size_t)M * DM * 2;
constexpr size_t OFF_X1 = OFF_PA, OFF_MG = OFF_X1 + (size_t)M * DM * 4, OFF_XB1 = OFF_MG + (size_t)M * DM * 2;
constexpr size_t OFF_GT = OFF_PA + (size_t)M * NA * 2;
constexpr size_t OFF_Y = OFF_GT + (size_t)M * NG * 2;
constexpr size_t OFF_T = OFF_Y;
constexpr size_t OFF_Y8 = OFF_Y, OFF_YC = OFF_Y + (size_t)M * 2048;
constexpr size_t OFF_WBR8 = OFF_XB8 + (size_t)M * DM;
static_assert(OFF_WBR8 + (size_t)DEPTH * 2 * DM * 1024 <= OFF_WBR, "WBR8 fits");
constexpr size_t OFF_PB = OFF_Y + (size_t)M * 3072 * 2;
constexpr size_t OFF_SSQ = OFF_PB + (size_t)DEPTH * M * PLE * 2;
constexpr size_t OFF_KM = OFF_SSQ + (size_t)5 * M * 4;
constexpr size_t OFF_CHA = OFF_KM + (size_t)BATCH * 8 * 16 * 128 * 2, OFF_CHH = OFF_CHA + (size_t)BATCH * 64 * 1024 * 4;
constexpr size_t OFF_BAR = OFF_CHH + (size_t)BATCH * 64 * 1024 * 4, BAR_BYTES = 16384;
constexpr size_t OFF_SELCNT = OFF_BAR + BAR_BYTES;
constexpr size_t OFF_LIST = OFF_SELCNT + 4096;
constexpr size_t OFF_HL = OFF_LIST + (size_t)32 * 16 * 4096 * 4, OFF_CA = OFF_HL + (size_t)M * 1024 * 2;
constexpr size_t OFF_PO = OFF_HL;
constexpr size_t OFF_ML = OFF_PO + (size_t)32 * SEQ * 3 * 128 * 2;
constexpr size_t WS_END = OFF_ML + (size_t)32 * SEQ * 3 * 2 * 4;
static_assert(WS_END <= (size_t)973078528, "workspace budget (4 x largest tensor)");
static_assert(OFF_XB1 + (size_t)M * DM * 2 <= OFF_GT, "overlay fits");
static_assert(OFF_XB8 + (size_t)M * DM <= OFF_WBR, "fp8 / bf16 in-projection weight copies + fp8 x fit the old WIN region");
static_assert(OFF_VTB + (size_t)BATCH * 256 * SEQ * 2 <= OFF_PA, "VT overlay fits");

constexpr int LDS_BYTES = 147456;
constexpr int NTHR = 512;

__device__ __forceinline__ unsigned pk2(float lo, float hi) { f32x2 v = {lo, hi}; bf16x2_t b = __builtin_convertvector(v, bf16x2_t); return __builtin_bit_cast(unsigned, b); }
__device__ __forceinline__ float bf_lo(unsigned u) { return __uint_as_float(u << 16); }
__device__ __forceinline__ float bf_hi(unsigned u) { return __uint_as_float(u & 0xffff0000u); }
__device__ __forceinline__ float sigm(float v) { return __builtin_amdgcn_rcpf(1.f + __expf(-v)); }
__device__ __forceinline__ int opq(int v) { asm volatile("" : "+v"(v)); return v; }
__device__ __forceinline__ int sopq(int v) { asm volatile("" : "+s"(v)); return v; }
template <class T> __device__ __forceinline__ T launder_s(T p) { asm volatile("" : "+s"(p)); return p; }
__device__ __forceinline__ int lane_id() { return (int)__builtin_amdgcn_mbcnt_hi(~0u, __builtin_amdgcn_mbcnt_lo(~0u, 0u)); }
__device__ __forceinline__ int crow(int r, int hi) { return (r & 3) + 8 * (r >> 2) + 4 * hi; }
__device__ __forceinline__ float wave_sum(float v) {
#pragma unroll
    for (int o = 1; o < 64; o <<= 1) v += __shfl_xor(v, o);
    return v;
}
__device__ __forceinline__ int t5_bucket(int n) {
    if (n < 16) return n;
    int b = 16;
    b += (n >= 19); b += (n >= 21); b += (n >= 24); b += (n >= 27); b += (n >= 31); b += (n >= 35); b += (n >= 40); b += (n >= 46);
    b += (n >= 52); b += (n >= 59); b += (n >= 67); b += (n >= 77); b += (n >= 87); b += (n >= 99); b += (n >= 113);
    return b;
}

namespace pg8 {
constexpr int BM = 256, BK = 64, HALF = 128, HTB = HALF * BK * 2, STAGE_BYTES = 8 * HTB, NXCD = 8, WGM = 8;
__device__ __forceinline__ int lds_byte(int r, int c) { const int st = (r >> 4) * 2 + (c >> 5), rr = r & 15, cc = c & 31, ob = rr * 64 + cc * 2; return st * 1024 + (ob ^ (((ob >> 9) & 1) << 5)); }
__device__ __forceinline__ void stage_rc(int b, int& R, int& C) { const int st = b / 1024, sb = b % 1024, swz = sb ^ (((sb >> 9) & 1) << 5); R = (st >> 1) * 16 + swz / 64; C = (st & 1) * 32 + (swz % 64) / 2; }
__device__ __forceinline__ int perm32(int rho) { const int n = rho >> 4, i = rho & 15; return 8 * (i >> 2) + 4 * n + (i & 3); }

typedef int v4i_t __attribute__((ext_vector_type(4)));
typedef int v8i_t __attribute__((ext_vector_type(8)));
__device__ __forceinline__ v8i_t cat8(bf16x8 lo, bf16x8 hi) { return __builtin_shufflevector(__builtin_bit_cast(v4i_t, lo), __builtin_bit_cast(v4i_t, hi), 0, 1, 2, 3, 4, 5, 6, 7); }
__device__ __forceinline__ void glds16_s(const char* sbase, unsigned voff, unsigned ldsbase, int imm) { unsigned keep;
    asm volatile("s_mov_b32 %0, m0\n\ts_add_i32 m0, %3, %4\n\ts_nop 0\n\tglobal_load_lds_dwordx4 %1, %2\n\ts_mov_b32 m0, %0" : "=&s"(keep) : "v"(voff), "s"(sbase), "s"(ldsbase), "i"(imm) : "memory", "scc"); }
struct Unit { int pm, pn, z; };
struct Gemm { const bf16_t* A; const bf16_t* Bt; int lda, ldb, K; size_t zA, zB; int wave; };

struct StaticOrder {
    int nM, nN, nwg, G, c;
    __device__ void init(int M_, int N_, int G_, int c_) { nM = M_ / BM; nN = N_ / BM; nwg = nM * nN; G = G_; c = c_; }
    __device__ bool next(int i, Unit& u) const {
        const long L = (long)i * G + c; if (L >= nwg) return false;
        int wgid = (int)L; { const int q = nwg / NXCD, r = nwg % NXCD, xcd = wgid % NXCD, off = wgid / NXCD; wgid = (xcd < r ? xcd * (q + 1) : r * (q + 1) + (xcd - r) * q) + off; }
        const int nig = WGM * nN, gid = wgid / nig, fm = gid * WGM, gsz = (nM - fm) < WGM ? (nM - fm) : WGM;
        u.pm = fm + ((wgid % nig) % gsz); u.pn = (wgid % nig) / gsz; u.z = 0; return true;
    }
};
struct ZOrder2 {
    StaticOrder S;
    __device__ bool next(int i, Unit& u) const { if (!S.next(i >> 1, u)) return false; u.z = i & 1; return true; }
};
struct ZFixed {
    StaticOrder S; int z;
    __device__ bool next(int i, Unit& u) const { if (!S.next(i, u)) return false; u.z = z; return true; }
};

template <class Epi, class Sched, bool ALIGN_EPI, bool F8 = false>
__device__ __forceinline__ void gemm_phase(LAS unsigned char* lds, const Gemm g, const Sched& S, const Epi& E) {
    const int wid = __builtin_amdgcn_readfirstlane(g.wave), tid = opq((wid << 6) | lane_id()), lane = tid & 63, wr = wid >> 2, wc = wid & 3, fr = lane & 15, fq = lane >> 4;
    const int K = g.K, nt = K / BK;
    unsigned voffA[2], voffB[2];
#pragma unroll
    for (int i = 0; i < 2; ++i) { int R, C; stage_rc(tid * 16 + i * 8192, R, C); const int Rb = (R & ~31) + perm32(R & 31);
        voffA[i] = (unsigned)(R * g.lda + C) * 2u; voffB[i] = (unsigned)(Rb * g.ldb + C) * 2u; }
    const unsigned kstep = (unsigned)(BK * 2);
    const unsigned hstepA = (unsigned)HALF * g.lda * 2u, hstepB = (unsigned)HALF * g.ldb * 2u;
    const unsigned tstepA = 2u * hstepA, tstepB = 2u * hstepB;
    const unsigned ldsw = (unsigned)wid * 1024u;
    const unsigned lds_w32 = (unsigned)__builtin_amdgcn_readfirstlane((int)((unsigned)(uintptr_t)lds + ldsw));
    constexpr int KOFF = F8 ? 16 : 1024;
    const int aoff = lds_byte(wr * 64 + fr, F8 ? fq * 16 : fq * 8), boff = lds_byte(wc * 32 + fr, F8 ? fq * 16 : fq * 8);
#define PG8_SA(b, h) (((b) * 2 + (h)) * HTB)
#define PG8_SB(b, h) ((4 + (b) * 2 + (h)) * HTB)
#define PG8_STAGE_X(bufoff, rs, base, off, voff) do { _Pragma("unroll") for (int _i = 0; _i < 2; ++_i) { \
        if constexpr (F8) __builtin_amdgcn_raw_ptr_buffer_load_lds(rs, (LAS void*)(lds + (bufoff) + ldsw + _i * 8192), 16, (int)(voff)[_i], (int)(unsigned)(off), 0, 0); \
        else __builtin_amdgcn_global_load_lds((const unsigned*)((const char*)(base) + (size_t)((off) + (voff)[_i])), (LAS unsigned*)(lds + (bufoff) + ldsw + _i * 8192), 16, 0, 0); } } while (0)
#define PG8_STAGE_A(bufoff, off) PG8_STAGE_X(bufoff, rsA, g.A, off, voffA)
#define PG8_STAGE_B(bufoff, off) PG8_STAGE_X(bufoff, rsB, g.Bt, off, voffB)
#define PG8_LDA(dst, b, h) do { _Pragma("unroll") for (int m = 0; m < 4; ++m) _Pragma("unroll") for (int k = 0; k < 2; ++k) { const v4i_t f_ = *(const LAS v4i_t*)(lds + PG8_SA(b, h) + aoff + m * 2048 + k * KOFF); dst[m][4 * k] = f_[0]; dst[m][4 * k + 1] = f_[1]; dst[m][4 * k + 2] = f_[2]; dst[m][4 * k + 3] = f_[3]; } } while (0)
#define PG8_LDB(dst, b, h) do { _Pragma("unroll") for (int n = 0; n < 2; ++n) _Pragma("unroll") for (int k = 0; k < 2; ++k) { const v4i_t f_ = *(const LAS v4i_t*)(lds + PG8_SB(b, h) + boff + n * 2048 + k * KOFF); dst[n][4 * k] = f_[0]; dst[n][4 * k + 1] = f_[1]; dst[n][4 * k + 2] = f_[2]; dst[n][4 * k + 3] = f_[3]; } } while (0)
#define PG8_HALF(v, k) __builtin_bit_cast(bf16x8, (v4i_t){v[4 * (k)], v[4 * (k) + 1], v[4 * (k) + 2], v[4 * (k) + 3]})
#define PG8_MMA(ai, bj, At, Bt) do { __builtin_amdgcn_s_setprio(1); \
        if constexpr (F8) { _Pragma("unroll") for (int m = 0; m < 4; ++m) _Pragma("unroll") for (int n = 0; n < 2; ++n) \
            acc[ai][bj][m][n] = __builtin_amdgcn_mfma_scale_f32_16x16x128_f8f6f4(Bt[n], At[m], acc[ai][bj][m][n], 0, 0, 0, 0, 0, 0); }     \
        else { _Pragma("unroll") for (int m = 0; m < 4; ++m) _Pragma("unroll") for (int n = 0; n < 2; ++n) _Pragma("unroll") for (int k = 0; k < 2; ++k) \
            acc[ai][bj][m][n] = __builtin_amdgcn_mfma_f32_16x16x32_bf16(PG8_HALF(Bt[n], k), PG8_HALF(At[m], k), acc[ai][bj][m][n], 0, 0, 0); } \
        __builtin_amdgcn_s_setprio(0); } while (0)
#define PG8_WAIT_V(n) asm volatile("s_waitcnt vmcnt(" #n ")" ::: "memory")
#define PG8_WAIT_L(n) asm volatile("s_waitcnt lgkmcnt(" #n ")" ::: "memory")
#define PG8_BAR __builtin_amdgcn_s_barrier()
#define PG8_SCHED __builtin_amdgcn_sched_barrier(0)
    Unit cur, nxt; int ui = 0;
    if (!S.next(0, cur)) return;
    f32x4 acc[2][2][4][2];
#pragma unroll
    for (int a = 0; a < 2; ++a)
#pragma unroll
        for (int b = 0; b < 2; ++b)
#pragma unroll
            for (int m = 0; m < 4; ++m)
#pragma unroll
                for (int n = 0; n < 2; ++n) acc[a][b][m][n] = (f32x4){0.f, 0.f, 0.f, 0.f};
    v8i_t At[4], B0[2], B1[2];
    unsigned cA = (unsigned)cur.pm * tstepA + (unsigned)cur.z * (unsigned)g.zA, cB = (unsigned)cur.pn * tstepB + (unsigned)cur.z * (unsigned)g.zB;
    __amdgpu_buffer_rsrc_t rsA = __builtin_amdgcn_make_buffer_rsrc((void*)g.A, 0, 0x7fffffff, 0x00020000), rsB = __builtin_amdgcn_make_buffer_rsrc((void*)g.Bt, 0, 0x7fffffff, 0x00020000); (void)rsA; (void)rsB;
    PG8_STAGE_B(PG8_SB(0, 0), cB); PG8_STAGE_B(PG8_SB(0, 1), cB + hstepB); PG8_STAGE_A(PG8_SA(0, 0), cA); PG8_STAGE_A(PG8_SA(0, 1), cA + hstepA);
    if (wr == 1) PG8_BAR;
    PG8_WAIT_V(2); PG8_BAR;
    PG8_STAGE_B(PG8_SB(1, 0), cB + kstep); PG8_STAGE_A(PG8_SA(1, 0), cA + kstep); PG8_STAGE_B(PG8_SB(1, 1), cB + hstepB + kstep);
    PG8_WAIT_V(6); PG8_BAR;
    for (;;) {
        const bool has_next = S.next(ui + 1, nxt);
        const unsigned nA = has_next ? (unsigned)nxt.pm * tstepA + (unsigned)nxt.z * (unsigned)g.zA : cA;
        const unsigned nB = has_next ? (unsigned)nxt.pn * tstepB + (unsigned)nxt.z * (unsigned)g.zB : cB;
#pragma unroll 1
        for (int t = 0; t < nt; t += 2) {
            const bool last = (t == nt - 2);
            const unsigned a1 = cA + (unsigned)(t + 1) * kstep;
            const unsigned a2 = last ? nA : cA + (unsigned)(t + 2) * kstep; const unsigned b2 = last ? nB : cB + (unsigned)(t + 2) * kstep;
            const unsigned a3 = a2 + kstep; const unsigned b3 = b2 + kstep;
            PG8_LDB(B0, 0, 0); PG8_LDB(B1, 0, 1); PG8_SCHED; PG8_LDA(At, 0, 0); PG8_STAGE_A(PG8_SA(1, 1), a1 + hstepA);
            PG8_WAIT_V(8); PG8_WAIT_L(0); PG8_BAR; PG8_MMA(0, 0, At, B0); PG8_MMA(0, 1, At, B1); PG8_BAR; PG8_SCHED;
            PG8_LDA(At, 0, 1); PG8_STAGE_B(PG8_SB(0, 0), b2); PG8_STAGE_B(PG8_SB(0, 1), b2 + hstepB); PG8_STAGE_A(PG8_SA(0, 0), a2);
            PG8_WAIT_V(8); PG8_WAIT_L(0); PG8_BAR; PG8_MMA(1, 0, At, B0); PG8_MMA(1, 1, At, B1); PG8_BAR; PG8_SCHED;
            PG8_LDB(B0, 1, 0); PG8_LDB(B1, 1, 1); PG8_SCHED; PG8_LDA(At, 1, 0); PG8_STAGE_A(PG8_SA(0, 1), a2 + hstepA);
            PG8_WAIT_V(8); PG8_WAIT_L(0); PG8_BAR; PG8_MMA(0, 0, At, B0); PG8_MMA(0, 1, At, B1); PG8_BAR; PG8_SCHED;
            PG8_LDA(At, 1, 1); PG8_STAGE_B(PG8_SB(1, 0), b3); PG8_STAGE_B(PG8_SB(1, 1), b3 + hstepB); PG8_STAGE_A(PG8_SA(1, 0), a3);
            PG8_WAIT_V(8); PG8_WAIT_L(0); PG8_BAR; PG8_MMA(1, 0, At, B0); PG8_MMA(1, 1, At, B1); PG8_BAR; PG8_SCHED;
        }
        if constexpr (ALIGN_EPI) { if (wr == 0) PG8_BAR; }
        { const int l2_ = opq(lane_id()); E(acc, cur, wr, wc, l2_ & 15, l2_ >> 4); }
        if (!has_next) break;
#pragma unroll
        for (int a = 0; a < 2; ++a)
#pragma unroll
            for (int b = 0; b < 2; ++b)
#pragma unroll
                for (int m = 0; m < 4; ++m)
#pragma unroll
                    for (int n = 0; n < 2; ++n) acc[a][b][m][n] = (f32x4){0.f, 0.f, 0.f, 0.f};
        cur = nxt; cA = nA; cB = nB; ++ui;
        if constexpr (ALIGN_EPI) { if (wr == 1) PG8_BAR; }
    }
    PG8_WAIT_V(0);
    if constexpr (!ALIGN_EPI) { if (wr == 0) PG8_BAR; }
    PG8_BAR;
#undef PG8_SA
#undef PG8_SB
#undef PG8_STAGE_X
#undef PG8_STAGE_A
#undef PG8_STAGE_B
#undef PG8_LDA
#undef PG8_LDB
#undef PG8_MMA
#undef PG8_HALF
#undef PG8_WAIT_V
#undef PG8_WAIT_L
#undef PG8_BAR
#undef PG8_SCHED
}

template <int ACT> __device__ __forceinline__ float actf(float v) { if (ACT == 1) return v * sigm(v); if (ACT == 2) return sigm(v); return v; }
template <int ACT> __device__ __forceinline__ u32x4 pack8(f32x4 v0, f32x4 v1, float s) {
    u32x4 w; w.x = pk2(actf<ACT>(v0[0] * s), actf<ACT>(v0[1] * s)); w.y = pk2(actf<ACT>(v0[2] * s), actf<ACT>(v0[3] * s));
    w.z = pk2(actf<ACT>(v1[0] * s), actf<ACT>(v1[1] * s)); w.w = pk2(actf<ACT>(v1[2] * s), actf<ACT>(v1[3] * s)); return w;
}
struct EpiIn {
    bf16_t* PA; bf16_t* GT; const float* ssq; int mode; float oscale;
    template <int ACT> __device__ __forceinline__ void st(const f32x4 (&acc)[2][2][4][2], bf16_t* base, int ldc, int row0, int col0) const {
        float rs[2][4];
#pragma unroll
        for (int ai = 0; ai < 2; ++ai)
#pragma unroll
            for (int m = 0; m < 4; ++m) rs[ai][m] = ssq[row0 + ai * HALF + m * 16];
#pragma unroll
        for (int ai = 0; ai < 2; ++ai)
#pragma unroll
            for (int m = 0; m < 4; ++m) { const int row = row0 + ai * HALF + m * 16; const float r = rsqrtf(rs[ai][m] * (1.f / DM) + EPS) * oscale;
                bf16_t* rowp = base + (size_t)row * ldc + col0;
#pragma unroll
                for (int bj = 0; bj < 2; ++bj) *(u32x4*)(rowp + bj * HALF) = pack8<ACT>(acc[ai][bj][m][0], acc[ai][bj][m][1], r); }
    }
    __device__ __forceinline__ void operator()(const f32x4 (&acc)[2][2][4][2], const Unit& u, int wr, int wc, int fr, int fq) const {
        const int pn = (mode == 1) ? (u.pn < 18 ? u.pn + 8 : u.pn + 16) : (u.pn < 8 ? u.pn : u.pn + 18), row0 = u.pm * BM + wr * 64 + fr;
        if (pn >= 34) { st<2>(acc, GT, NG, row0, (pn - 34) * BM + wc * 32 + 8 * fq); }
        else { const int col0 = pn * BM + wc * 32 + 8 * fq;
            const bool silu = (pn >= 12 && pn < 16) || (pn >= 22 && pn < 26) || (pn >= 30);
            if (silu) st<1>(acc, PA, NA, row0, col0); else st<0>(acc, PA, NA, row0, col0); }
    }
};
struct EpiPlain {
    bf16_t* O; int ldc;
    __device__ __forceinline__ void operator()(const f32x4 (&acc)[2][2][4][2], const Unit& u, int wr, int wc, int fr, int fq) const {
        const int row0 = u.pm * BM + wr * 64 + fr, col0 = u.pn * BM + wc * 32 + 8 * fq;
#pragma unroll
        for (int ai = 0; ai < 2; ++ai)
#pragma unroll
            for (int m = 0; m < 4; ++m) { bf16_t* rowp = O + (size_t)(row0 + ai * HALF + m * 16) * ldc + col0;
#pragma unroll
                for (int bj = 0; bj < 2; ++bj) *(u32x4*)(rowp + bj * HALF) = pack8<0>(acc[ai][bj][m][0], acc[ai][bj][m][1], 1.f); }
    }
};
struct EpiMerge {
    const bf16_t* GT; bf16_t* MG; float oscale;
    __device__ __forceinline__ void operator()(const f32x4 (&acc)[2][2][4][2], const Unit& u, int wr, int wc, int fr, int fq) const {
        const int row0 = u.pm * BM + wr * 64 + fr, col0 = u.pn * BM + wc * 32 + 8 * fq, z = u.z;
#pragma unroll
        for (int ai = 0; ai < 2; ++ai)
#pragma unroll
            for (int bj = 0; bj < 2; ++bj) { const int col = col0 + bj * HALF;
                u32x4 gw[4], tw[4];
#pragma unroll
                for (int m = 0; m < 4; ++m) { const size_t row = (size_t)(row0 + ai * HALF + m * 16);
                    gw[m] = *(const u32x4*)(GT + row * NG + z * DM + col);
                    tw[m] = (z > 0) ? *(const u32x4*)(MG + row * DM + col) : (u32x4){0u, 0u, 0u, 0u}; }
#pragma unroll
                for (int m = 0; m < 4; ++m) { const size_t row = (size_t)(row0 + ai * HALF + m * 16);
                    const f32x4 a0 = acc[ai][bj][m][0] * oscale, a1 = acc[ai][bj][m][1] * oscale; u32x4 w;
                    w.x = pk2(a0[0] * bf_lo(gw[m].x) + bf_lo(tw[m].x), a0[1] * bf_hi(gw[m].x) + bf_hi(tw[m].x));
                    w.y = pk2(a0[2] * bf_lo(gw[m].y) + bf_lo(tw[m].y), a0[3] * bf_hi(gw[m].y) + bf_hi(tw[m].y));
                    w.z = pk2(a1[0] * bf_lo(gw[m].z) + bf_lo(tw[m].z), a1[1] * bf_hi(gw[m].z) + bf_hi(tw[m].z));
                    w.w = pk2(a1[2] * bf_lo(gw[m].w) + bf_lo(tw[m].w), a1[3] * bf_hi(gw[m].w) + bf_hi(tw[m].w));
                    *(u32x4*)(MG + row * DM + col) = w; } }
    }
};
struct EpiOut {
    const float* xin; float* X1; bf16_t* XB1; float* ssq;
    __device__ __forceinline__ void operator()(const f32x4 (&acc)[2][2][4][2], const Unit& u, int wr, int wc, int fr, int fq) const {
        const int row0 = u.pm * BM + wr * 64 + fr, col0 = u.pn * BM + wc * 32 + 8 * fq;
#pragma unroll
        for (int ai = 0; ai < 2; ++ai) { float s[4] = {0.f, 0.f, 0.f, 0.f};
#pragma unroll
            for (int bj = 0; bj < 2; ++bj) { f32x4 x0[4], x1[4];
#pragma unroll
                for (int m = 0; m < 4; ++m) { const size_t o = (size_t)(row0 + ai * HALF + m * 16) * DM + col0 + bj * HALF; x0[m] = *(const f32x4*)(xin + o); x1[m] = *(const f32x4*)(xin + o + 4); }
#pragma unroll
                for (int m = 0; m < 4; ++m) { const size_t o = (size_t)(row0 + ai * HALF + m * 16) * DM + col0 + bj * HALF;
                    const f32x4 v0 = x0[m] + acc[ai][bj][m][0], v1 = x1[m] + acc[ai][bj][m][1];
                    *(f32x4*)(X1 + o) = v0; *(f32x4*)(X1 + o + 4) = v1;
                    u32x4 w; w.x = pk2(v0[0], v0[1]); w.y = pk2(v0[2], v0[3]); w.z = pk2(v1[0], v1[1]); w.w = pk2(v1[2], v1[3]); *(u32x4*)(XB1 + o) = w;
                    s[m] += (v0[0] * v0[0] + v0[1] * v0[1]) + (v0[2] * v0[2] + v0[3] * v0[3]) + (v1[0] * v1[0] + v1[1] * v1[1]) + (v1[2] * v1[2] + v1[3] * v1[3]); } }
#pragma unroll
            for (int m = 0; m < 4; ++m) { float t = s[m]; t += __shfl_xor(t, 16); t += __shfl_xor(t, 32);
                if (fq == 0) atomicAdd(ssq + (row0 + ai * HALF + m * 16), t); } }
    }
};
struct EpiPle {
    const float* X1; const bf16_t* T; const float* ssq1; float* xout; bf16_t* XB; unsigned char* XB8; float* ssq2; bool wxb;
    __device__ __forceinline__ void operator()(const f32x4 (&acc)[2][2][4][2], const Unit& u, int wr, int wc, int fr, int fq) const {
        const int row0 = u.pm * BM + wr * 64 + fr, col0 = u.pn * BM + wc * 32 + 8 * fq;
        float rsv[2][4];
#pragma unroll
        for (int ai = 0; ai < 2; ++ai)
#pragma unroll
            for (int m = 0; m < 4; ++m) rsv[ai][m] = ssq1[row0 + ai * HALF + m * 16];
#pragma unroll
        for (int ai = 0; ai < 2; ++ai) { float s[4] = {0.f, 0.f, 0.f, 0.f};
#pragma unroll
            for (int bj = 0; bj < 2; ++bj)
#pragma unroll
              for (int mh = 0; mh < 2; ++mh) { f32x4 x0[2], x1[2]; u32x4 tw[2];
#pragma unroll
                for (int mm = 0; mm < 2; ++mm) { const int m = 2 * mh + mm; const size_t o = (size_t)(row0 + ai * HALF + m * 16) * DM + col0 + bj * HALF; x0[mm] = *(const f32x4*)(X1 + o); x1[mm] = *(const f32x4*)(X1 + o + 4); tw[mm] = *(const u32x4*)(T + o); }
#pragma unroll
                for (int mm = 0; mm < 2; ++mm) { const int m = 2 * mh + mm; const size_t o = (size_t)(row0 + ai * HALF + m * 16) * DM + col0 + bj * HALF;
                    const float rs = rsqrtf(rsv[ai][m] * (1.f / DM) + EPS);
                    const f32x4 a0 = acc[ai][bj][m][0], a1 = acc[ai][bj][m][1]; f32x4 v0 = x0[mm], v1 = x1[mm];
                    v0[0] += sigm(a0[0] * rs) * bf_lo(tw[mm].x); v0[1] += sigm(a0[1] * rs) * bf_hi(tw[mm].x); v0[2] += sigm(a0[2] * rs) * bf_lo(tw[mm].y); v0[3] += sigm(a0[3] * rs) * bf_hi(tw[mm].y);
                    v1[0] += sigm(a1[0] * rs) * bf_lo(tw[mm].z); v1[1] += sigm(a1[1] * rs) * bf_hi(tw[mm].z); v1[2] += sigm(a1[2] * rs) * bf_lo(tw[mm].w); v1[3] += sigm(a1[3] * rs) * bf_hi(tw[mm].w);
                    *(f32x4*)(xout + o) = v0; *(f32x4*)(xout + o + 4) = v1;
                    if (wxb) { u32x4 w; w.x = pk2(v0[0], v0[1]); w.y = pk2(v0[2], v0[3]); w.z = pk2(v1[0], v1[1]); w.w = pk2(v1[2], v1[3]); *(u32x4*)(XB + o) = w;
                        int q0 = 0, q1 = 0; q0 = __builtin_amdgcn_cvt_pk_fp8_f32(v0[0] * 8.f, v0[1] * 8.f, q0, false); q0 = __builtin_amdgcn_cvt_pk_fp8_f32(v0[2] * 8.f, v0[3] * 8.f, q0, true);
                        q1 = __builtin_amdgcn_cvt_pk_fp8_f32(v1[0] * 8.f, v1[1] * 8.f, q1, false); q1 = __builtin_amdgcn_cvt_pk_fp8_f32(v1[2] * 8.f, v1[3] * 8.f, q1, true);
                        *(u32x2*)(XB8 + o) = (u32x2){(unsigned)q0, (unsigned)q1}; }
                    s[m] += (v0[0] * v0[0] + v0[1] * v0[1]) + (v0[2] * v0[2] + v0[3] * v0[3]) + (v1[0] * v1[0] + v1[1] * v1[1]) + (v1[2] * v1[2] + v1[3] * v1[3]); } }
#pragma unroll
            for (int m = 0; m < 4; ++m) { float t = s[m]; t += __shfl_xor(t, 16); t += __shfl_xor(t, 32);
                if (fq == 0) atomicAdd(ssq2 + (row0 + ai * HALF + m * 16), t); } }
    }
};
}

template <bool F8> __device__ __forceinline__ void transpose_item(const float* W, int K, int N, int ld, void* WTv, const float* kscale, float wscale, LAS float* scr, int item, int lane_) {
    const int lane = opq(lane_);
    const int nblk = N / 64, kb = item / nblk, nb = item % nblk, k0 = 64 * kb, n0 = 64 * nb;
    float v[64];
#pragma unroll
    for (int kk = 0; kk < 64; ++kk) v[kk] = W[(size_t)(k0 + kk) * ld + n0 + lane];
#pragma unroll
    for (int kk = 0; kk < 64; ++kk) { const float sc = (kscale ? kscale[k0 + kk] : 1.f) * wscale; scr[kk * 65 + lane] = v[kk] * sc; }
    if constexpr (F8) {
        unsigned char* WT = (unsigned char*)WTv; const int c = lane & 3;
#pragma unroll
        for (int j = 0; j < 4; ++j) { const int n = (lane >> 2) + 16 * j; const LAS float* s = scr + (16 * c) * 65 + n; int q[4];
#pragma unroll
            for (int d = 0; d < 4; ++d) { int w = 0; w = __builtin_amdgcn_cvt_pk_fp8_f32(s[(4 * d) * 65], s[(4 * d + 1) * 65], w, false); w = __builtin_amdgcn_cvt_pk_fp8_f32(s[(4 * d + 2) * 65], s[(4 * d + 3) * 65], w, true); q[d] = w; }
            *(u32x4*)(WT + (size_t)(n0 + n) * K + k0 + 16 * c) = (u32x4){(unsigned)q[0], (unsigned)q[1], (unsigned)q[2], (unsigned)q[3]}; }
    } else {
        bf16_t* WT = (bf16_t*)WTv; const int c = lane & 7;
#pragma unroll
        for (int j = 0; j < 8; ++j) { const int n = (lane >> 3) + 8 * j; const LAS float* s = scr + (8 * c) * 65 + n;
            u32x4 o; o.x = pk2(s[0 * 65], s[1 * 65]); o.y = pk2(s[2 * 65], s[3 * 65]); o.z = pk2(s[4 * 65], s[5 * 65]); o.w = pk2(s[6 * 65], s[7 * 65]);
            *(u32x4*)(WT + (size_t)(n0 + n) * K + k0 + 8 * c) = o; }
    }
}
template <bool F8 = false> __device__ __forceinline__ void transpose_matrix(const float* W, int K, int N, int ld, void* WT, const float* kscale, float wscale, LAS float* scr, int gw, int NGW, int lane) {
    const int nitems = (K / 64) * (N / 64);
    for (int it = gw; it < nitems; it += NGW) transpose_item<F8>(W, K, N, ld, WT, kscale, wscale, scr, it, lane);
}

struct Args { const float* in[19]; float* out; unsigned char* ws; int ph_lo, ph_hi; };
typedef const __attribute__((address_space(4))) Args* KArgs;
struct Ptrs {
    __device__ __forceinline__ void reload(KArgs a) {
        x = a->in[0]; p = a->in[1]; rpe = a->in[2]; norm_g = a->in[3]; w_in = a->in[4]; sinks = a->in[5]; conv_w = a->in[6]; conv_b = a->in[7]; w_r = a->in[8]; b_r = a->in[9]; w_i = a->in[10];
        b_i = a->in[11]; lam = a->in[12]; w_br = a->in[13]; w_out = a->in[14]; ple_g = a->in[15]; w_pg = a->in[16]; w_pp = a->in[17]; fin_g = a->in[18]; out = a->out; ws = a->ws; }
    const float *x, *p, *rpe, *norm_g, *w_in, *sinks, *conv_w, *conv_b, *w_r, *b_r, *w_i, *b_i, *lam, *w_br, *w_out, *ple_g, *w_pg, *w_pp, *fin_g;
    float* out; unsigned char* ws; int wave;
#define WSP(NAME, TYPE, OFF) __device__ __forceinline__ TYPE* NAME() const { return (TYPE*)(ws + (OFF)); }
    WSP(WIN8, unsigned char, OFF_WIN8) WSP(WINB, bf16_t, OFF_WINB) WSP(XB8, unsigned char, OFF_XB8) WSP(WBR, bf16_t, OFF_WBR) WSP(WOUT, bf16_t, OFF_WOUT) WSP(WPG, bf16_t, OFF_WPG) WSP(WPP, bf16_t, OFF_WPP) WSP(WR, bf16_t, OFF_WR) WSP(WI, bf16_t, OFF_WI)
    WSP(XB, bf16_t, OFF_XB) WSP(VTA, bf16_t, OFF_VTA) WSP(VTB, bf16_t, OFF_VTB) WSP(PA, bf16_t, OFF_PA) WSP(MG, bf16_t, OFF_MG) WSP(XB1, bf16_t, OFF_XB1) WSP(GT, bf16_t, OFF_GT)
    WSP(Y8, unsigned char, OFF_Y8) WSP(YC, bf16_t, OFF_YC) WSP(WBR8, unsigned char, OFF_WBR8) WSP(T, bf16_t, OFF_T) WSP(HL, bf16_t, OFF_HL) WSP(CA, bf16_t, OFF_CA) WSP(PB, bf16_t, OFF_PB) WSP(KM, bf16_t, OFF_KM)
    WSP(X1, float, OFF_X1) WSP(SSQ, float, OFF_SSQ) WSP(CHA, float, OFF_CHA) WSP(CHH, float, OFF_CHH)
    WSP(SELCNT, unsigned, OFF_SELCNT) WSP(LIST, unsigned, OFF_LIST) WSP(PO, bf16_t, OFF_PO) WSP(ML, float, OFF_ML)
#undef WSP
};

__device__ __forceinline__ void kmean_item(LAS unsigned char* lds, const Ptrs& P, int it) {
    const int tid = opq((P.wave << 6) | lane_id()), b = it >> 7, h = (it >> 4) & 7, n = it & 15;
    const int rg = tid >> 4, c8 = tid & 15;
    float s0 = 0.f, s1 = 0.f, s2 = 0.f, s3 = 0.f, s4 = 0.f, s5 = 0.f, s6 = 0.f, s7 = 0.f;
#pragma unroll
    for (int i = 0; i < 8; ++i) { const int row = rg + 32 * i;
        const u32x4 w = *(const u32x4*)(P.PA() + (size_t)(b * SEQ + n * 256 + row) * NA + C_KA + h * 128 + c8 * 8);
        s0 += bf_lo(w.x); s1 += bf_hi(w.x); s2 += bf_lo(w.y); s3 += bf_hi(w.y); s4 += bf_lo(w.z); s5 += bf_hi(w.z); s6 += bf_lo(w.w); s7 += bf_hi(w.w); }
    LAS float* red = (LAS float*)lds;
    LAS float* rp = red + rg * 128 + c8 * 8;
    rp[0] = s0; rp[1] = s1; rp[2] = s2; rp[3] = s3; rp[4] = s4; rp[5] = s5; rp[6] = s6; rp[7] = s7;
    __syncthreads();
    if (tid < 128) { float s = 0.f;
#pragma unroll 8
        for (int r = 0; r < 32; ++r) s += red[r * 128 + tid];
        P.KM()[(size_t)it * 128 + tid] = (bf16_t)(pk2(s * (1.f / 256.f), 0.f) & 0xffffu); }
    __syncthreads();
}
__device__ __forceinline__ void vtrans_item(LAS unsigned char* scr, const Ptrs& P, int it, int lane_) {
    const int lane = opq(lane_);
    int b, tt, colbase; bf16_t* dst0;
    if (it < 4096) { b = it >> 10; const int r = it & 1023; tt = r >> 4; const int ct = r & 15; colbase = C_VA + ct * 64; dst0 = P.VTA() + ((size_t)(b * 1024 + ct * 64) * SEQ + tt * 64); }
    else { it -= 4096; b = it >> 8; const int r = it & 255; tt = r >> 2; const int ct = r & 3; colbase = C_VB + ct * 64; dst0 = P.VTB() + ((size_t)(b * 256 + ct * 64) * SEQ + tt * 64); }
#pragma unroll
    for (int i = 0; i < 8; ++i) { const int row = i * 8 + (lane >> 3), c8 = lane & 7;
        const u32x4 w = *(const u32x4*)(P.PA() + (size_t)(b * SEQ + tt * 64 + row) * NA + colbase + c8 * 8);
        *(LAS u32x4*)(scr + row * 144 + c8 * 16) = w; }
#pragma unroll
    for (int i = 0; i < 8; ++i) { const int c = (lane >> 3) + 8 * i, tg = lane & 7; unsigned e[8];
#pragma unroll
        for (int k = 0; k < 8; ++k) e[k] = *(const LAS unsigned short*)(scr + (tg * 8 + k) * 144 + c * 2);
        u32x4 o; o.x = e[0] | (e[1] << 16); o.y = e[2] | (e[3] << 16); o.z = e[4] | (e[5] << 16); o.w = e[6] | (e[7] << 16);
        *(u32x4*)(dst0 + (size_t)c * SEQ + tg * 8) = o; }
}
__device__ __forceinline__ void lru_local_phase(LAS unsigned char* lds, const Ptrs& P, int l, int bx, int G) {
    const int tid = opq((P.wave << 6) | lane_id()), lane = tid & 63, wid = __builtin_amdgcn_readfirstlane(tid >> 6);
    constexpr int NIT = BATCH * 64 * 8;
    u32x4 xw[4][2];
#define LRU_LOAD(itx) do { const int b_ = (itx) >> 9, c_ = ((itx) >> 3) & 63, n_ = (itx) & 7; \
        _Pragma("unroll") for (int w = 0; w < 4; ++w) { int tt_ = c_ * 64 + (tid >> 3) - 3 + w; tt_ = tt_ < 0 ? 0 : tt_; \
            const bf16_t* src_ = P.PA() + (size_t)(b_ * SEQ + tt_) * NA + C_XC + n_ * 128 + (tid & 7) * 16; \
            xw[w][0] = *(const u32x4*)src_; xw[w][1] = *(const u32x4*)(src_ + 8); } } while (0)
    if (bx < NIT) LRU_LOAD(bx);
    int n_cur = -1; bf16x8 br[4], bi[4]; float brv = 0.f, biv = 0.f, c8sp = 0.f; f32x4 cbv[4], cwv[4][4];
#pragma unroll 1
    for (int it = bx; it < NIT; it += G) {
    const int b = it >> 9, c = (it >> 3) & 63, n = it & 7, t0 = c * 64, ch0 = n * 128;
    const int col = lane & 15, quad = lane >> 4, d0 = 16 * wid, ch = ch0 + d0 + col;
    if (n != n_cur) {
        n_cur = n;
        const size_t wofs = ((size_t)(l * 8 + n) * 128 + d0 + col) * 128 + quad * 8;
#pragma unroll
        for (int ks = 0; ks < 4; ++ks) { br[ks] = *(const bf16x8*)(P.WR() + wofs + ks * 32); bi[ks] = *(const bf16x8*)(P.WI() + wofs + ks * 32); }
        brv = P.b_r[l * 1024 + ch]; biv = P.b_i[l * 1024 + ch]; c8sp = -8.f * log1pf(__expf(-P.lam[l * 1024 + ch]));
        const int chb_ = ch0 + (tid & 7) * 16;
#pragma unroll
        for (int q = 0; q < 4; ++q) cbv[q] = *(const f32x4*)(P.conv_b + l * 1024 + chb_ + 4 * q);
#pragma unroll
        for (int w = 0; w < 4; ++w)
#pragma unroll
            for (int q = 0; q < 4; ++q) cwv[w][q] = *(const f32x4*)(P.conv_w + (size_t)(l * 4 + w) * 1024 + chb_ + 4 * q);
    }
    LAS unsigned char* convb = lds;
    LAS float* convf = (LAS float*)(lds + 17408);
    LAS unsigned char* hlS = lds + 51200;
    LAS unsigned char* caS = lds + 68608;
    {
        const int t = tid >> 3, cg8 = tid & 7, chb = ch0 + cg8 * 16;
        float a[16];
#pragma unroll
        for (int q = 0; q < 4; ++q) { const f32x4 v = cbv[q]; a[4 * q] = v[0]; a[4 * q + 1] = v[1]; a[4 * q + 2] = v[2]; a[4 * q + 3] = v[3]; }
#pragma unroll
        for (int w = 0; w < 4; ++w) { const int tt = t0 + t - 3 + w; const float msk = tt >= 0 ? 1.f : 0.f;
#pragma unroll
            for (int hh = 0; hh < 2; ++hh) { const u32x4 xv = xw[w][hh]; const f32x4 w0 = cwv[w][2 * hh] * msk, w1 = cwv[w][2 * hh + 1] * msk;
                a[8 * hh + 0] += w0[0] * bf_lo(xv.x); a[8 * hh + 1] += w0[1] * bf_hi(xv.x); a[8 * hh + 2] += w0[2] * bf_lo(xv.y); a[8 * hh + 3] += w0[3] * bf_hi(xv.y);
                a[8 * hh + 4] += w1[0] * bf_lo(xv.z); a[8 * hh + 5] += w1[1] * bf_hi(xv.z); a[8 * hh + 6] += w1[2] * bf_lo(xv.w); a[8 * hh + 7] += w1[3] * bf_hi(xv.w); } }
#pragma unroll
        for (int q = 0; q < 4; ++q) *(LAS f32x4*)(convf + t * 132 + cg8 * 16 + 4 * q) = (f32x4){a[4 * q], a[4 * q + 1], a[4 * q + 2], a[4 * q + 3]};
#pragma unroll
        for (int hh = 0; hh < 2; ++hh) { u32x4 o; o.x = pk2(a[8 * hh], a[8 * hh + 1]); o.y = pk2(a[8 * hh + 2], a[8 * hh + 3]); o.z = pk2(a[8 * hh + 4], a[8 * hh + 5]); o.w = pk2(a[8 * hh + 6], a[8 * hh + 7]);
            *(LAS u32x4*)(convb + t * 272 + cg8 * 32 + hh * 16) = o; }
    }
    __syncthreads();
    if (it + G < NIT) LRU_LOAD(it + G);
    f32x4 accr[4], acci[4];
    {
#pragma unroll
        for (int m = 0; m < 4; ++m) { accr[m] = (f32x4){0.f, 0.f, 0.f, 0.f}; acci[m] = (f32x4){0.f, 0.f, 0.f, 0.f};
#pragma unroll
            for (int ks = 0; ks < 4; ++ks) { const bf16x8 av = *(const LAS bf16x8*)(convb + (m * 16 + col) * 272 + (ks * 32 + quad * 8) * 2);
                accr[m] = __builtin_amdgcn_mfma_f32_16x16x32_bf16(av, br[ks], accr[m], 0, 0, 0);
                acci[m] = __builtin_amdgcn_mfma_f32_16x16x32_bf16(av, bi[ks], acci[m], 0, 0, 0); } }
    }
    {
        float Ac = 1.f, Hc = 0.f;
#pragma unroll
        for (int m = 0; m < 4; ++m) {
            float hl[4], Pl[4]; float h = 0.f, Pp = 1.f;
#pragma unroll
            for (int jj = 0; jj < 4; ++jj) { const int tok = m * 16 + quad * 4 + jj;
                const float r = sigm(accr[m][jj] + brv), ig = sigm(acci[m][jj] + biv);
                const float la = c8sp * r, av = __expf(la);
                const float bm = __builtin_amdgcn_sqrtf(fmaxf(1.f - __expf(2.f * la), 0.f));
                const float bb = bm * ig * convf[tok * 132 + d0 + col];
                h = av * h + bb; Pp *= av; hl[jj] = h; Pl[jj] = Pp; }
            const float A0 = __shfl(Pp, col), A1 = __shfl(Pp, col + 16), A2 = __shfl(Pp, col + 32), A3 = __shfl(Pp, col + 48);
            const float H0 = __shfl(h, col), H1 = __shfl(h, col + 16), H2 = __shfl(h, col + 32), H3 = __shfl(h, col + 48);
            float Ain = 1.f, Hin = 0.f;
            if (quad > 0) { Hin = H0; Ain = A0; }
            if (quad > 1) { Hin = A1 * Hin + H1; Ain *= A1; }
            if (quad > 2) { Hin = A2 * Hin + H2; Ain *= A2; }
            const float At = A0 * A1 * A2 * A3, Ht = ((H0 * A1 + H1) * A2 + H2) * A3 + H3;
            const float Hstart = Ain * Hc + Hin, Pstart = Ac * Ain;
#pragma unroll
            for (int jj = 0; jj < 4; ++jj) { const int tok = m * 16 + quad * 4 + jj;
                *(LAS unsigned short*)(hlS + tok * 272 + (d0 + col) * 2) = (unsigned short)(pk2(Pl[jj] * Hstart + hl[jj], 0.f) & 0xffffu);
                *(LAS unsigned short*)(caS + tok * 272 + (d0 + col) * 2) = (unsigned short)(pk2(Pstart * Pl[jj], 0.f) & 0xffffu); }
            Hc = At * Hc + Ht; Ac *= At;
        }
        if (quad == 0) { P.CHA()[(size_t)(b * 64 + c) * 1024 + ch] = Ac; P.CHH()[(size_t)(b * 64 + c) * 1024 + ch] = Hc; }
    }
    __syncthreads();
    {
        const int t = tid >> 3, cg8 = tid & 7; const size_t o = (size_t)(b * SEQ + t0 + t) * 1024 + ch0 + cg8 * 16;
#pragma unroll
        for (int hh = 0; hh < 2; ++hh) { *(u32x4*)(P.HL() + o + 8 * hh) = *(const LAS u32x4*)(hlS + t * 272 + cg8 * 32 + hh * 16); *(u32x4*)(P.CA() + o + 8 * hh) = *(const LAS u32x4*)(caS + t * 272 + cg8 * 32 + hh * 16); }
    }
    }
#undef LRU_LOAD
}

__device__ __forceinline__ void lru_fix_item(const Ptrs& P, int it) {
    const int tid = opq((P.wave << 6) | lane_id()), b = it >> 6, c = it & 63, tg = tid >> 7, c8 = tid & 127;
    f32x4 H0 = {0.f, 0.f, 0.f, 0.f}, H1 = {0.f, 0.f, 0.f, 0.f};
    int cc = 0;
#pragma unroll 1
    for (; cc + 8 <= c; cc += 8) {
        f32x4 a0[8], a1[8], h0[8], h1[8];
#pragma unroll
        for (int u = 0; u < 8; ++u) { const size_t o = (size_t)(b * 64 + cc + u) * 1024 + c8 * 8;
            a0[u] = *(const f32x4*)(P.CHA() + o); a1[u] = *(const f32x4*)(P.CHA() + o + 4); h0[u] = *(const f32x4*)(P.CHH() + o); h1[u] = *(const f32x4*)(P.CHH() + o + 4); }
#pragma unroll
        for (int u = 0; u < 8; ++u) { H0 = a0[u] * H0 + h0[u]; H1 = a1[u] * H1 + h1[u]; }
    }
    for (; cc < c; ++cc) { const size_t o = (size_t)(b * 64 + cc) * 1024 + c8 * 8;
        const f32x4 a0 = *(const f32x4*)(P.CHA() + o), a1 = *(const f32x4*)(P.CHA() + o + 4), h0 = *(const f32x4*)(P.CHH() + o), h1 = *(const f32x4*)(P.CHH() + o + 4);
        H0 = a0 * H0 + h0; H1 = a1 * H1 + h1; }
#pragma unroll 4
    for (int k = 0; k < 16; ++k) { const size_t row = (size_t)(b * SEQ + c * 64 + tg + 4 * k);
        const u32x4 hw = *(const u32x4*)(P.HL() + row * 1024 + c8 * 8), cw = *(const u32x4*)(P.CA() + row * 1024 + c8 * 8), gw = *(const u32x4*)(P.PA() + row * NA + C_GC + c8 * 8);
        u32x4 o;
        o.x = pk2((bf_lo(hw.x) + bf_lo(cw.x) * H0[0]) * bf_lo(gw.x), (bf_hi(hw.x) + bf_hi(cw.x) * H0[1]) * bf_hi(gw.x));
        o.y = pk2((bf_lo(hw.y) + bf_lo(cw.y) * H0[2]) * bf_lo(gw.y), (bf_hi(hw.y) + bf_hi(cw.y) * H0[3]) * bf_hi(gw.y));
        o.z = pk2((bf_lo(hw.z) + bf_lo(cw.z) * H1[0]) * bf_lo(gw.z), (bf_hi(hw.z) + bf_hi(cw.z) * H1[1]) * bf_hi(gw.z));
        o.w = pk2((bf_lo(hw.w) + bf_lo(cw.w) * H1[2]) * bf_lo(gw.w), (bf_hi(hw.w) + bf_hi(cw.w) * H1[3]) * bf_hi(gw.w));
        *(u32x4*)(P.YC() + row * 1024 + c8 * 8) = o; }
}

#define SOFTMAX_TILE(p0, p1, m, l, NO, o, pw) do { \
    float rm_ = fmaxf(p0[0], p1[0]); \
    _Pragma("unroll") for (int r = 1; r < 16; ++r) rm_ = fmaxf(rm_, fmaxf(p0[r], p1[r])); \
    rm_ = fmaxf(rm_, __shfl_xor(rm_, 32)); \
    if (__ballot(rm_ > m + 8.f) != 0ull) {        \
        const float mn_ = fmaxf(m, rm_); const float al_ = __builtin_amdgcn_exp2f(m - mn_); m = mn_; l *= al_; \
        _Pragma("unroll") for (int d_ = 0; d_ < NO; ++d_) o[d_] *= al_; } \
    float ps_ = 0.f; \
    _Pragma("unroll") for (int r = 0; r < 16; ++r) { p0[r] = __builtin_amdgcn_exp2f(p0[r] - m); p1[r] = __builtin_amdgcn_exp2f(p1[r] - m); ps_ += p0[r] + p1[r]; } \
    l += ps_; \
    pw[0] = (u32x4){pk2(p0[0], p0[1]), pk2(p0[2], p0[3]), pk2(p0[4], p0[5]), pk2(p0[6], p0[7])}; \
    pw[1] = (u32x4){pk2(p0[8], p0[9]), pk2(p0[10], p0[11]), pk2(p0[12], p0[13]), pk2(p0[14], p0[15])}; \
    pw[2] = (u32x4){pk2(p1[0], p1[1]), pk2(p1[2], p1[3]), pk2(p1[4], p1[5]), pk2(p1[6], p1[7])}; \
    pw[3] = (u32x4){pk2(p1[8], p1[9]), pk2(p1[10], p1[11]), pk2(p1[12], p1[13]), pk2(p1[14], p1[15])}; } while (0)

__device__ __forceinline__ void moba_load_q(bf16x8 (&qr)[8], const Ptrs& P, size_t qrow, int h, int hi) {
#pragma unroll
    for (int ks = 0; ks < 8; ++ks) qr[ks] = *(const bf16x8*)(P.PA() + qrow * NA + C_QA + h * 128 + ks * 16 + hi * 8);
}
__device__ __forceinline__ void moba_list_item(const Ptrs& P, int bh, int j) {
    const int tid = opq((P.wave << 6) | lane_id()), lane = tid & 63, wid = __builtin_amdgcn_readfirstlane(tid >> 6), r32 = lane & 31, hi = lane >> 5;
    const int b = bh >> 3, h = bh & 7, t = j * 256 + 32 * wid + r32;
    bf16x8 qr[8]; moba_load_q(qr, P, (size_t)(b * SEQ + t), h, hi);
    f32x16 ga = {};
#pragma unroll
    for (int ks = 0; ks < 8; ++ks) { const bf16x8 kf = *(const bf16x8*)(P.KM() + ((size_t)(bh * 16 + (r32 & 15))) * 128 + ks * 16 + hi * 8);
        ga = __builtin_amdgcn_mfma_f32_32x32x16_bf16(kf, qr[ks], ga, 0, 0, 0); }
    float g[16];
#pragma unroll
    for (int e = 0; e < 8; ++e) { const float mine = ga[e], oth = __shfl_xor(mine, 32);
        const float lo = hi ? oth : mine, hh = hi ? mine : oth;
        g[(e & 3) + 8 * (e >> 2)] = lo; g[4 + (e & 3) + 8 * (e >> 2)] = hh; }
    const float NI = -3.0e38f;
    unsigned sel = 0u;
#pragma unroll
    for (int pass = 0; pass < 3; ++pass) { float best = NI; int bi = -1;
#pragma unroll
        for (int n = 0; n < 16; ++n) { const bool ok = (n < j) && (((sel >> n) & 1u) == 0u) && (g[n] > best); best = ok ? g[n] : best; bi = ok ? n : bi; }
        if (bi >= 0) sel |= 1u << bi; }
    for (int n = 0; n < j; ++n) {
        const bool sb = (((sel >> n) & 1u) != 0u) && (hi == 0);
        const unsigned long long mk = __ballot(sb);
        if (mk != 0ull) {
            unsigned base = 0u;
            if (lane == 0) base = atomicAdd(P.SELCNT() + bh * 16 + n, (unsigned)__popcll(mk));
            base = (unsigned)__builtin_amdgcn_readfirstlane((int)base);
            if (sb) { const unsigned pos = base + (unsigned)__popcll(mk & ((1ull << lane) - 1ull)); const unsigned k = (unsigned)__popc(sel & ((1u << n) - 1u));
                if (pos < 4096u) P.LIST()[(size_t)(bh * 16 + n) * 4096 + pos] = (unsigned)t | (k << 12); }
        }
    }
}
__device__ __forceinline__ void moba_kv_item(LAS unsigned char* lds, const Ptrs& P, int bh, int n, int part, bool split) {
    const int tid = opq((P.wave << 6) | lane_id()), lane = tid & 63, wid = __builtin_amdgcn_readfirstlane(tid >> 6), r32 = lane & 31, hi = lane >> 5;
    const int b = bh >> 3, h = bh & 7;
    const float SC = 0.08838834764831845f * LOG2E;
    LAS unsigned char* kb = lds; LAS unsigned char* vb = lds + 69632; LAS float* lut = (LAS float*)(lds + 136192);
    if (tid < 129) lut[tid] = P.rpe[t5_bucket(tid) * 24 + h] * LOG2E;
    const float cbias = P.rpe[31 * 24 + h] * LOG2E;
    {   const int kr = tid >> 4, kc8 = tid & 15, vd = tid >> 5, vk8 = tid & 31;
        u32x4 rg[8], rv[8];
#pragma unroll
        for (int i = 0; i < 8; ++i) rg[i] = *(const u32x4*)(P.PA() + (size_t)(b * SEQ + n * 256 + kr + 32 * i) * NA + C_KA + h * 128 + kc8 * 8);
#pragma unroll
        for (int i = 0; i < 8; ++i) rv[i] = *(const u32x4*)(P.VTA() + ((size_t)(bh * 128 + vd + 16 * i)) * SEQ + n * 256 + vk8 * 8);
#pragma unroll
        for (int i = 0; i < 8; ++i) *(LAS u32x4*)(kb + (kr + 32 * i) * 272 + kc8 * 16) = rg[i];
#pragma unroll
        for (int i = 0; i < 8; ++i) { *(LAS u32x2*)(vb + (vd + 16 * i) * 520 + vk8 * 16) = (u32x2){rv[i].x, rv[i].y}; *(LAS u32x2*)(vb + (vd + 16 * i) * 520 + vk8 * 16 + 8) = (u32x2){rv[i].z, rv[i].w}; }
    }
    int cnt = (int)P.SELCNT()[bh * 16 + n]; cnt = cnt < 4096 ? cnt : 4096; cnt = __builtin_amdgcn_readfirstlane(cnt);
    int beg = 0, end = cnt;
    if (split) { int half = ((cnt >> 1) + 31) & ~31; half = half < cnt ? half : cnt; if (part == 0) end = half; else beg = half; }
    __syncthreads();
    const int ntile = (end - beg + 31) >> 5;
    const unsigned* list = P.LIST() + (size_t)(bh * 16 + n) * 4096;
    bf16x8 qn[8]; unsigned en = 0u; bool vn = false;
    if (wid < ntile) { const int idx = beg + wid * 32 + r32; vn = idx < end; en = list[vn ? idx : beg]; moba_load_q(qn, P, (size_t)(b * SEQ + (int)(en & 4095u)), h, hi); }
#pragma unroll 1
    for (int qt = wid; qt < ntile; qt += 8) {
        const bool valid = vn; const unsigned e = en;
        const int t = (int)(e & 4095u), k = (int)(e >> 12);
        bf16x8 qr[8];
#pragma unroll
        for (int ks = 0; ks < 8; ++ks) qr[ks] = qn[ks];
        if (qt + 8 < ntile) { const int idx = beg + (qt + 8) * 32 + r32; vn = idx < end; en = list[vn ? idx : beg]; moba_load_q(qn, P, (size_t)(b * SEQ + (int)(en & 4095u)), h, hi); }
        float m = NEGF, l = 0.f; f32x16 o[4]; o[0] = f32x16{}; o[1] = f32x16{}; o[2] = f32x16{}; o[3] = f32x16{};
        const bool allfar = (__ballot(t < n * 256 + 383) == 0ull);
#pragma unroll 1
        for (int kvt = 0; kvt < 4; ++kvt) {
            f32x16 p0 = {}, p1 = {};
__builtin_amdgcn_s_setprio(1);
#pragma unroll
            for (int ks = 0; ks < 8; ++ks) { const bf16x8 k0 = *(const LAS bf16x8*)(kb + (kvt * 64 + r32) * 272 + ks * 32 + hi * 16), k1 = *(const LAS bf16x8*)(kb + (kvt * 64 + 32 + r32) * 272 + ks * 32 + hi * 16);
                p0 = __builtin_amdgcn_mfma_f32_32x32x16_bf16(k0, qr[ks], p0, 0, 0, 0); p1 = __builtin_amdgcn_mfma_f32_32x32x16_bf16(k1, qr[ks], p1, 0, 0, 0); }
__builtin_amdgcn_s_setprio(0);
            if (allfar) {
#pragma unroll
                for (int r = 0; r < 16; ++r) { p0[r] = p0[r] * SC + cbias; p1[r] = p1[r] * SC + cbias; }
            } else {
                const int dbase = t - n * 256 - 64 * kvt;
#pragma unroll
                for (int g4 = 0; g4 < 4; ++g4) {
#pragma unroll
                    for (int e4 = 0; e4 < 4; ++e4) { const int r = 4 * g4 + e4; const int d0 = dbase - crow(r, hi), d1 = d0 - 32;
                        p0[r] = p0[r] * SC + lut[min(max(d0, 0), 128)]; p1[r] = p1[r] * SC + lut[min(max(d1, 0), 128)]; }
                    __builtin_amdgcn_sched_barrier(0);
                }
            }
            u32x4 pw[4];
            SOFTMAX_TILE(p0, p1, m, l, 4, o, pw);
__builtin_amdgcn_s_setprio(1);
#pragma unroll
            for (int sl = 0; sl < 4; ++sl)
#pragma unroll
                for (int dt = 0; dt < 4; ++dt) { const LAS unsigned char* vp = vb + (dt * 32 + r32) * 520 + (kvt * 64 + 16 * sl + 4 * hi) * 2;
                    const u32x2 lo = *(const LAS u32x2*)vp, hh = *(const LAS u32x2*)(vp + 16);
                    const u32x4 vf = {lo.x, lo.y, hh.x, hh.y};
                    o[dt] = __builtin_amdgcn_mfma_f32_32x32x16_bf16(__builtin_bit_cast(bf16x8, vf), __builtin_bit_cast(bf16x8, pw[sl]), o[dt], 0, 0, 0); }
__builtin_amdgcn_s_setprio(0);
        }
        const float lt = l + __shfl_xor(l, 32); const float inv = __builtin_amdgcn_rcpf(lt);
        if (valid) {
            const size_t slot = ((size_t)bh * SEQ + t) * 3 + k;
            if (hi == 0) *(f32x2*)(P.ML() + slot * 2) = (f32x2){m, lt};
            bf16_t* po = P.PO() + slot * 128;
#pragma unroll
            for (int dt = 0; dt < 4; ++dt)
#pragma unroll
                for (int g4 = 0; g4 < 4; ++g4) { const int d = 32 * dt + 8 * g4 + 4 * hi;
                    *(u32x2*)(po + d) = (u32x2){pk2(o[dt][4 * g4] * inv, o[dt][4 * g4 + 1] * inv), pk2(o[dt][4 * g4 + 2] * inv, o[dt][4 * g4 + 3] * inv)}; }
        }
    }
    __syncthreads();
}
__device__ __forceinline__ void moba_own_item(LAS unsigned char* lds, const Ptrs& P, int b, int h, int j) {
    const int tid = opq((P.wave << 6) | lane_id()), lane = tid & 63, wid = __builtin_amdgcn_readfirstlane(tid >> 6), r32 = lane & 31, hi = lane >> 5;
    const float SC = 0.08838834764831845f * LOG2E;
    LAS unsigned char* kb = lds; LAS unsigned char* vb = lds + 69632; LAS float* lut = (LAS float*)(lds + 136192);
    if (tid < 129) lut[tid] = P.rpe[t5_bucket(tid) * 24 + h] * LOG2E;
    const int bh = b * 8 + h;
    const int q_local = 32 * wid + r32, t = j * 256 + q_local; const size_t qrow = (size_t)(b * SEQ + t);
    bf16x8 qr[8]; moba_load_q(qr, P, qrow, h, hi);
    {   const int kr = tid >> 4, kc8 = tid & 15, vd = tid >> 5, vk8 = tid & 31;
        u32x4 rg[8], rv[8];
#pragma unroll
        for (int i = 0; i < 8; ++i) rg[i] = *(const u32x4*)(P.PA() + (size_t)(b * SEQ + j * 256 + kr + 32 * i) * NA + C_KA + h * 128 + kc8 * 8);
#pragma unroll
        for (int i = 0; i < 8; ++i) rv[i] = *(const u32x4*)(P.VTA() + ((size_t)(bh * 128 + vd + 16 * i)) * SEQ + j * 256 + vk8 * 8);
#pragma unroll
        for (int i = 0; i < 8; ++i) *(LAS u32x4*)(kb + (kr + 32 * i) * 272 + kc8 * 16) = rg[i];
#pragma unroll
        for (int i = 0; i < 8; ++i) { *(LAS u32x2*)(vb + (vd + 16 * i) * 520 + vk8 * 16) = (u32x2){rv[i].x, rv[i].y}; *(LAS u32x2*)(vb + (vd + 16 * i) * 520 + vk8 * 16 + 8) = (u32x2){rv[i].z, rv[i].w}; }
    }
    const int nsel = j < 3 ? j : 3;
    const size_t slot0 = ((size_t)bh * SEQ + t) * 3;
    float mk[3], lk[3];
#pragma unroll
    for (int k = 0; k < 3; ++k) { mk[k] = NEGF; lk[k] = 0.f;
        if (k < nsel) { const f32x2 v = *(const f32x2*)(P.ML() + (slot0 + k) * 2); mk[k] = v[0]; lk[k] = v[1]; } }
    __syncthreads();
    float m = NEGF, l = 0.f; f32x16 o[4]; o[0] = f32x16{}; o[1] = f32x16{}; o[2] = f32x16{}; o[3] = f32x16{};
    const int ntt = ((32 * wid + 31) >> 6) + 1;
#pragma unroll 1
    for (int tt = 0; tt < ntt; ++tt) {
        f32x16 p0 = {}, p1 = {};
__builtin_amdgcn_s_setprio(1);
#pragma unroll
        for (int ks = 0; ks < 8; ++ks) { const bf16x8 k0 = *(const LAS bf16x8*)(kb + (tt * 64 + r32) * 272 + ks * 32 + hi * 16), k1 = *(const LAS bf16x8*)(kb + (tt * 64 + 32 + r32) * 272 + ks * 32 + hi * 16);
            p0 = __builtin_amdgcn_mfma_f32_32x32x16_bf16(k0, qr[ks], p0, 0, 0, 0); p1 = __builtin_amdgcn_mfma_f32_32x32x16_bf16(k1, qr[ks], p1, 0, 0, 0); }
__builtin_amdgcn_s_setprio(0);
        const int dbase = q_local - 64 * tt;
#pragma unroll
        for (int g4 = 0; g4 < 4; ++g4) {
#pragma unroll
            for (int e4 = 0; e4 < 4; ++e4) { const int r = 4 * g4 + e4; const int d0 = dbase - crow(r, hi), d1 = d0 - 32;
                const float b0 = lut[min(max(d0, 0), 128)], b1 = lut[min(max(d1, 0), 128)];
                p0[r] = (d0 >= 0) ? p0[r] * SC + b0 : NEGF; p1[r] = (d1 >= 0) ? p1[r] * SC + b1 : NEGF; }
            __builtin_amdgcn_sched_barrier(0);
        }
        u32x4 pw[4];
        SOFTMAX_TILE(p0, p1, m, l, 4, o, pw);
__builtin_amdgcn_s_setprio(1);
#pragma unroll
        for (int sl = 0; sl < 4; ++sl)
#pragma unroll
            for (int dt = 0; dt < 4; ++dt) { const LAS unsigned char* vp = vb + (dt * 32 + r32) * 520 + (tt * 64 + 16 * sl + 4 * hi) * 2;
                const u32x2 lo = *(const LAS u32x2*)vp, hh = *(const LAS u32x2*)(vp + 16);
                const u32x4 vf = {lo.x, lo.y, hh.x, hh.y};
                o[dt] = __builtin_amdgcn_mfma_f32_32x32x16_bf16(__builtin_bit_cast(bf16x8, vf), __builtin_bit_cast(bf16x8, pw[sl]), o[dt], 0, 0, 0); }
__builtin_amdgcn_s_setprio(0);
    }
    float lown = l + __shfl_xor(l, 32);
    float Mx = m;
#pragma unroll
    for (int k = 0; k < 3; ++k) if (k < nsel) Mx = fmaxf(Mx, mk[k]);
    const float wo = __builtin_amdgcn_exp2f(m - Mx); float L = lown * wo;
#pragma unroll
    for (int dt = 0; dt < 4; ++dt) o[dt] *= wo;
#pragma unroll
    for (int k = 0; k < 3; ++k) if (k < nsel) { const float wk = lk[k] * __builtin_amdgcn_exp2f(mk[k] - Mx); L += wk;
        const bf16_t* po = P.PO() + (slot0 + k) * 128;
#pragma unroll
        for (int dt = 0; dt < 4; ++dt)
#pragma unroll
            for (int g4 = 0; g4 < 4; ++g4) { const u32x2 w = *(const u32x2*)(po + 32 * dt + 8 * g4 + 4 * hi);
                o[dt][4 * g4] += wk * bf_lo(w.x); o[dt][4 * g4 + 1] += wk * bf_hi(w.x); o[dt][4 * g4 + 2] += wk * bf_lo(w.y); o[dt][4 * g4 + 3] += wk * bf_hi(w.y); } }
    const float inv = __builtin_amdgcn_rcpf(L);
#pragma unroll
    for (int dt = 0; dt < 4; ++dt)
#pragma unroll
        for (int g4 = 0; g4 < 4; ++g4) { const int d = 32 * dt + 8 * g4 + 4 * hi;
            const u32x2 gw = *(const u32x2*)(P.PA() + qrow * NA + C_GA + h * 128 + d);
            const float i64 = inv * 16.f; int w8 = 0;
            w8 = __builtin_amdgcn_cvt_pk_fp8_f32(o[dt][4 * g4] * i64 * bf_lo(gw.x), o[dt][4 * g4 + 1] * i64 * bf_hi(gw.x), w8, false); w8 = __builtin_amdgcn_cvt_pk_fp8_f32(o[dt][4 * g4 + 2] * i64 * bf_lo(gw.y), o[dt][4 * g4 + 3] * i64 * bf_hi(gw.y), w8, true);
            *(unsigned*)(P.Y8() + qrow * 2048 + h * 128 + d) = (unsigned)w8; }
    __syncthreads();
}
__device__ const unsigned char MOBA_SCHED[8][3] = {{0 + 32, 9, 255}, {0 + 16 + 32, 10, 13}, {4, 11, 12}, {1 + 32, 8, 14}, {1 + 16 + 32, 7, 255}, {5, 3 + 32, 255}, {2 + 32, 6, 255}, {2 + 16 + 32, 3 + 16 + 32, 255}};

__device__ __forceinline__ void swa_item(LAS unsigned char* lds, const Ptrs& P, int l, int b, int hk, int qblk) {
    const int tid = opq((P.wave << 6) | lane_id()), lane = tid & 63, wid = __builtin_amdgcn_readfirstlane(tid >> 6), r32 = lane & 31, hi = lane >> 5;
    const float SC = 0.125f * LOG2E;
    LAS unsigned char* kb = lds; LAS unsigned char* vb = lds + 36864; LAS float* lut = (LAS float*)(lds + 70144);
    const int kvbase = qblk * 128 - 128;
#pragma unroll
    for (int i = 0; i < 4; ++i) { const int r = (tid >> 3) + 64 * i, c8 = tid & 7, kv = kvbase + r;
        u32x4 w = {0u, 0u, 0u, 0u};
        if (kv >= 0) w = *(const u32x4*)(P.PA() + (size_t)(b * SEQ + kv) * NA + C_KB + hk * 64 + c8 * 8);
        *(LAS u32x4*)(kb + r * 144 + c8 * 16) = w; }
#pragma unroll
    for (int i = 0; i < 4; ++i) { const int d = (tid >> 5) + 16 * i, k8 = tid & 31, kv = kvbase + k8 * 8;
        u32x4 w = {0u, 0u, 0u, 0u};
        if (kv >= 0) w = *(const u32x4*)(P.VTB() + ((size_t)((b * 4 + hk) * 64 + d)) * SEQ + kv);
        *(LAS u32x2*)(vb + d * 520 + k8 * 16) = (u32x2){w.x, w.y}; *(LAS u32x2*)(vb + d * 520 + k8 * 16 + 8) = (u32x2){w.z, w.w}; }
    { const int g = tid >> 7, dist = tid & 127; lut[tid] = P.rpe[t5_bucket(dist) * 24 + 8 + hk * 4 + g] * LOG2E; }
    const int g = wid >> 1, hq = hk * 4 + g;
    const float sink2 = P.sinks[l * 16 + hq] * LOG2E;
    bf16x8 qrs[2][4];
#pragma unroll
    for (int qs = 0; qs < 2; ++qs)
#pragma unroll
        for (int ks = 0; ks < 4; ++ks) qrs[qs][ks] = *(const bf16x8*)(P.PA() + (size_t)(b * SEQ + qblk * 128 + 32 * (2 * (wid & 1) + qs) + r32) * NA + C_QB + hq * 64 + ks * 16 + hi * 8);
    __syncthreads();
#pragma unroll
    for (int qs = 0; qs < 2; ++qs) {
        const int qq = 2 * (wid & 1) + qs, q_local = 32 * qq + r32; const size_t qrow = (size_t)(b * SEQ + qblk * 128 + q_local);
        bf16x8 qr[4];
#pragma unroll
        for (int ks = 0; ks < 4; ++ks) qr[ks] = qrs[qs][ks];
        float m = NEGF, lsum = 0.f; f32x16 o[2]; o[0] = f32x16{}; o[1] = f32x16{};
        const int tk_hi = (32 * qq + 159) >> 6, tk_lo = (32 * qq + 1) >> 6;
#pragma unroll 1
        for (int tk = tk_hi; tk >= tk_lo; --tk) {
            f32x16 p0 = {}, p1 = {};
__builtin_amdgcn_s_setprio(1);
#pragma unroll
            for (int ks = 0; ks < 4; ++ks) { const bf16x8 k0 = *(const LAS bf16x8*)(kb + (tk * 64 + r32) * 144 + ks * 32 + hi * 16), k1 = *(const LAS bf16x8*)(kb + (tk * 64 + 32 + r32) * 144 + ks * 32 + hi * 16);
                p0 = __builtin_amdgcn_mfma_f32_32x32x16_bf16(k0, qr[ks], p0, 0, 0, 0); p1 = __builtin_amdgcn_mfma_f32_32x32x16_bf16(k1, qr[ks], p1, 0, 0, 0); }
__builtin_amdgcn_s_setprio(0);
            const int dbase = 128 + q_local - tk * 64;
#pragma unroll
            for (int r = 0; r < 16; ++r) { const int d0 = dbase - crow(r, hi), d1 = d0 - 32;
                const int rb0 = tk * 64 + crow(r, hi), rb1 = rb0 + 32;
                const bool v0 = (d0 >= 0) && (d0 < 128) && (qblk > 0 || rb0 >= 128), v1 = (d1 >= 0) && (d1 < 128) && (qblk > 0 || rb1 >= 128);
                const float b0 = lut[g * 128 + (d0 & 127)], b1 = lut[g * 128 + (d1 & 127)];
                p0[r] = v0 ? p0[r] * SC + b0 : NEGF; p1[r] = v1 ? p1[r] * SC + b1 : NEGF; }
            u32x4 pw[4];
            SOFTMAX_TILE(p0, p1, m, lsum, 2, o, pw);
__builtin_amdgcn_s_setprio(1);
#pragma unroll
            for (int dt = 0; dt < 2; ++dt)
#pragma unroll
                for (int s = 0; s < 4; ++s) { const LAS unsigned char* vp = vb + (dt * 32 + r32) * 520 + (tk * 64 + 16 * s + 4 * hi) * 2;
                    const u32x2 lo = *(const LAS u32x2*)vp, hh = *(const LAS u32x2*)(vp + 16);
                    const u32x4 vf = {lo.x, lo.y, hh.x, hh.y};
                    o[dt] = __builtin_amdgcn_mfma_f32_32x32x16_bf16(__builtin_bit_cast(bf16x8, vf), __builtin_bit_cast(bf16x8, pw[s]), o[dt], 0, 0, 0); }
__builtin_amdgcn_s_setprio(0);
        }
        const float lt = lsum + __shfl_xor(lsum, 32) + __builtin_amdgcn_exp2f(sink2 - m); const float inv = __builtin_amdgcn_rcpf(lt);
#pragma unroll
        for (int dt = 0; dt < 2; ++dt)
#pragma unroll
            for (int g4 = 0; g4 < 4; ++g4) { const int d = 32 * dt + 8 * g4 + 4 * hi;
                const u32x2 gw = *(const u32x2*)(P.PA() + qrow * NA + C_GB + hq * 64 + d);
                const float i64 = inv * 16.f; int w8 = 0;
                w8 = __builtin_amdgcn_cvt_pk_fp8_f32(o[dt][4 * g4] * i64 * bf_lo(gw.x), o[dt][4 * g4 + 1] * i64 * bf_hi(gw.x), w8, false); w8 = __builtin_amdgcn_cvt_pk_fp8_f32(o[dt][4 * g4 + 2] * i64 * bf_lo(gw.y), o[dt][4 * g4 + 3] * i64 * bf_hi(gw.y), w8, true);
                *(unsigned*)(P.Y8() + qrow * 2048 + 1024 + hq * 64 + d) = (unsigned)w8; }
    }
    __syncthreads();
}

#define XB_TMO      128
#define XB_XCNT(j)  (256  + 64 * (j))
#define XB_XSUB(j)  (1280 + 64 * (j))
#define XB_XGEN(j)  (2304 + 64 * (j))
#define XB_TOP      3328
#define XB_TOPGEN   3392
#define XCD_BAR_WORDS 3456
#define XB_SPIN_CAP (1u << 18)

__device__ __forceinline__ unsigned xb_ld(unsigned* p)              { return __hip_atomic_load(p, __ATOMIC_RELAXED, __HIP_MEMORY_SCOPE_AGENT); }
__device__ __forceinline__ unsigned xb_add(unsigned* p, unsigned v) { return __hip_atomic_fetch_add(p, v, __ATOMIC_RELAXED, __HIP_MEMORY_SCOPE_AGENT); }
__device__ __forceinline__ unsigned xb_xcc_id() { return (unsigned)__builtin_amdgcn_s_getreg((3 << 11) | 20) & 0xFu; }
#define XB_SPIN(cond, bar) do { unsigned _sp = 0; while (cond) { __builtin_amdgcn_s_sleep(1); \
    if ((++_sp & 255u) == 0u) { if (xb_ld(&(bar)[XB_TMO])) break; if (_sp > XB_SPIN_CAP) { atomicAdd(&(bar)[XB_TMO], 1u); break; } } } } while (0)

struct XcdBarrier {
    unsigned* bar; unsigned x; int wave;
    volatile LAS unsigned* st;
};

__device__ __forceinline__ XcdBarrier xcd_barrier_post(unsigned* bar, volatile LAS unsigned* st, int wave) {
    XcdBarrier b; b.bar = bar; b.x = xb_xcc_id(); b.st = st; b.wave = wave;
    if (wave == 0 && lane_id() == 0) (void)xb_add(&bar[XB_XCNT(b.x)], 1u);
    return b;
}
__device__ __forceinline__ void xcd_barrier_complete(unsigned* bar, unsigned x, unsigned& nloc, unsigned& nx) {
    const unsigned G = gridDim.x * gridDim.y * gridDim.z;
    unsigned sum, cnt, mine, sp = 0u;
    for (;;) {
        sum = 0u; cnt = 0u; mine = 0u;
#pragma unroll
        for (unsigned j = 0; j < 16; ++j) { const unsigned c = xb_ld(&bar[XB_XCNT(j)]); sum += c; cnt += (c > 0u) ? 1u : 0u; mine = (j == x) ? c : mine; }
        if (sum == G) break;
        __builtin_amdgcn_s_sleep(1);
        if ((++sp & 255u) == 0u) { if (xb_ld(&bar[XB_TMO])) break; if (sp > XB_SPIN_CAP) { atomicAdd(&bar[XB_TMO], 1u); break; } }
    }
    nloc = mine > 0u ? mine : 1u; nx = cnt > 0u ? cnt : 1u;
}

__device__ __forceinline__ void xcd_barrier(const XcdBarrier& b) {
    asm volatile("s_waitcnt vmcnt(0)" ::: "memory");
    __syncthreads();
    if (b.wave == 0 && lane_id() == 0) {
        unsigned* bar = launder_s(b.bar);
        __builtin_amdgcn_s_waitcnt(0);
        unsigned nloc = b.st[0], nx = b.st[1];
        if (nloc == 0u) { xcd_barrier_complete(bar, b.x, nloc, nx); b.st[0] = nloc; b.st[1] = nx; }
        const unsigned old = xb_add(&bar[XB_XSUB(b.x)], 1u);
        const unsigned gen = old / nloc;
        if (old + 1u == (gen + 1u) * nloc) {
            __builtin_amdgcn_fence(__ATOMIC_RELEASE, "agent");
            asm volatile("s_waitcnt vmcnt(0)" ::: "memory");
            const unsigned og = xb_add(&bar[XB_TOP], 1u);
            const unsigned tg = og / nx;
            if (og + 1u == (tg + 1u) * nx) xb_add(&bar[XB_TOPGEN], 1u);
            else XB_SPIN(xb_ld(&bar[XB_TOPGEN]) == tg, bar);
            __builtin_amdgcn_fence(__ATOMIC_ACQUIRE, "agent");
            xb_add(&bar[XB_XGEN(b.x)], 1u);
            asm volatile("s_waitcnt vmcnt(0)" ::: "memory");
        } else {
            XB_SPIN(xb_ld(&bar[XB_XGEN(b.x)]) == gen, bar);
            __builtin_amdgcn_fence(__ATOMIC_ACQUIRE, "agent");
            asm volatile("s_waitcnt vmcnt(0)" ::: "memory");
        }
    }
    __syncthreads();
}

template <int l> __device__ __forceinline__ void layer_phases(LAS unsigned char* lds, Ptrs& P, const XcdBarrier& xbar, KArgs kargs, const int lo, const int hi, const int lane0, const int wave, const int G0, const int bx0) {
#define PHASE_BEGIN() P.reload(launder_s(kargs)); const int G = sopq(G0), bx = sopq(bx0); const int lane = opq(lane_id()); const int gw = bx * 8 + wave, NGW = G * 8; (void)gw; (void)NGW; (void)lane
#define IN(k) (lo <= (k) && (k) < hi)
#define SEAM(k) do { if (IN(k) && IN((k) + 1)) xcd_barrier(xbar); } while (0)
        constexpr int pb = 1 + 8 * l;
        if (IN(pb)) {
            PHASE_BEGIN();
#ifndef NO_P1
            { pg8::Gemm g{(const bf16_t*)P.XB8(), (const bf16_t*)(P.WIN8() + (size_t)l * N8 * DM), DM / 2, DM / 2, DM / 2, 0, 0, P.wave}; pg8::StaticOrder S; S.init(M, N8, G, bx);
              pg8::EpiIn E{P.PA(), P.GT(), P.SSQ() + (size_t)(2 * l) * M, 1, 1.f / 512.f};
              pg8::gemm_phase<pg8::EpiIn, pg8::StaticOrder, true, true>(lds, g, S, E); }
            { pg8::Gemm g{P.XB(), P.WINB() + (size_t)l * NB16 * DM, DM, DM, DM, 0, 0, P.wave}; pg8::StaticOrder S; S.init(M, NB16, G, bx);
              pg8::EpiIn E{P.PA(), P.GT(), P.SSQ() + (size_t)(2 * l) * M, 2, 1.f};
              pg8::gemm_phase<pg8::EpiIn, pg8::StaticOrder, true, false>(lds, g, S, E); }
#endif
        }
        SEAM(pb);
        if (IN(pb + 1)) {
            PHASE_BEGIN();
#ifndef NO_P2A
#ifndef REP_P2A
#define REP_P2A 1
#endif
            for (int rep = 0; rep < REP_P2A; ++rep) {
            if (bx == 0) P.SELCNT()[(P.wave << 6) | lane_id()] = 0u;
#ifndef REP_KM
#define REP_KM 1
#endif
#ifndef REP_VT
#define REP_VT 1
#endif
#ifndef REP_LRU
#define REP_LRU 1
#endif
            for (int r2 = 0; r2 < REP_KM; ++r2)
            for (int it = bx; it < BATCH * 8 * 16; it += G) kmean_item(lds, P, it);
            for (int r2 = 0; r2 < REP_VT; ++r2)
            for (int it = gw; it < 5120; it += NGW) vtrans_item(lds + wave * 9216, P, it, lane);
            __syncthreads();
            for (int r2 = 0; r2 < REP_LRU; ++r2)
            lru_local_phase(lds, P, l, bx, G);
            __syncthreads(); }
#endif
        }
        SEAM(pb + 1);
        if (IN(pb + 2)) {
            PHASE_BEGIN();
            for (int it = bx; it < 512; it += G) { const int j = it & 15; if (j > 0) moba_list_item(P, it >> 4, j); }
            for (int it = bx; it < 256; it += G) lru_fix_item(P, it);
            for (int it = bx; it < 512; it += G) swa_item(lds, P, l, it >> 7, (it >> 5) & 3, it & 31);
        }
        SEAM(pb + 2);
        if (IN(pb + 3)) {
            PHASE_BEGIN();
#ifndef REP_KV
#define REP_KV 1
#endif
            for (int rep = 0; rep < REP_KV; ++rep)
            for (int it = bx; it < 256; it += G) { const int bh = it >> 3, sb = it & 7;
#pragma unroll 1
                for (int q = 0; q < 3; ++q) { const int code = MOBA_SCHED[sb][q]; if (code != 255) moba_kv_item(lds, P, bh, code & 15, (code >> 4) & 1, (code & 32) != 0); } }
        }
        SEAM(pb + 3);
        if (IN(pb + 4)) {
            PHASE_BEGIN();
#ifndef REP_OWN
#define REP_OWN 1
#endif
            for (int rep = 0; rep < REP_OWN; ++rep)
            for (int it = bx; it < 256; it += G) { const int bh = it >> 3, sb = it & 7;
                moba_own_item(lds, P, bh >> 3, bh & 7, 15 - sb);
                moba_own_item(lds, P, bh >> 3, bh & 7, sb); }
        }
        SEAM(pb + 4);
        if (IN(pb + 5)) {
            PHASE_BEGIN();
#ifndef NO_P3
            { pg8::Gemm g{(const bf16_t*)P.Y8(), (const bf16_t*)(P.WBR8() + (size_t)l * 2 * DM * 1024), 1024, 512, 512, (size_t)1024, (size_t)DM * 1024, P.wave}; pg8::ZOrder2 S; S.S.init(M, DM, G, bx);
              pg8::EpiMerge E{P.GT(), P.MG(), 1.f / 512.f};
              pg8::gemm_phase<pg8::EpiMerge, pg8::ZOrder2, true, true>(lds, g, S, E); }
            { pg8::Gemm g{P.YC(), P.WBR() + (size_t)(l * 3 + 2) * DM * 1024, 1024, 1024, 1024, 0, 0, P.wave}; pg8::ZFixed S; S.S.init(M, DM, G, bx); S.z = 2;
              pg8::EpiMerge E{P.GT(), P.MG(), 1.f};
              pg8::gemm_phase<pg8::EpiMerge, pg8::ZFixed, true, false>(lds, g, S, E); }
#endif
        }
        SEAM(pb + 5);
        if (IN(pb + 6)) {
            PHASE_BEGIN();
            { pg8::Gemm g{P.MG(), P.WOUT() + (size_t)l * DM * DM, DM, DM, DM, 0, 0, P.wave}; pg8::StaticOrder S; S.init(M, DM, G, bx);
              pg8::EpiOut E{l == 0 ? P.x : P.out, P.X1(), P.XB1(), P.SSQ() + (size_t)(1 + 2 * l) * M};
#ifndef NO_P4
              pg8::gemm_phase<pg8::EpiOut, pg8::StaticOrder, true>(lds, g, S, E);
#endif
            }
            { pg8::Gemm g{P.PB() + (size_t)l * M * PLE, P.WPP() + (size_t)l * DM * PLE, PLE, PLE, PLE, 0, 0, P.wave}; pg8::StaticOrder S; S.init(M, DM, G, bx);
              pg8::EpiPlain E{P.T(), DM};
#ifndef NO_P4T
              pg8::gemm_phase<pg8::EpiPlain, pg8::StaticOrder, true>(lds, g, S, E);
#endif
            }
        }
        SEAM(pb + 6);
        if (IN(pb + 7)) {
            PHASE_BEGIN();
            pg8::Gemm g{P.XB1(), P.WPG() + (size_t)l * DM * DM, DM, DM, DM, 0, 0, P.wave}; pg8::StaticOrder S; S.init(M, DM, G, bx);
            pg8::EpiPle E{P.X1(), P.T(), P.SSQ() + (size_t)(1 + 2 * l) * M, P.out, P.XB(), P.XB8(), P.SSQ() + (size_t)(2 + 2 * l) * M, l + 1 < DEPTH};
#ifndef NO_P5
            pg8::gemm_phase<pg8::EpiPle, pg8::StaticOrder, true>(lds, g, S, E);
#endif
        }
        SEAM(pb + 7);

#undef IN
#undef SEAM
#undef PHASE_BEGIN
}

constexpr int NPH = 18;

__global__ void __launch_bounds__(NTHR, 2) fwd_kernel(Args args) {
    extern __shared__ __attribute__((aligned(16))) unsigned char lds_raw[];
    LAS unsigned char* lds = (LAS unsigned char*)lds_raw;
    cg::grid_group grid = cg::this_grid();
    const int tid = threadIdx.x, lane0 = tid & 63, wave = __builtin_amdgcn_readfirstlane(tid >> 6);
    const int G0 = gridDim.x, bx0 = blockIdx.x;
#define PHASE_BEGIN() P.reload(launder_s(kargs)); const int G = sopq(G0), bx = sopq(bx0); const int lane = opq(lane_id()); const int gw = bx * 8 + wave, NGW = G * 8; (void)gw; (void)NGW; (void)lane
    unsigned char* ws = args.ws;
    Ptrs P;
    KArgs kargs = (KArgs)__builtin_amdgcn_kernarg_segment_ptr();
    P.wave = wave;
    const int lo = args.ph_lo, hi = args.ph_hi;
    volatile LAS unsigned* bst = (volatile LAS unsigned*)(lds + LDS_BYTES - 64);
    if (tid < 2) bst[tid] = 0u;
    __syncthreads();
    const XcdBarrier xbar = xcd_barrier_post((unsigned*)(ws + OFF_BAR), bst, wave);
    if (hi > 1000) grid.sync();
#define IN(k) (lo <= (k) && (k) < hi)
#define SEAM(k) do { if (IN(k) && IN((k) + 1)) xcd_barrier(xbar); } while (0)

#ifndef REP_P0
#define REP_P0 1
#endif
    if (IN(0)) for (int rep0 = 0; rep0 < REP_P0; ++rep0) {
        PHASE_BEGIN();
        LAS float* scr = (LAS float*)(lds + wave * 16640);
        for (int l = 0; l < DEPTH; ++l) {
            { const float* wl = P.w_in + (size_t)l * DM * NIN; const float* ng = P.norm_g + l * DM;
              unsigned char* w8 = P.WIN8() + (size_t)l * N8 * DM; bf16_t* wb = P.WINB() + (size_t)l * NB16 * DM;
              transpose_matrix<true>(wl + 2048, DM, 4608, NIN, w8, ng, 64.f, scr, gw, NGW, lane);
              transpose_matrix<true>(wl + 8704, DM, 6144, NIN, w8 + (size_t)4608 * DM, ng, 64.f, scr, gw, NGW, lane);
              transpose_matrix(wl, DM, 2048, NIN, wb, ng, 1.f, scr, gw, NGW, lane);
              transpose_matrix(wl + 6656, DM, 2048, NIN, wb + (size_t)2048 * DM, ng, 1.f, scr, gw, NGW, lane); }
            for (int z = 0; z < 2; ++z) transpose_matrix<true>(P.w_br + (size_t)(l * 3 + z) * 1024 * DM, 1024, DM, DM, P.WBR8() + (size_t)(l * 2 + z) * DM * 1024, nullptr, 32.f, scr, gw, NGW, lane);
            transpose_matrix(P.w_br + (size_t)(l * 3 + 2) * 1024 * DM, 1024, DM, DM, P.WBR() + (size_t)(l * 3 + 2) * DM * 1024, nullptr, 1.f, scr, gw, NGW, lane);
            transpose_matrix(P.w_out + (size_t)l * DM * DM, DM, DM, DM, P.WOUT() + (size_t)l * DM * DM, nullptr, 1.f, scr, gw, NGW, lane);
            transpose_matrix(P.w_pg + (size_t)l * DM * DM, DM, DM, DM, P.WPG() + (size_t)l * DM * DM, P.ple_g + l * DM, 1.f, scr, gw, NGW, lane);
            transpose_matrix(P.w_pp + (size_t)l * PLE * DM, PLE, DM, DM, P.WPP() + (size_t)l * DM * PLE, nullptr, 1.f, scr, gw, NGW, lane);
            for (int n = 0; n < 8; ++n) {
                transpose_matrix(P.w_r + (size_t)(l * 8 + n) * 16384, 128, 128, 128, P.WR() + (size_t)(l * 8 + n) * 16384, nullptr, 1.f, scr, gw, NGW, lane);
                transpose_matrix(P.w_i + (size_t)(l * 8 + n) * 16384, 128, 128, 128, P.WI() + (size_t)(l * 8 + n) * 16384, nullptr, 1.f, scr, gw, NGW, lane);
            }
        }
        for (int mrow = gw; mrow < M; mrow += NGW) {
            const f32x4* xr = (const f32x4*)(P.x + (size_t)mrow * DM) + lane; u32x2* ob = (u32x2*)(P.XB() + (size_t)mrow * DM) + lane; unsigned* o8 = (unsigned*)(P.XB8() + (size_t)mrow * DM) + lane; float s = 0.f;
#pragma unroll
            for (int jv = 0; jv < 8; ++jv) { const f32x4 v = xr[64 * jv]; s += (v[0] * v[0] + v[1] * v[1]) + (v[2] * v[2] + v[3] * v[3]); ob[64 * jv] = (u32x2){pk2(v[0], v[1]), pk2(v[2], v[3])};
                int q = 0; q = __builtin_amdgcn_cvt_pk_fp8_f32(v[0] * 8.f, v[1] * 8.f, q, false); q = __builtin_amdgcn_cvt_pk_fp8_f32(v[2] * 8.f, v[3] * 8.f, q, true); o8[64 * jv] = (unsigned)q; }
            s = wave_sum(s);
            if (lane == 0) P.SSQ()[mrow] = s;
        }
        for (size_t i = (size_t)bx * NTHR + tid; i < (size_t)DEPTH * M * PLE / 8; i += (size_t)G * NTHR) {
            const f32x4 v0 = *(const f32x4*)(P.p + i * 8), v1 = *(const f32x4*)(P.p + i * 8 + 4);
            *(u32x4*)(P.PB() + i * 8) = (u32x4){pk2(v0[0], v0[1]), pk2(v0[2], v0[3]), pk2(v1[0], v1[1]), pk2(v1[2], v1[3])}; }
        for (int i = bx * NTHR + tid; i < 4 * M; i += G * NTHR) P.SSQ()[M + i] = 0.f;
    }
    SEAM(0);

    layer_phases<0>(lds, P, xbar, kargs, lo, hi, lane0, wave, G0, bx0);
    layer_phases<1>(lds, P, xbar, kargs, lo, hi, lane0, wave, G0, bx0);
    if (IN(17)) {
        PHASE_BEGIN();
        for (int mrow = gw; mrow < M; mrow += NGW) {
            const float rs = rsqrtf(P.SSQ()[(size_t)4 * M + mrow] * (1.f / DM) + EPS);
            f32x4* xr = (f32x4*)(P.out + (size_t)mrow * DM) + lane; const f32x4* gr = (const f32x4*)P.fin_g + lane;
#pragma unroll
            for (int jv = 0; jv < 8; ++jv) { const f32x4 v = xr[64 * jv], gg = gr[64 * jv]; xr[64 * jv] = v * rs * gg; }
        }
    }
#undef IN
#undef SEAM
}

extern "C" void kernel_launch(void* const* d_in, const int* in_sizes, int n_in, void* d_out, int out_size, void* d_ws, size_t ws_size, hipStream_t stream) {
    static int grid = 0;
    if (grid == 0) {
        if (n_in != 19 || out_size != M * DM || ws_size < WS_END) { fprintf(stderr, "kernel_launch: unexpected problem (n_in %d, out %d, ws %zu < %zu)\n", n_in, out_size, ws_size, (size_t)WS_END); grid = -1; return; }
        int dev = 0, cus = 0, per_cu = 0;
        (void)hipGetDevice(&dev); (void)hipDeviceGetAttribute(&cus, hipDeviceAttributeMultiprocessorCount, dev);
        (void)hipFuncSetAttribute((const void*)fwd_kernel, hipFuncAttributeMaxDynamicSharedMemorySize, LDS_BYTES);
        if (hipOccupancyMaxActiveBlocksPerMultiprocessor(&per_cu, (const void*)fwd_kernel, NTHR, LDS_BYTES) != hipSuccess || per_cu < 1) per_cu = 1;
        (void)hipGetLastError();
        grid = cus > 0 ? cus : 256;
    }
    if (grid < 0) return;
    (void)hipMemsetAsync((unsigned char*)d_ws + OFF_BAR, 0, BAR_BYTES, stream);
    Args a{};
    for (int i = 0; i < 19; ++i) a.in[i] = (const float*)d_in[i];
    a.out = (float*)d_out; a.ws = (unsigned char*)d_ws; a.ph_lo = 0; a.ph_hi = NPH;
    void* params[] = {&a};
    hipError_t e = hipLaunchCooperativeKernel((const void*)fwd_kernel, dim3(grid), dim3(NTHR), params, LDS_BYTES, stream);
    if (e != hipSuccess) fprintf(stderr, "cooperative launch failed: %s (grid %d)\n", hipGetErrorString(e), grid);
}
```

```cpp
#include <hip/hip_runtime.h>
#include <hip/hip_cooperative_groups.h>
#include <cstdio>
#include <cstdint>
namespace cg = cooperative_groups;

#define LAS __attribute__((address_space(3)))
typedef unsigned short bf16_t;
typedef short bf16x8 __attribute__((ext_vector_type(8)));
typedef float f32x4 __attribute__((ext_vector_type(4)));
typedef float f32x2 __attribute__((ext_vector_type(2)));
typedef float f32x16 __attribute__((ext_vector_type(16)));
typedef unsigned u32x4 __attribute__((ext_vector_type(4)));
typedef unsigned u32x2 __attribute__((ext_vector_type(2)));
typedef __bf16 bf16x2_t __attribute__((ext_vector_type(2)));

constexpr int BATCH = 4, SEQ = 4096, DM = 2048, M = BATCH * SEQ, DEPTH = 2, PLE = 256;
constexpr int NIN = 14848, NA = 8704, NG = 6144;
constexpr int C_QA = 0, C_KA = 1024, C_VA = 2048, C_GA = 3072, C_QB = 4096, C_KB = 5120, C_VB = 5376, C_GB = 5632, C_XC = 6656, C_GC = 7680;
constexpr float EPS = 1e-6f, LOG2E = 1.4426950408889634f, NEGF = -1e30f;

constexpr size_t SZ_WIN = (size_t)DEPTH * NIN * DM * 2, SZ_WBR = (size_t)DEPTH * 3 * DM * 1024 * 2, SZ_WSQ = (size_t)DEPTH * DM * DM * 2;
constexpr size_t SZ_WPP = (size_t)DEPTH * DM * PLE * 2, SZ_WRI = (size_t)DEPTH * 8 * 128 * 128 * 2;
constexpr int N8 = 10752, NB16 = 4096;
constexpr size_t OFF_WIN = 0, OFF_WIN8 = OFF_WIN, OFF_WINB = OFF_WIN8 + (size_t)DEPTH * N8 * DM, OFF_XB8 = OFF_WINB + (size_t)DEPTH * NB16 * DM * 2, OFF_WBR = OFF_WIN + SZ_WIN, OFF_WOUT = OFF_WBR + SZ_WBR, OFF_WPG = OFF_WOUT + SZ_WSQ, OFF_WPP = OFF_WPG + SZ_WSQ;
constexpr size_t OFF_WR = OFF_WPP + SZ_WPP, OFF_WI = OFF_WR + SZ_WRI;
constexpr size_t OFF_XB = OFF_WI + SZ_WRI;
constexpr size_t OFF_VTA = OFF_XB, OFF_VTB = OFF_XB + (size_t)BATCH * 1024 * SEQ * 2;
constexpr size_t OFF_PA = OFF_XB + (size_t)M * DM * 2;
constexpr size_t OFF_X1 = OFF_PA, OFF_MG = OFF_X1 + (size_t)M * DM * 4, OFF_XB1 = OFF_MG + (size_t)M * DM * 2;
constexpr size_t OFF_GT = OFF_PA + (size_t)M * NA * 2;
constexpr size_t OFF_Y = OFF_GT + (size_t)M * NG * 2;
constexpr size_t OFF_T = OFF_Y;
constexpr size_t OFF_Y8 = OFF_Y, OFF_YC = OFF_Y + (size_t)M * 2048;
constexpr size_t OFF_WBR8 = OFF_XB8 + (size_t)M * DM;
static_assert(OFF_WBR8 + (size_t)DEPTH * 2 * DM * 1024 <= OFF_WBR, "WBR8 fits");
constexpr size_t OFF_PB = OFF_Y + (size_t)M * 3072 * 2;
constexpr size_t OFF_SSQ = OFF_PB + (size_t)DEPTH * M * PLE * 2;
constexpr size_t OFF_KM = OFF_SSQ + (size_t)5 * M * 4;
constexpr size_t OFF_CHA = OFF_KM + (size_t)BATCH * 8 * 16 * 128 * 2, OFF_CHH = OFF_CHA + (size_t)BATCH * 64 * 1024 * 4;
constexpr size_t OFF_BAR = OFF_CHH + (size_t)BATCH * 64 * 1024 * 4, BAR_BYTES = 16384;
constexpr size_t OFF_SELCNT = OFF_BAR + BAR_BYTES;
constexpr size_t OFF_LIST = OFF_SELCNT + 4096;
constexpr size_t OFF_HL = OFF_LIST + (size_t)32 * 16 * 4096 * 4, OFF_CA = OFF_HL + (size_t)M * 1024 * 2;
constexpr size_t OFF_PO = OFF_HL;
constexpr size_t OFF_ML = OFF_PO + (size_t)32 * SEQ * 3 * 128 * 2;
constexpr size_t WS_END = OFF_ML + (size_t)32 * SEQ * 3 * 2 * 4;
static_assert(WS_END <= (size_t)973078528, "workspace budget (4 x largest tensor)");
static_assert(OFF_XB1 + (size_t)M * DM * 2 <= OFF_GT, "overlay fits");
static_assert(OFF_XB8 + (size_t)M * DM <= OFF_WBR, "fp8 / bf16 in-projection weight copies + fp8 x fit the old WIN region");
static_assert(OFF_VTB + (size_t)BATCH * 256 * SEQ * 2 <= OFF_PA, "VT overlay fits");

constexpr int LDS_BYTES = 147456;
constexpr int NTHR = 512;

__device__ __forceinline__ unsigned pk2(float lo, float hi) { f32x2 v = {lo, hi}; bf16x2_t b = __builtin_convertvector(v, bf16x2_t); return __builtin_bit_cast(unsigned, b); }
__device__ __forceinline__ float bf_lo(unsigned u) { return __uint_as_float(u << 16); }
__device__ __forceinline__ float bf_hi(unsigned u) { return __uint_as_float(u & 0xffff0000u); }
__device__ __forceinline__ float sigm(float v) { return __builtin_amdgcn_rcpf(1.f + __expf(-v)); }
__device__ __forceinline__ int opq(int v) { asm volatile("" : "+v"(v)); return v; }
__device__ __forceinline__ int sopq(int v) { asm volatile("" : "+s"(v)); return v; }
template <class T> __device__ __forceinline__ T launder_s(T p) { asm volatile("" : "+s"(p)); return p; }
__device__ __forceinline__ int lane_id() { return (int)__builtin_amdgcn_mbcnt_hi(~0u, __builtin_amdgcn_mbcnt_lo(~0u, 0u)); }
__device__ __forceinline__ int crow(int r, int hi) { return (r & 3) + 8 * (r >> 2) + 4 * hi; }
__device__ __forceinline__ float wave_sum(float v) {
#pragma unroll
    for (int o = 1; o < 64; o <<= 1) v += __shfl_xor(v, o);
    return v;
}
__device__ __forceinline__ int t5_bucket(int n) {
    if (n < 16) return n;
    int b = 16;
    b += (n >= 19); b += (n >= 21); b += (n >= 24); b += (n >= 27); b += (n >= 31); b += (n >= 35); b += (n >= 40); b += (n >= 46);
    b += (n >= 52); b += (n >= 59); b += (n >= 67); b += (n >= 77); b += (n >= 87); b += (n >= 99); b += (n >= 113);
    return b;
}

namespace pg8 {
constexpr int BM = 256, BK = 64, HALF = 128, HTB = HALF * BK * 2, STAGE_BYTES = 8 * HTB, NXCD = 8, WGM = 8;
__device__ __forceinline__ int lds_byte(int r, int c) { const int st = (r >> 4) * 2 + (c >> 5), rr = r & 15, cc = c & 31, ob = rr * 64 + cc * 2; return st * 1024 + (ob ^ (((ob >> 9) & 1) << 5)); }
__device__ __forceinline__ void stage_rc(int b, int& R, int& C) { const int st = b / 1024, sb = b % 1024, swz = sb ^ (((sb >> 9) & 1) << 5); R = (st >> 1) * 16 + swz / 64; C = (st & 1) * 32 + (swz % 64) / 2; }
__device__ __forceinline__ int perm32(int rho) { const int n = rho >> 4, i = rho & 15; return 8 * (i >> 2) + 4 * n + (i & 3); }

typedef int v4i_t __attribute__((ext_vector_type(4)));
typedef int v8i_t __attribute__((ext_vector_type(8)));
__device__ __forceinline__ v8i_t cat8(bf16x8 lo, bf16x8 hi) { return __builtin_shufflevector(__builtin_bit_cast(v4i_t, lo), __builtin_bit_cast(v4i_t, hi), 0, 1, 2, 3, 4, 5, 6, 7); }
__device__ __forceinline__ void glds16_s(const char* sbase, unsigned voff, unsigned ldsbase, int imm) { unsigned keep;
    asm volatile("s_mov_b32 %0, m0\n\ts_add_i32 m0, %3, %4\n\ts_nop 0\n\tglobal_load_lds_dwordx4 %1, %2\n\ts_mov_b32 m0, %0" : "=&s"(keep) : "v"(voff), "s"(sbase), "s"(ldsbase), "i"(imm) : "memory", "scc"); }
struct Unit { int pm, pn, z; };
struct Gemm { const bf16_t* A; const bf16_t* Bt; int lda, ldb, K; size_t zA, zB; int wave; };

struct StaticOrder {
    int nM, nN, nwg, G, c;
    __device__ void init(int M_, int N_, int G_, int c_) { nM = M_ / BM; nN = N_ / BM; nwg = nM * nN; G = G_; c = c_; }
    __device__ bool next(int i, Unit& u) const {
        const long L = (long)i * G + c; if (L >= nwg) return false;
        int wgid = (int)L; { const int q = nwg / NXCD, r = nwg % NXCD, xcd = wgid % NXCD, off = wgid / NXCD; wgid = (xcd < r ? xcd * (q + 1) : r * (q + 1) + (xcd - r) * q) + off; }
        const int nig = WGM * nN, gid = wgid / nig, fm = gid * WGM, gsz = (nM - fm) < WGM ? (nM - fm) : WGM;
        u.pm = fm + ((wgid % nig) % gsz); u.pn = (wgid % nig) / gsz; u.z = 0; return true;
    }
};
struct ZOrder2 {
    StaticOrder S;
    __device__ bool next(int i, Unit& u) const { if (!S.next(i >> 1, u)) return false; u.z = i & 1; return true; }
};
struct ZFixed {
    StaticOrder S; int z;
    __device__ bool next(int i, Unit& u) const { if (!S.next(i, u)) return false; u.z = z; return true; }
};

template <class Epi, class Sched, bool ALIGN_EPI, bool F8 = false>
__device__ __forceinline__ void gemm_phase(LAS unsigned char* lds, const Gemm g, const Sched& S, const Epi& E) {
    const int wid = __builtin_amdgcn_readfirstlane(g.wave), tid = opq((wid << 6) | lane_id()), lane = tid & 63, wr = wid >> 2, wc = wid & 3, fr = lane & 15, fq = lane >> 4;
    const int K = g.K, nt = K / BK;
    unsigned voffA[2], voffB[2];
#pragma unroll
    for (int i = 0; i < 2; ++i) { int R, C; stage_rc(tid * 16 + i * 8192, R, C); const int Rb = (R & ~31) + perm32(R & 31);
        voffA[i] = (unsigned)(R * g.lda + C) * 2u; voffB[i] = (unsigned)(Rb * g.ldb + C) * 2u; }
    const unsigned kstep = (unsigned)(BK * 2);
    const unsigned hstepA = (unsigned)HALF * g.lda * 2u, hstepB = (unsigned)HALF * g.ldb * 2u;
    const unsigned tstepA = 2u * hstepA, tstepB = 2u * hstepB;
    const unsigned ldsw = (unsigned)wid * 1024u;
    const unsigned lds_w32 = (unsigned)__builtin_amdgcn_readfirstlane((int)((unsigned)(uintptr_t)lds + ldsw));
    constexpr int KOFF = F8 ? 16 : 1024;
    const int aoff = lds_byte(wr * 64 + fr, F8 ? fq * 16 : fq * 8), boff = lds_byte(wc * 32 + fr, F8 ? fq * 16 : fq * 8);
#define PG8_SA(b, h) (((b) * 2 + (h)) * HTB)
#define PG8_SB(b, h) ((4 + (b) * 2 + (h)) * HTB)
#define PG8_STAGE_X(bufoff, rs, base, off, voff) do { _Pragma("unroll") for (int _i = 0; _i < 2; ++_i) { \
        if constexpr (F8) __builtin_amdgcn_raw_ptr_buffer_load_lds(rs, (LAS void*)(lds + (bufoff) + ldsw + _i * 8192), 16, (int)(voff)[_i], (int)(unsigned)(off), 0, 0); \
        else __builtin_amdgcn_global_load_lds((const unsigned*)((const char*)(base) + (size_t)((off) + (voff)[_i])), (LAS unsigned*)(lds + (bufoff) + ldsw + _i * 8192), 16, 0, 0); } } while (0)
#define PG8_STAGE_A(bufoff, off) PG8_STAGE_X(bufoff, rsA, g.A, off, voffA)
#define PG8_STAGE_B(bufoff, off) PG8_STAGE_X(bufoff, rsB, g.Bt, off, voffB)
#define PG8_LDA(dst, b, h) do { _Pragma("unroll") for (int m = 0; m < 4; ++m) _Pragma("unroll") for (int k = 0; k < 2; ++k) { const v4i_t f_ = *(const LAS v4i_t*)(lds + PG8_SA(b, h) + aoff + m * 2048 + k * KOFF); dst[m][4 * k] = f_[0]; dst[m][4 * k + 1] = f_[1]; dst[m][4 * k + 2] = f_[2]; dst[m][4 * k + 3] = f_[3]; } } while (0)
#define PG8_LDB(dst, b, h) do { _Pragma("unroll") for (int n = 0; n < 2; ++n) _Pragma("unroll") for (int k = 0; k < 2; ++k) { const v4i_t f_ = *(const LAS v4i_t*)(lds + PG8_SB(b, h) + boff + n * 2048 + k * KOFF); dst[n][4 * k] = f_[0]; dst[n][4 * k + 1] = f_[1]; dst[n][4 * k + 2] = f_[2]; dst[n][4 * k + 3] = f_[3]; } } while (0)
#define PG8_HALF(v, k) __builtin_bit_cast(bf16x8, (v4i_t){v[4 * (k)], v[4 * (k) + 1], v[4 * (k) + 2], v[4 * (k) + 3]})
#define PG8_MMA(ai, bj, At, Bt) do { __builtin_amdgcn_s_setprio(1); \
        if constexpr (F8) { _Pragma("unroll") for (int m = 0; m < 4; ++m) _Pragma("unroll") for (int n = 0; n < 2; ++n) \
            acc[ai][bj][m][n] = __builtin_amdgcn_mfma_scale_f32_16x16x128_f8f6f4(Bt[n], At[m], acc[ai][bj][m][n], 0, 0, 0, 0, 0, 0); }     \
        else { _Pragma("unroll") for (int m = 0; m < 4; ++m) _Pragma("unroll") for (int n = 0; n < 2; ++n) _Pragma("unroll") for (int k = 0; k < 2; ++k) \
            acc[ai][bj][m][n] = __builtin_amdgcn_mfma_f32_16x16x32_bf16(PG8_HALF(Bt[n], k), PG8_HALF(At[m], k), acc[ai][bj][m][n], 0, 0, 0); } \
        __builtin_amdgcn_s_setprio(0); } while (0)
#define PG8_WAIT_V(n) asm volatile("s_waitcnt vmcnt(" #n ")" ::: "memory")
#define PG8_WAIT_L(n) asm volatile("s_waitcnt lgkmcnt(" #n ")" ::: "memory")
#define PG8_BAR __builtin_amdgcn_s_barrier()
#define PG8_SCHED __builtin_amdgcn_sched_barrier(0)
    Unit cur, nxt; int ui = 0;
    if (!S.next(0, cur)) return;
    f32x4 acc[2][2][4][2];
#pragma unroll
    for (int a = 0; a < 2; ++a)
#pragma unroll
        for (int b = 0; b < 2; ++b)
#pragma unroll
            for (int m = 0; m < 4; ++m)
#pragma unroll
                for (int n = 0; n < 2; ++n) acc[a][b][m][n] = (f32x4){0.f, 0.f, 0.f, 0.f};
    v8i_t At[4], B0[2], B1[2];
    unsigned cA = (unsigned)cur.pm * tstepA + (unsigned)cur.z * (unsigned)g.zA, cB = (unsigned)cur.pn * tstepB + (unsigned)cur.z * (unsigned)g.zB;
    __amdgpu_buffer_rsrc_t rsA = __builtin_amdgcn_make_buffer_rsrc((void*)g.A, 0, 0x7fffffff, 0x00020000), rsB = __builtin_amdgcn_make_buffer_rsrc((void*)g.Bt, 0, 0x7fffffff, 0x00020000); (void)rsA; (void)rsB;
    PG8_STAGE_B(PG8_SB(0, 0), cB); PG8_STAGE_B(PG8_SB(0, 1), cB + hstepB); PG8_STAGE_A(PG8_SA(0, 0), cA); PG8_STAGE_A(PG8_SA(0, 1), cA + hstepA);
    if (wr == 1) PG8_BAR;
    PG8_WAIT_V(2); PG8_BAR;
    PG8_STAGE_B(PG8_SB(1, 0), cB + kstep); PG8_STAGE_A(PG8_SA(1, 0), cA + kstep); PG8_STAGE_B(PG8_SB(1, 1), cB + hstepB + kstep);
    PG8_WAIT_V(6); PG8_BAR;
    for (;;) {
        const bool has_next = S.next(ui + 1, nxt);
        const unsigned nA = has_next ? (unsigned)nxt.pm * tstepA + (unsigned)nxt.z * (unsigned)g.zA : cA;
        const unsigned nB = has_next ? (unsigned)nxt.pn * tstepB + (unsigned)nxt.z * (unsigned)g.zB : cB;
#pragma unroll 1
        for (int t = 0; t < nt; t += 2) {
            const bool last = (t == nt - 2);
            const unsigned a1 = cA + (unsigned)(t + 1) * kstep;
            const unsigned a2 = last ? nA : cA + (unsigned)(t + 2) * kstep; const unsigned b2 = last ? nB : cB + (unsigned)(t + 2) * kstep;
            const unsigned a3 = a2 + kstep; const unsigned b3 = b2 + kstep;
            PG8_LDB(B0, 0, 0); PG8_LDB(B1, 0, 1); PG8_SCHED; PG8_LDA(At, 0, 0); PG8_STAGE_A(PG8_SA(1, 1), a1 + hstepA);
            PG8_WAIT_V(8); PG8_WAIT_L(0); PG8_BAR; PG8_MMA(0, 0, At, B0); PG8_MMA(0, 1, At, B1); PG8_BAR; PG8_SCHED;
            PG8_LDA(At, 0, 1); PG8_STAGE_B(PG8_SB(0, 0), b2); PG8_STAGE_B(PG8_SB(0, 1), b2 + hstepB); PG8_STAGE_A(PG8_SA(0, 0), a2);
            PG8_WAIT_V(8); PG8_WAIT_L(0); PG8_BAR; PG8_MMA(1, 0, At, B0); PG8_MMA(1, 1, At, B1); PG8_BAR; PG8_SCHED;
            PG8_LDB(B0, 1, 0); PG8_LDB(B1, 1, 1); PG8_SCHED; PG8_LDA(At, 1, 0); PG8_STAGE_A(PG8_SA(0, 1), a2 + hstepA);
            PG8_WAIT_V(8); PG8_WAIT_L(0); PG8_BAR; PG8_MMA(0, 0, At, B0); PG8_MMA(0, 1, At, B1); PG8_BAR; PG8_SCHED;
            PG8_LDA(At, 1, 1); PG8_STAGE_B(PG8_SB(1, 0), b3); PG8_STAGE_B(PG8_SB(1, 1), b3 + hstepB); PG8_STAGE_A(PG8_SA(1, 0), a3);
            PG8_WAIT_V(8); PG8_WAIT_L(0); PG8_BAR; PG8_MMA(1, 0, At, B0); PG8_MMA(1, 1, At, B1); PG8_BAR; PG8_SCHED;
        }
        if constexpr (ALIGN_EPI) { if (wr == 0) PG8_BAR; }
        { const int l2_ = opq(lane_id()); E(acc, cur, wr, wc, l2_ & 15, l2_ >> 4); }
        if (!has_next) break;
#pragma unroll
        for (int a = 0; a < 2; ++a)
#pragma unroll
            for (int b = 0; b < 2; ++b)
#pragma unroll
                for (int m = 0; m < 4; ++m)
#pragma unroll
                    for (int n = 0; n < 2; ++n) acc[a][b][m][n] = (f32x4){0.f, 0.f, 0.f, 0.f};
        cur = nxt; cA = nA; cB = nB; ++ui;
        if constexpr (ALIGN_EPI) { if (wr == 1) PG8_BAR; }
    }
    PG8_WAIT_V(0);
    if constexpr (!ALIGN_EPI) { if (wr == 0) PG8_BAR; }
    PG8_BAR;
#undef PG8_SA
#undef PG8_SB
#undef PG8_STAGE_X
#undef PG8_STAGE_A
#undef PG8_STAGE_B
#undef PG8_LDA
#undef PG8_LDB
#undef PG8_MMA
#undef PG8_HALF
#undef PG8_WAIT_V
#undef PG8_WAIT_L
#undef PG8_BAR
#undef PG8_SCHED
}

template <int ACT> __device__ __forceinline__ float actf(float v) { if (ACT == 1) return v * sigm(v); if (ACT == 2) return sigm(v); return v; }
template <int ACT> __device__ __forceinline__ u32x4 pack8(f32x4 v0, f32x4 v1, float s) {
    u32x4 w; w.x = pk2(actf<ACT>(v0[0] * s), actf<ACT>(v0[1] * s)); w.y = pk2(actf<ACT>(v0[2] * s), actf<ACT>(v0[3] * s));
    w.z = pk2(actf<ACT>(v1[0] * s), actf<ACT>(v1[1] * s)); w.w = pk2(actf<ACT>(v1[2] * s), actf<ACT>(v1[3] * s)); return w;
}
struct EpiIn {
    bf16_t* PA; bf16_t* GT; const float* ssq; int mode; float oscale;
    template <int ACT> __device__ __forceinline__ void st(const f32x4 (&acc)[2][2][4][2], bf16_t* base, int ldc, int row0, int col0) const {
        float rs[2][4];
#pragma unroll
        for (int ai = 0; ai < 2; ++ai)
#pragma unroll
            for (int m = 0; m < 4; ++m) rs[ai][m] = ssq[row0 + ai * HALF + m * 16];
#pragma unroll
        for (int ai = 0; ai < 2; ++ai)
#pragma unroll
            for (int m = 0; m < 4; ++m) { const int row = row0 + ai * HALF + m * 16; const float r = rsqrtf(rs[ai][m] * (1.f / DM) + EPS) * oscale;
                bf16_t* rowp = base + (size_t)row * ldc + col0;
#pragma unroll
                for (int bj = 0; bj < 2; ++bj) *(u32x4*)(rowp + bj * HALF) = pack8<ACT>(acc[ai][bj][m][0], acc[ai][bj][m][1], r); }
    }
    __device__ __forceinline__ void operator()(const f32x4 (&acc)[2][2][4][2], const Unit& u, int wr, int wc, int fr, int fq) const {
        const int pn = (mode == 1) ? (u.pn < 18 ? u.pn + 8 : u.pn + 16) : (u.pn < 8 ? u.pn : u.pn + 18), row0 = u.pm * BM + wr * 64 + fr;
        if (pn >= 34) { st<2>(acc, GT, NG, row0, (pn - 34) * BM + wc * 32 + 8 * fq); }
        else { const int col0 = pn * BM + wc * 32 + 8 * fq;
            const bool silu = (pn >= 12 && pn < 16) || (pn >= 22 && pn < 26) || (pn >= 30);
            if (silu) st<1>(acc, PA, NA, row0, col0); else st<0>(acc, PA, NA, row0, col0); }
    }
};
struct EpiPlain {
    bf16_t* O; int ldc;
    __device__ __forceinline__ void operator()(const f32x4 (&acc)[2][2][4][2], const Unit& u, int wr, int wc, int fr, int fq) const {
        const int row0 = u.pm * BM + wr * 64 + fr, col0 = u.pn * BM + wc * 32 + 8 * fq;
#pragma unroll
        for (int ai = 0; ai < 2; ++ai)
#pragma unroll
            for (int m = 0; m < 4; ++m) { bf16_t* rowp = O + (size_t)(row0 + ai * HALF + m * 16) * ldc + col0;
#pragma unroll
                for (int bj = 0; bj < 2; ++bj) *(u32x4*)(rowp + bj * HALF) = pack8<0>(acc[ai][bj][m][0], acc[ai][bj][m][1], 1.f); }
    }
};
struct EpiMerge {
    const bf16_t* GT; bf16_t* MG; float oscale;
    __device__ __forceinline__ void operator()(const f32x4 (&acc)[2][2][4][2], const Unit& u, int wr, int wc, int fr, int fq) const {
        const int row0 = u.pm * BM + wr * 64 + fr, col0 = u.pn * BM + wc * 32 + 8 * fq, z = u.z;
#pragma unroll
        for (int ai = 0; ai < 2; ++ai)
#pragma unroll
            for (int bj = 0; bj < 2; ++bj) { const int col = col0 + bj * HALF;
                u32x4 gw[4], tw[4];
#pragma unroll
                for (int m = 0; m < 4; ++m) { const size_t row = (size_t)(row0 + ai * HALF + m * 16);
                    gw[m] = *(const u32x4*)(GT + row * NG + z * DM + col);
                    tw[m] = (z > 0) ? *(const u32x4*)(MG + row * DM + col) : (u32x4){0u, 0u, 0u, 0u}; }
#pragma unroll
                for (int m = 0; m < 4; ++m) { const size_t row = (size_t)(row0 + ai * HALF + m * 16);
                    const f32x4 a0 = acc[ai][bj][m][0] * oscale, a1 = acc[ai][bj][m][1] * oscale; u32x4 w;
                    w.x = pk2(a0[0] * bf_lo(gw[m].x) + bf_lo(tw[m].x), a0[1] * bf_hi(gw[m].x) + bf_hi(tw[m].x));
                    w.y = pk2(a0[2] * bf_lo(gw[m].y) + bf_lo(tw[m].y), a0[3] * bf_hi(gw[m].y) + bf_hi(tw[m].y));
                    w.z = pk2(a1[0] * bf_lo(gw[m].z) + bf_lo(tw[m].z), a1[1] * bf_hi(gw[m].z) + bf_hi(tw[m].z));
                    w.w = pk2(a1[2] * bf_lo(gw[m].w) + bf_lo(tw[m].w), a1[3] * bf_hi(gw[m].w) + bf_hi(tw[m].w));
                    *(u32x4*)(MG + row * DM + col) = w; } }
    }
};
struct EpiOut {
    const float* xin; float* X1; bf16_t* XB1; float* ssq;
    __device__ __forceinline__ void operator()(const f32x4 (&acc)[2][2][4][2], const Unit& u, int wr, int wc, int fr, int fq) const {
        const int row0 = u.pm * BM + wr * 64 + fr, col0 = u.pn * BM + wc * 32 + 8 * fq;
#pragma unroll
        for (int ai = 0; ai < 2; ++ai) { float s[4] = {0.f, 0.f, 0.f, 0.f};
#pragma unroll
            for (int bj = 0; bj < 2; ++bj) { f32x4 x0[4], x1[4];
#pragma unroll
                for (int m = 0; m < 4; ++m) { const size_t o = (size_t)(row0 + ai * HALF + m * 16) * DM + col0 + bj * HALF; x0[m] = *(const f32x4*)(xin + o); x1[m] = *(const f32x4*)(xin + o + 4); }
#pragma unroll
                for (int m = 0; m < 4; ++m) { const size_t o = (size_t)(row0 + ai * HALF + m * 16) * DM + col0 + bj * HALF;
                    const f32x4 v0 = x0[m] + acc[ai][bj][m][0], v1 = x1[m] + acc[ai][bj][m][1];
                    *(f32x4*)(X1 + o) = v0; *(f32x4*)(X1 + o + 4) = v1;
                    u32x4 w; w.x = pk2(v0[0], v0[1]); w.y = pk2(v0[2], v0[3]); w.z = pk2(v1[0], v1[1]); w.w = pk2(v1[2], v1[3]); *(u32x4*)(XB1 + o) = w;
                    s[m] += (v0[0] * v0[0] + v0[1] * v0[1]) + (v0[2] * v0[2] + v0[3] * v0[3]) + (v1[0] * v1[0] + v1[1] * v1[1]) + (v1[2] * v1[2] + v1[3] * v1[3]); } }
#pragma unroll
            for (int m = 0; m < 4; ++m) { float t = s[m]; t += __shfl_xor(t, 16); t += __shfl_xor(t, 32);
                if (fq == 0) atomicAdd(ssq + (row0 + ai * HALF + m * 16), t); } }
    }
};
struct EpiPle {
    const float* X1; const bf16_t* T; const float* ssq1; float* xout; bf16_t* XB; unsigned char* XB8; float* ssq2; bool wxb;
    __device__ __forceinline__ void operator()(const f32x4 (&acc)[2][2][4][2], const Unit& u, int wr, int wc, int fr, int fq) const {
        const int row0 = u.pm * BM + wr * 64 + fr, col0 = u.pn * BM + wc * 32 + 8 * fq;
        float rsv[2][4];
#pragma unroll
        for (int ai = 0; ai < 2; ++ai)
#pragma unroll
            for (int m = 0; m < 4; ++m) rsv[ai][m] = ssq1[row0 + ai * HALF + m * 16];
#pragma unroll
        for (int ai = 0; ai < 2; ++ai) { float s[4] = {0.f, 0.f, 0.f, 0.f};
#pragma unroll
            for (int bj = 0; bj < 2; ++bj)
#pragma unroll
              for (int mh = 0; mh < 2; ++mh) { f32x4 x0[2], x1[2]; u32x4 tw[2];
#pragma unroll
                for (int mm = 0; mm < 2; ++mm) { const int m = 2 * mh + mm; const size_t o = (size_t)(row0 + ai * HALF + m * 16) * DM + col0 + bj * HALF; x0[mm] = *(const f32x4*)(X1 + o); x1[mm] = *(const f32x4*)(X1 + o + 4); tw[mm] = *(const u32x4*)(T + o); }
#pragma unroll
                for (int mm = 0; mm < 2; ++mm) { const int m = 2 * mh + mm; const size_t o = (size_t)(row0 + ai * HALF + m * 16) * DM + col0 + bj * HALF;
                    const float rs = rsqrtf(rsv[ai][m] * (1.f / DM) + EPS);
                    const f32x4 a0 = acc[ai][bj][m][0], a1 = acc[ai][bj][m][1]; f32x4 v0 = x0[mm], v1 = x1[mm];
                    v0[0] += sigm(a0[0] * rs) * bf_lo(tw[mm].x); v0[1] += sigm(a0[1] * rs) * bf_hi(tw[mm].x); v0[2] += sigm(a0[2] * rs) * bf_lo(tw[mm].y); v0[3] += sigm(a0[3] * rs) * bf_hi(tw[mm].y);
                    v1[0] += sigm(a1[0] * rs) * bf_lo(tw[mm].z); v1[1] += sigm(a1[1] * rs) * bf_hi(tw[mm].z); v1[2] += sigm(a1[2] * rs) * bf_lo(tw[mm].w); v1[3] += sigm(a1[3] * rs) * bf_hi(tw[mm].w);
                    *(f32x4*)(xout + o) = v0; *(f32x4*)(xout + o + 4) = v1;
                    if (wxb) { u32x4 w; w.x = pk2(v0[0], v0[1]); w.y = pk2(v0[2], v0[3]); w.z = pk2(v1[0], v1[1]); w.w = pk2(v1[2], v1[3]); *(u32x4*)(XB + o) = w;
                        int q0 = 0, q1 = 0; q0 = __builtin_amdgcn_cvt_pk_fp8_f32(v0[0] * 8.f, v0[1] * 8.f, q0, false); q0 = __builtin_amdgcn_cvt_pk_fp8_f32(v0[2] * 8.f, v0[3] * 8.f, q0, true);
                        q1 = __builtin_amdgcn_cvt_pk_fp8_f32(v1[0] * 8.f, v1[1] * 8.f, q1, false); q1 = __builtin_amdgcn_cvt_pk_fp8_f32(v1[2] * 8.f, v1[3] * 8.f, q1, true);
                        *(u32x2*)(XB8 + o) = (u32x2){(unsigned)q0, (unsigned)q1}; }
                    s[m] += (v0[0] * v0[0] + v0[1] * v0[1]) + (v0[2] * v0[2] + v0[3] * v0[3]) + (v1[0] * v1[0] + v1[1] * v1[1]) + (v1[2] * v1[2] + v1[3] * v1[3]); } }
#pragma unroll
            for (int m = 0; m < 4; ++m) { float t = s[m]; t += __shfl_xor(t, 16); t += __shfl_xor(t, 32);
                if (fq == 0) atomicAdd(ssq2 + (row0 + ai * HALF + m * 16), t); } }
    }
};
}

template <bool F8> __device__ __forceinline__ void transpose_item(const float* W, int K, int N, int ld, void* WTv, const float* kscale, float wscale, LAS float* scr, int item, int lane_) {
    const int lane = opq(lane_);
    const int nblk = N / 64, kb = item / nblk, nb = item % nblk, k0 = 64 * kb, n0 = 64 * nb;
    float v[64];
#pragma unroll
    for (int kk = 0; kk < 64; ++kk) v[kk] = W[(size_t)(k0 + kk) * ld + n0 + lane];
#pragma unroll
    for (int kk = 0; kk < 64; ++kk) { const float sc = (kscale ? kscale[k0 + kk] : 1.f) * wscale; scr[kk * 65 + lane] = v[kk] * sc; }
    if constexpr (F8) {
        unsigned char* WT = (unsigned char*)WTv; const int c = lane & 3;
#pragma unroll
        for (int j = 0; j < 4; ++j) { const int n = (lane >> 2) + 16 * j; const LAS float* s = scr + (16 * c) * 65 + n; int q[4];
#pragma unroll
            for (int d = 0; d < 4; ++d) { int w = 0; w = __builtin_amdgcn_cvt_pk_fp8_f32(s[(4 * d) * 65], s[(4 * d + 1) * 65], w, false); w = __builtin_amdgcn_cvt_pk_fp8_f32(s[(4 * d + 2) * 65], s[(4 * d + 3) * 65], w, true); q[d] = w; }
            *(u32x4*)(WT + (size_t)(n0 + n) * K + k0 + 16 * c) = (u32x4){(unsigned)q[0], (unsigned)q[1], (unsigned)q[2], (unsigned)q[3]}; }
    } else {
        bf16_t* WT = (bf16_t*)WTv; const int c = lane & 7;
#pragma unroll
        for (int j = 0; j < 8; ++j) { const int n = (lane >> 3) + 8 * j; const LAS float* s = scr + (8 * c) * 65 + n;
            u32x4 o; o.x = pk2(s[0 * 65], s[1 * 65]); o.y = pk2(s[2 * 65], s[3 * 65]); o.z = pk2(s[4 * 65], s[5 * 65]); o.w = pk2(s[6 * 65], s[7 * 65]);
            *(u32x4*)(WT + (size_t)(n0 + n) * K + k0 + 8 * c) = o; }
    }
}
template <bool F8 = false> __device__ __forceinline__ void transpose_matrix(const float* W, int K, int N, int ld, void* WT, const float* kscale, float wscale, LAS float* scr, int gw, int NGW, int lane) {
    const int nitems = (K / 64) * (N / 64);
    for (int it = gw; it < nitems; it += NGW) transpose_item<F8>(W, K, N, ld, WT, kscale, wscale, scr, it, lane);
}

struct Args { const float* in[19]; float* out; unsigned char* ws; int ph_lo, ph_hi; };
typedef const __attribute__((address_space(4))) Args* KArgs;
struct Ptrs {
    __device__ __forceinline__ void reload(KArgs a) {
        x = a->in[0]; p = a->in[1]; rpe = a->in[2]; norm_g = a->in[3]; w_in = a->in[4]; sinks = a->in[5]; conv_w = a->in[6]; conv_b = a->in[7]; w_r = a->in[8]; b_r = a->in[9]; w_i = a->in[10];
        b_i = a->in[11]; lam = a->in[12]; w_br = a->in[13]; w_out = a->in[14]; ple_g = a->in[15]; w_pg = a->in[16]; w_pp = a->in[17]; fin_g = a->in[18]; out = a->out; ws = a->ws; }
    const float *x, *p, *rpe, *norm_g, *w_in, *sinks, *conv_w, *conv_b, *w_r, *b_r, *w_i, *b_i, *lam, *w_br, *w_out, *ple_g, *w_pg, *w_pp, *fin_g;
    float* out; unsigned char* ws; int wave;
#define WSP(NAME, TYPE, OFF) __device__ __forceinline__ TYPE* NAME() const { return (TYPE*)(ws + (OFF)); }
    WSP(WIN8, unsigned char, OFF_WIN8) WSP(WINB, bf16_t, OFF_WINB) WSP(XB8, unsigned char, OFF_XB8) WSP(WBR, bf16_t, OFF_WBR) WSP(WOUT, bf16_t, OFF_WOUT) WSP(WPG, bf16_t, OFF_WPG) WSP(WPP, bf16_t, OFF_WPP) WSP(WR, bf16_t, OFF_WR) WSP(WI, bf16_t, OFF_WI)
    WSP(XB, bf16_t, OFF_XB) WSP(VTA, bf16_t, OFF_VTA) WSP(VTB, bf16_t, OFF_VTB) WSP(PA, bf16_t, OFF_PA) WSP(MG, bf16_t, OFF_MG) WSP(XB1, bf16_t, OFF_XB1) WSP(GT, bf16_t, OFF_GT)
    WSP(Y8, unsigned char, OFF_Y8) WSP(YC, bf16_t, OFF_YC) WSP(WBR8, unsigned char, OFF_WBR8) WSP(T, bf16_t, OFF_T) WSP(HL, bf16_t, OFF_HL) WSP(CA, bf16_t, OFF_CA) WSP(PB, bf16_t, OFF_PB) WSP(KM, bf16_t, OFF_KM)
    WSP(X1, float, OFF_X1) WSP(SSQ, float, OFF_SSQ) WSP(CHA, float, OFF_CHA) WSP(CHH, float, OFF_CHH)
    WSP(SELCNT, unsigned, OFF_SELCNT) WSP(LIST, unsigned, OFF_LIST) WSP(PO, bf16_t, OFF_PO) WSP(ML, float, OFF_ML)
#undef WSP
};

__device__ __forceinline__ void kmean_item(LAS unsigned char* lds, const Ptrs& P, int it) {
    const int tid = opq((P.wave << 6) | lane_id()), b = it >> 7, h = (it >> 4) & 7, n = it & 15;
    const int rg = tid >> 4, c8 = tid & 15;
    float s0 = 0.f, s1 = 0.f, s2 = 0.f, s3 = 0.f, s4 = 0.f, s5 = 0.f, s6 = 0.f, s7 = 0.f;
#pragma unroll
    for (int i = 0; i < 8; ++i) { const int row = rg + 32 * i;
        const u32x4 w = *(const u32x4*)(P.PA() + (size_t)(b * SEQ + n * 256 + row) * NA + C_KA + h * 128 + c8 * 8);
        s0 += bf_lo(w.x); s1 += bf_hi(w.x); s2 += bf_lo(w.y); s3 += bf_hi(w.y); s4 += bf_lo(w.z); s5 += bf_hi(w.z); s6 += bf_lo(w.w); s7 += bf_hi(w.w); }
    LAS float* red = (LAS float*)lds;
    LAS float* rp = red + rg * 128 + c8 * 8;
    rp[0] = s0; rp[1] = s1; rp[2] = s2; rp[3] = s3; rp[4] = s4; rp[5] = s5; rp[6] = s6; rp[7] = s7;
    __syncthreads();
    if (tid < 128) { float s = 0.f;
#pragma unroll 8
        for (int r = 0; r < 32; ++r) s += red[r * 128 + tid];
        P.KM()[(size_t)it * 128 + tid] = (bf16_t)(pk2(s * (1.f / 256.f), 0.f) & 0xffffu); }
    __syncthreads();
}
__device__ __forceinline__ void vtrans_item(LAS unsigned char* scr, const Ptrs& P, int it, int lane_) {
    const int lane = opq(lane_);
    int b, tt, colbase; bf16_t* dst0;
    if (it < 4096) { b = it >> 10; const int r = it & 1023; tt = r >> 4; const int ct = r & 15; colbase = C_VA + ct * 64; dst0 = P.VTA() + ((size_t)(b * 1024 + ct * 64) * SEQ + tt * 64); }
    else { it -= 4096; b = it >> 8; const int r = it & 255; tt = r >> 2; const int ct = r & 3; colbase = C_VB + ct * 64; dst0 = P.VTB() + ((size_t)(b * 256 + ct * 64) * SEQ + tt * 64); }
#pragma unroll
    for (int i = 0; i < 8; ++i) { const int row = i * 8 + (lane >> 3), c8 = lane & 7;
        const u32x4 w = *(const u32x4*)(P.PA() + (size_t)(b * SEQ + tt * 64 + row) * NA + colbase + c8 * 8);
        *(LAS u32x4*)(scr + row * 144 + c8 * 16) = w; }
#pragma unroll
    for (int i = 0; i < 8; ++i) { const int c = (lane >> 3) + 8 * i, tg = lane & 7; unsigned e[8];
#pragma unroll
        for (int k = 0; k < 8; ++k) e[k] = *(const LAS unsigned short*)(scr + (tg * 8 + k) * 144 + c * 2);
        u32x4 o; o.x = e[0] | (e[1] << 16); o.y = e[2] | (e[3] << 16); o.z = e[4] | (e[5] << 16); o.w = e[6] | (e[7] << 16);
        *(u32x4*)(dst0 + (size_t)c * SEQ + tg * 8) = o; }
}
__device__ __forceinline__ void lru_local_phase(LAS unsigned char* lds, const Ptrs& P, int l, int bx, int G) {
    const int tid = opq((P.wave << 6) | lane_id()), lane = tid & 63, wid = __builtin_amdgcn_readfirstlane(tid >> 6);
    constexpr int NIT = BATCH * 64 * 8;
    u32x4 xw[4][2];
#define LRU_LOAD(itx) do { const int b_ = (itx) >> 9, c_ = ((itx) >> 3) & 63, n_ = (itx) & 7; \
        _Pragma("unroll") for (int w = 0; w < 4; ++w) { int tt_ = c_ * 64 + (tid >> 3) - 3 + w; tt_ = tt_ < 0 ? 0 : tt_; \
            const bf16_t* src_ = P.PA() + (size_t)(b_ * SEQ + tt_) * NA + C_XC + n_ * 128 + (tid & 7) * 16; \
            xw[w][0] = *(const u32x4*)src_; xw[w][1] = *(const u32x4*)(src_ + 8); } } while (0)
    if (bx < NIT) LRU_LOAD(bx);
    int n_cur = -1; bf16x8 br[4], bi[4]; float brv = 0.f, biv = 0.f, c8sp = 0.f; f32x4 cbv[4], cwv[4][4];
#pragma unroll 1
    for (int it = bx; it < NIT; it += G) {
    const int b = it >> 9, c = (it >> 3) & 63, n = it & 7, t0 = c * 64, ch0 = n * 128;
    const int col = lane & 15, quad = lane >> 4, d0 = 16 * wid, ch = ch0 + d0 + col;
    if (n != n_cur) {
        n_cur = n;
        const size_t wofs = ((size_t)(l * 8 + n) * 128 + d0 + col) * 128 + quad * 8;
#pragma unroll
        for (int ks = 0; ks < 4; ++ks) { br[ks] = *(const bf16x8*)(P.WR() + wofs + ks * 32); bi[ks] = *(const bf16x8*)(P.WI() + wofs + ks * 32); }
        brv = P.b_r[l * 1024 + ch]; biv = P.b_i[l * 1024 + ch]; c8sp = -8.f * log1pf(__expf(-P.lam[l * 1024 + ch]));
        const int chb_ = ch0 + (tid & 7) * 16;
#pragma unroll
        for (int q = 0; q < 4; ++q) cbv[q] = *(const f32x4*)(P.conv_b + l * 1024 + chb_ + 4 * q);
#pragma unroll
        for (int w = 0; w < 4; ++w)
#pragma unroll
            for (int q = 0; q < 4; ++q) cwv[w][q] = *(const f32x4*)(P.conv_w + (size_t)(l * 4 + w) * 1024 + chb_ + 4 * q);
    }
    LAS unsigned char* convb = lds;
    LAS float* convf = (LAS float*)(lds + 17408);
    LAS unsigned char* hlS = lds + 51200;
    LAS unsigned char* caS = lds + 68608;
    {
        const int t = tid >> 3, cg8 = tid & 7, chb = ch0 + cg8 * 16;
        float a[16];
#pragma unroll
        for (int q = 0; q < 4; ++q) { const f32x4 v = cbv[q]; a[4 * q] = v[0]; a[4 * q + 1] = v[1]; a[4 * q + 2] = v[2]; a[4 * q + 3] = v[3]; }
#pragma unroll
        for (int w = 0; w < 4; ++w) { const int tt = t0 + t - 3 + w; const float msk = tt >= 0 ? 1.f : 0.f;
#pragma unroll
            for (int hh = 0; hh < 2; ++hh) { const u32x4 xv = xw[w][hh]; const f32x4 w0 = cwv[w][2 * hh] * msk, w1 = cwv[w][2 * hh + 1] * msk;
                a[8 * hh + 0] += w0[0] * bf_lo(xv.x); a[8 * hh + 1] += w0[1] * bf_hi(xv.x); a[8 * hh + 2] += w0[2] * bf_lo(xv.y); a[8 * hh + 3] += w0[3] * bf_hi(xv.y);
                a[8 * hh + 4] += w1[0] * bf_lo(xv.z); a[8 * hh + 5] += w1[1] * bf_hi(xv.z); a[8 * hh + 6] += w1[2] * bf_lo(xv.w); a[8 * hh + 7] += w1[3] * bf_hi(xv.w); } }
#pragma unroll
        for (int q = 0; q < 4; ++q) *(LAS f32x4*)(convf + t * 132 + cg8 * 16 + 4 * q) = (f32x4){a[4 * q], a[4 * q + 1], a[4 * q + 2], a[4 * q + 3]};
#pragma unroll
        for (int hh = 0; hh < 2; ++hh) { u32x4 o; o.x = pk2(a[8 * hh], a[8 * hh + 1]); o.y = pk2(a[8 * hh + 2], a[8 * hh + 3]); o.z = pk2(a[8 * hh + 4], a[8 * hh + 5]); o.w = pk2(a[8 * hh + 6], a[8 * hh + 7]);
            *(LAS u32x4*)(convb + t * 272 + cg8 * 32 + hh * 16) = o; }
    }
    __syncthreads();
    if (it + G < NIT) LRU_LOAD(it + G);
    f32x4 accr[4], acci[4];
    {
#pragma unroll
        for (int m = 0; m < 4; ++m) { accr[m] = (f32x4){0.f, 0.f, 0.f, 0.f}; acci[m] = (f32x4){0.f, 0.f, 0.f, 0.f};
#pragma unroll
            for (int ks = 0; ks < 4; ++ks) { const bf16x8 av = *(const LAS bf16x8*)(convb + (m * 16 + col) * 272 + (ks * 32 + quad * 8) * 2);
                accr[m] = __builtin_amdgcn_mfma_f32_16x16x32_bf16(av, br[ks], accr[m], 0, 0, 0);
                acci[m] = __builtin_amdgcn_mfma_f32_16x16x32_bf16(av, bi[ks], acci[m], 0, 0, 0); } }
    }
    {
        float Ac = 1.f, Hc = 0.f;
#pragma unroll
        for (int m = 0; m < 4; ++m) {
            float hl[4], Pl[4]; float h = 0.f, Pp = 1.f;
#pragma unroll
            for (int jj = 0; jj < 4; ++jj) { const int tok = m * 16 + quad * 4 + jj;
                const float r = sigm(accr[m][jj] + brv), ig = sigm(acci[m][jj] + biv);
                const float la = c8sp * r, av = __expf(la);
                const float bm = __builtin_amdgcn_sqrtf(fmaxf(1.f - __expf(2.f * la), 0.f));
                const float bb = bm * ig * convf[tok * 132 + d0 + col];
                h = av * h + bb; Pp *= av; hl[jj] = h; Pl[jj] = Pp; }
            const float A0 = __shfl(Pp, col), A1 = __shfl(Pp, col + 16), A2 = __shfl(Pp, col + 32), A3 = __shfl(Pp, col + 48);
            const float H0 = __shfl(h, col), H1 = __shfl(h, col + 16), H2 = __shfl(h, col + 32), H3 = __shfl(h, col + 48);
            float Ain = 1.f, Hin = 0.f;
            if (quad > 0) { Hin = H0; Ain = A0; }
            if (quad > 1) { Hin = A1 * Hin + H1; Ain *= A1; }
            if (quad > 2) { Hin = A2 * Hin + H2; Ain *= A2; }
            const float At = A0 * A1 * A2 * A3, Ht = ((H0 * A1 + H1) * A2 + H2) * A3 + H3;
            const float Hstart = Ain * Hc + Hin, Pstart = Ac * Ain;
#pragma unroll
            for (int jj = 0; jj < 4; ++jj) { const int tok = m * 16 + quad * 4 + jj;
                *(LAS unsigned short*)(hlS + tok * 272 + (d0 + col) * 2) = (unsigned short)(pk2(Pl[jj] * Hstart + hl[jj], 0.f) & 0xffffu);
                *(LAS unsigned short*)(caS + tok * 272 + (d0 + col) * 2) = (unsigned short)(pk2(Pstart * Pl[jj], 0.f) & 0xffffu); }
            Hc = At * Hc + Ht; Ac *= At;
        }
        if (quad == 0) { P.CHA()[(size_t)(b * 64 + c) * 1024 + ch] = Ac; P.CHH()[(size_t)(b * 64 + c) * 1024 + ch] = Hc; }
    }
    __syncthreads();
    {
        const int t = tid >> 3, cg8 = tid & 7; const size_t o = (size_t)(b * SEQ + t0 + t) * 1024 + ch0 + cg8 * 16;
#pragma unroll
        for (int hh = 0; hh < 2; ++hh) { *(u32x4*)(P.HL() + o + 8 * hh) = *(const LAS u32x4*)(hlS + t * 272 + cg8 * 32 + hh * 16); *(u32x4*)(P.CA() + o + 8 * hh) = *(const LAS u32x4*)(caS + t * 272 + cg8 * 32 + hh * 16); }
    }
    }
#undef LRU_LOAD
}

__device__ __forceinline__ void lru_fix_item(const Ptrs& P, int it) {
    const int tid = opq((P.wave << 6) | lane_id()), b = it >> 6, c = it & 63, tg = tid >> 7, c8 = tid & 127;
    f32x4 H0 = {0.f, 0.f, 0.f, 0.f}, H1 = {0.f, 0.f, 0.f, 0.f};
    int cc = 0;
#pragma unroll 1
    for (; cc + 8 <= c; cc += 8) {
        f32x4 a0[8], a1[8], h0[8], h1[8];
#pragma unroll
        for (int u = 0; u < 8; ++u) { const size_t o = (size_t)(b * 64 + cc + u) * 1024 + c8 * 8;
            a0[u] = *(const f32x4*)(P.CHA() + o); a1[u] = *(const f32x4*)(P.CHA() + o + 4); h0[u] = *(const f32x4*)(P.CHH() + o); h1[u] = *(const f32x4*)(P.CHH() + o + 4); }
#pragma unroll
        for (int u = 0; u < 8; ++u) { H0 = a0[u] * H0 + h0[u]; H1 = a1[u] * H1 + h1[u]; }
    }
    for (; cc < c; ++cc) { const size_t o = (size_t)(b * 64 + cc) * 1024 + c8 * 8;
        const f32x4 a0 = *(const f32x4*)(P.CHA() + o), a1 = *(const f32x4*)(P.CHA() + o + 4), h0 = *(const f32x4*)(P.CHH() + o), h1 = *(const f32x4*)(P.CHH() + o + 4);
        H0 = a0 * H0 + h0; H1 = a1 * H1 + h1; }
#pragma unroll 4
    for (int k = 0; k < 16; ++k) { const size_t row = (size_t)(b * SEQ + c * 64 + tg + 4 * k);
        const u32x4 hw = *(const u32x4*)(P.HL() + row * 1024 + c8 * 8), cw = *(const u32x4*)(P.CA() + row * 1024 + c8 * 8), gw = *(const u32x4*)(P.PA() + row * NA + C_GC + c8 * 8);
        u32x4 o;
        o.x = pk2((bf_lo(hw.x) + bf_lo(cw.x) * H0[0]) * bf_lo(gw.x), (bf_hi(hw.x) + bf_hi(cw.x) * H0[1]) * bf_hi(gw.x));
        o.y = pk2((bf_lo(hw.y) + bf_lo(cw.y) * H0[2]) * bf_lo(gw.y), (bf_hi(hw.y) + bf_hi(cw.y) * H0[3]) * bf_hi(gw.y));
        o.z = pk2((bf_lo(hw.z) + bf_lo(cw.z) * H1[0]) * bf_lo(gw.z), (bf_hi(hw.z) + bf_hi(cw.z) * H1[1]) * bf_hi(gw.z));
        o.w = pk2((bf_lo(hw.w) + bf_lo(cw.w) * H1[2]) * bf_lo(gw.w), (bf_hi(hw.w) + bf_hi(cw.w) * H1[3]) * bf_hi(gw.w));
        *(u32x4*)(P.YC() + row * 1024 + c8 * 8) = o; }
}

#define SOFTMAX_TILE(p0, p1, m, l, NO, o, pw) do { \
    float rm_ = fmaxf(p0[0], p1[0]); \
    _Pragma("unroll") for (int r = 1; r < 16; ++r) rm_ = fmaxf(rm_, fmaxf(p0[r], p1[r])); \
    rm_ = fmaxf(rm_, __shfl_xor(rm_, 32)); \
    if (__ballot(rm_ > m + 8.f) != 0ull) {        \
        const float mn_ = fmaxf(m, rm_); const float al_ = __builtin_amdgcn_exp2f(m - mn_); m = mn_; l *= al_; \
        _Pragma("unroll") for (int d_ = 0; d_ < NO; ++d_) o[d_] *= al_; } \
    float ps_ = 0.f; \
    _Pragma("unroll") for (int r = 0; r < 16; ++r) { p0[r] = __builtin_amdgcn_exp2f(p0[r] - m); p1[r] = __builtin_amdgcn_exp2f(p1[r] - m); ps_ += p0[r] + p1[r]; } \
    l += ps_; \
    pw[0] = (u32x4){pk2(p0[0], p0[1]), pk2(p0[2], p0[3]), pk2(p0[4], p0[5]), pk2(p0[6], p0[7])}; \
    pw[1] = (u32x4){pk2(p0[8], p0[9]), pk2(p0[10], p0[11]), pk2(p0[12], p0[13]), pk2(p0[14], p0[15])}; \
    pw[2] = (u32x4){pk2(p1[0], p1[1]), pk2(p1[2], p1[3]), pk2(p1[4], p1[5]), pk2(p1[6], p1[7])}; \
    pw[3] = (u32x4){pk2(p1[8], p1[9]), pk2(p1[10], p1[11]), pk2(p1[12], p1[13]), pk2(p1[14], p1[15])}; } while (0)

__device__ __forceinline__ void moba_load_q(bf16x8 (&qr)[8], const Ptrs& P, size_t qrow, int h, int hi) {
#pragma unroll
    for (int ks = 0; ks < 8; ++ks) qr[ks] = *(const bf16x8*)(P.PA() + qrow * NA + C_QA + h * 128 + ks * 16 + hi * 8);
}
__device__ __forceinline__ void moba_list_item(const Ptrs& P, int bh, int j) {
    const int tid = opq((P.wave << 6) | lane_id()), lane = tid & 63, wid = __builtin_amdgcn_readfirstlane(tid >> 6), r32 = lane & 31, hi = lane >> 5;
    const int b = bh >> 3, h = bh & 7, t = j * 256 + 32 * wid + r32;
    bf16x8 qr[8]; moba_load_q(qr, P, (size_t)(b * SEQ + t), h, hi);
    f32x16 ga = {};
#pragma unroll
    for (int ks = 0; ks < 8; ++ks) { const bf16x8 kf = *(const bf16x8*)(P.KM() + ((size_t)(bh * 16 + (r32 & 15))) * 128 + ks * 16 + hi * 8);
        ga = __builtin_amdgcn_mfma_f32_32x32x16_bf16(kf, qr[ks], ga, 0, 0, 0); }
    float g[16];
#pragma unroll
    for (int e = 0; e < 8; ++e) { const float mine = ga[e], oth = __shfl_xor(mine, 32);
        const float lo = hi ? oth : mine, hh = hi ? mine : oth;
        g[(e & 3) + 8 * (e >> 2)] = lo; g[4 + (e & 3) + 8 * (e >> 2)] = hh; }
    const float NI = -3.0e38f;
    unsigned sel = 0u;
#pragma unroll
    for (int pass = 0; pass < 3; ++pass) { float best = NI; int bi = -1;
#pragma unroll
        for (int n = 0; n < 16; ++n) { const bool ok = (n < j) && (((sel >> n) & 1u) == 0u) && (g[n] > best); best = ok ? g[n] : best; bi = ok ? n : bi; }
        if (bi >= 0) sel |= 1u << bi; }
    for (int n = 0; n < j; ++n) {
        const bool sb = (((sel >> n) & 1u) != 0u) && (hi == 0);
        const unsigned long long mk = __ballot(sb);
        if (mk != 0ull) {
            unsigned base = 0u;
            if (lane == 0) base = atomicAdd(P.SELCNT() + bh * 16 + n, (unsigned)__popcll(mk));
            base = (unsigned)__builtin_amdgcn_readfirstlane((int)base);
            if (sb) { const unsigned pos = base + (unsigned)__popcll(mk & ((1ull << lane) - 1ull)); const unsigned k = (unsigned)__popc(sel & ((1u << n) - 1u));
                if (pos < 4096u) P.LIST()[(size_t)(bh * 16 + n) * 4096 + pos] = (unsigned)t | (k << 12); }
        }
    }
}
__device__ __forceinline__ void moba_kv_item(LAS unsigned char* lds, const Ptrs& P, int bh, int n, int part, bool split) {
    const int tid = opq((P.wave << 6) | lane_id()), lane = tid & 63, wid = __builtin_amdgcn_readfirstlane(tid >> 6), r32 = lane & 31, hi = lane >> 5;
    const int b = bh >> 3, h = bh & 7;
    const float SC = 0.08838834764831845f * LOG2E;
    LAS unsigned char* kb = lds; LAS unsigned char* vb = lds + 69632; LAS float* lut = (LAS float*)(lds + 136192);
    if (tid < 129) lut[tid] = P.rpe[t5_bucket(tid) * 24 + h] * LOG2E;
    const float cbias = P.rpe[31 * 24 + h] * LOG2E;
    {   const int kr = tid >> 4, kc8 = tid & 15, vd = tid >> 5, vk8 = tid & 31;
        u32x4 rg[8], rv[8];
#pragma unroll
        for (int i = 0; i < 8; ++i) rg[i] = *(const u32x4*)(P.PA() + (size_t)(b * SEQ + n * 256 + kr + 32 * i) * NA + C_KA + h * 128 + kc8 * 8);
#pragma unroll
        for (int i = 0; i < 8; ++i) rv[i] = *(const u32x4*)(P.VTA() + ((size_t)(bh * 128 + vd + 16 * i)) * SEQ + n * 256 + vk8 * 8);
#pragma unroll
        for (int i = 0; i < 8; ++i) *(LAS u32x4*)(kb + (kr + 32 * i) * 272 + kc8 * 16) = rg[i];
#pragma unroll
        for (int i = 0; i < 8; ++i) { *(LAS u32x2*)(vb + (vd + 16 * i) * 520 + vk8 * 16) = (u32x2){rv[i].x, rv[i].y}; *(LAS u32x2*)(vb + (vd + 16 * i) * 520 + vk8 * 16 + 8) = (u32x2){rv[i].z, rv[i].w}; }
    }
    int cnt = (int)P.SELCNT()[bh * 16 + n]; cnt = cnt < 4096 ? cnt : 4096; cnt = __builtin_amdgcn_readfirstlane(cnt);
    int beg = 0, end = cnt;
    if (split) { int half = ((cnt >> 1) + 31) & ~31; half = half < cnt ? half : cnt; if (part == 0) end = half; else beg = half; }
    __syncthreads();
    const int ntile = (end - beg + 31) >> 5;
    const unsigned* list = P.LIST() + (size_t)(bh * 16 + n) * 4096;
    bf16x8 qn[8]; unsigned en = 0u; bool vn = false;
    if (wid < ntile) { const int idx = beg + wid * 32 + r32; vn = idx < end; en = list[vn ? idx : beg]; moba_load_q(qn, P, (size_t)(b * SEQ + (int)(en & 4095u)), h, hi); }
#pragma unroll 1
    for (int qt = wid; qt < ntile; qt += 8) {
        const bool valid = vn; const unsigned e = en;
        const int t = (int)(e & 4095u), k = (int)(e >> 12);
        bf16x8 qr[8];
#pragma unroll
        for (int ks = 0; ks < 8; ++ks) qr[ks] = qn[ks];
        if (qt + 8 < ntile) { const int idx = beg + (qt + 8) * 32 + r32; vn = idx < end; en = list[vn ? idx : beg]; moba_load_q(qn, P, (size_t)(b * SEQ + (int)(en & 4095u)), h, hi); }
        float m = NEGF, l = 0.f; f32x16 o[4]; o[0] = f32x16{}; o[1] = f32x16{}; o[2] = f32x16{}; o[3] = f32x16{};
        const bool allfar = (__ballot(t < n * 256 + 383) == 0ull);
#pragma unroll 1
        for (int kvt = 0; kvt < 4; ++kvt) {
            f32x16 p0 = {}, p1 = {};
#pragma unroll
            for (int ks = 0; ks < 8; ++ks) { const bf16x8 k0 = *(const LAS bf16x8*)(kb + (kvt * 64 + r32) * 272 + ks * 32 + hi * 16), k1 = *(const LAS bf16x8*)(kb + (kvt * 64 + 32 + r32) * 272 + ks * 32 + hi * 16);
                p0 = __builtin_amdgcn_mfma_f32_32x32x16_bf16(k0, qr[ks], p0, 0, 0, 0); p1 = __builtin_amdgcn_mfma_f32_32x32x16_bf16(k1, qr[ks], p1, 0, 0, 0); }
            if (allfar) {
#pragma unroll
                for (int r = 0; r < 16; ++r) { p0[r] = p0[r] * SC + cbias; p1[r] = p1[r] * SC + cbias; }
            } else {
                const int dbase = t - n * 256 - 64 * kvt;
#pragma unroll
                for (int g4 = 0; g4 < 4; ++g4) {
#pragma unroll
                    for (int e4 = 0; e4 < 4; ++e4) { const int r = 4 * g4 + e4; const int d0 = dbase - crow(r, hi), d1 = d0 - 32;
                        p0[r] = p0[r] * SC + lut[min(max(d0, 0), 128)]; p1[r] = p1[r] * SC + lut[min(max(d1, 0), 128)]; }
                    __builtin_amdgcn_sched_barrier(0);
                }
            }
            u32x4 pw[4];
            SOFTMAX_TILE(p0, p1, m, l, 4, o, pw);
#pragma unroll
            for (int sl = 0; sl < 4; ++sl)
#pragma unroll
                for (int dt = 0; dt < 4; ++dt) { const LAS unsigned char* vp = vb + (dt * 32 + r32) * 520 + (kvt * 64 + 16 * sl + 4 * hi) * 2;
                    const u32x2 lo = *(const LAS u32x2*)vp, hh = *(const LAS u32x2*)(vp + 16);
                    const u32x4 vf = {lo.x, lo.y, hh.x, hh.y};
                    o[dt] = __builtin_amdgcn_mfma_f32_32x32x16_bf16(__builtin_bit_cast(bf16x8, vf), __builtin_bit_cast(bf16x8, pw[sl]), o[dt], 0, 0, 0); }
        }
        const float lt = l + __shfl_xor(l, 32); const float inv = __builtin_amdgcn_rcpf(lt);
        if (valid) {
            const size_t slot = ((size_t)bh * SEQ + t) * 3 + k;
            if (hi == 0) *(f32x2*)(P.ML() + slot * 2) = (f32x2){m, lt};
            bf16_t* po = P.PO() + slot * 128;
#pragma unroll
            for (int dt = 0; dt < 4; ++dt)
#pragma unroll
                for (int g4 = 0; g4 < 4; ++g4) { const int d = 32 * dt + 8 * g4 + 4 * hi;
                    *(u32x2*)(po + d) = (u32x2){pk2(o[dt][4 * g4] * inv, o[dt][4 * g4 + 1] * inv), pk2(o[dt][4 * g4 + 2] * inv, o[dt][4 * g4 + 3] * inv)}; }
        }
    }
    __syncthreads();
}
__device__ __forceinline__ void moba_own_item(LAS unsigned char* lds, const Ptrs& P, int b, int h, int j) {
    const int tid = opq((P.wave << 6) | lane_id()), lane = tid & 63, wid = __builtin_amdgcn_readfirstlane(tid >> 6), r32 = lane & 31, hi = lane >> 5;
    const float SC = 0.08838834764831845f * LOG2E;
    LAS unsigned char* kb = lds; LAS unsigned char* vb = lds + 69632; LAS float* lut = (LAS float*)(lds + 136192);
    if (tid < 129) lut[tid] = P.rpe[t5_bucket(tid) * 24 + h] * LOG2E;
    const int bh = b * 8 + h;
    const int q_local = 32 * wid + r32, t = j * 256 + q_local; const size_t qrow = (size_t)(b * SEQ + t);
    bf16x8 qr[8]; moba_load_q(qr, P, qrow, h, hi);
    {   const int kr = tid >> 4, kc8 = tid & 15, vd = tid >> 5, vk8 = tid & 31;
        u32x4 rg[8], rv[8];
#pragma unroll
        for (int i = 0; i < 8; ++i) rg[i] = *(const u32x4*)(P.PA() + (size_t)(b * SEQ + j * 256 + kr + 32 * i) * NA + C_KA + h * 128 + kc8 * 8);
#pragma unroll
        for (int i = 0; i < 8; ++i) rv[i] = *(const u32x4*)(P.VTA() + ((size_t)(bh * 128 + vd + 16 * i)) * SEQ + j * 256 + vk8 * 8);
#pragma unroll
        for (int i = 0; i < 8; ++i) *(LAS u32x4*)(kb + (kr + 32 * i) * 272 + kc8 * 16) = rg[i];
#pragma unroll
        for (int i = 0; i < 8; ++i) { *(LAS u32x2*)(vb + (vd + 16 * i) * 520 + vk8 * 16) = (u32x2){rv[i].x, rv[i].y}; *(LAS u32x2*)(vb + (vd + 16 * i) * 520 + vk8 * 16 + 8) = (u32x2){rv[i].z, rv[i].w}; }
    }
    const int nsel = j < 3 ? j : 3;
    const size_t slot0 = ((size_t)bh * SEQ + t) * 3;
    float mk[3], lk[3];
#pragma unroll
    for (int k = 0; k < 3; ++k) { mk[k] = NEGF; lk[k] = 0.f;
        if (k < nsel) { const f32x2 v = *(const f32x2*)(P.ML() + (slot0 + k) * 2); mk[k] = v[0]; lk[k] = v[1]; } }
    __syncthreads();
    float m = NEGF, l = 0.f; f32x16 o[4]; o[0] = f32x16{}; o[1] = f32x16{}; o[2] = f32x16{}; o[3] = f32x16{};
    const int ntt = ((32 * wid + 31) >> 6) + 1;
#pragma unroll 1
    for (int tt = 0; tt < ntt; ++tt) {
        f32x16 p0 = {}, p1 = {};
#pragma unroll
        for (int ks = 0; ks < 8; ++ks) { const bf16x8 k0 = *(const LAS bf16x8*)(kb + (tt * 64 + r32) * 272 + ks * 32 + hi * 16), k1 = *(const LAS bf16x8*)(kb + (tt * 64 + 32 + r32) * 272 + ks * 32 + hi * 16);
            p0 = __builtin_amdgcn_mfma_f32_32x32x16_bf16(k0, qr[ks], p0, 0, 0, 0); p1 = __builtin_amdgcn_mfma_f32_32x32x16_bf16(k1, qr[ks], p1, 0, 0, 0); }
        const int dbase = q_local - 64 * tt;
#pragma unroll
        for (int g4 = 0; g4 < 4; ++g4) {
#pragma unroll
            for (int e4 = 0; e4 < 4; ++e4) { const int r = 4 * g4 + e4; const int d0 = dbase - crow(r, hi), d1 = d0 - 32;
                const float b0 = lut[min(max(d0, 0), 128)], b1 = lut[min(max(d1, 0), 128)];
                p0[r] = (d0 >= 0) ? p0[r] * SC + b0 : NEGF; p1[r] = (d1 >= 0) ? p1[r] * SC + b1 : NEGF; }
            __builtin_amdgcn_sched_barrier(0);
        }
        u32x4 pw[4];
        SOFTMAX_TILE(p0, p1, m, l, 4, o, pw);
#pragma unroll
        for (int sl = 0; sl < 4; ++sl)
#pragma unroll
            for (int dt = 0; dt < 4; ++dt) { const LAS unsigned char* vp = vb + (dt * 32 + r32) * 520 + (tt * 64 + 16 * sl + 4 * hi) * 2;
                const u32x2 lo = *(const LAS u32x2*)vp, hh = *(const LAS u32x2*)(vp + 16);
                const u32x4 vf = {lo.x, lo.y, hh.x, hh.y};
                o[dt] = __builtin_amdgcn_mfma_f32_32x32x16_bf16(__builtin_bit_cast(bf16x8, vf), __builtin_bit_cast(bf16x8, pw[sl]), o[dt], 0, 0, 0); }
    }
    float lown = l + __shfl_xor(l, 32);
    float Mx = m;
#pragma unroll
    for (int k = 0; k < 3; ++k) if (k < nsel) Mx = fmaxf(Mx, mk[k]);
    const float wo = __builtin_amdgcn_exp2f(m - Mx); float L = lown * wo;
#pragma unroll
    for (int dt = 0; dt < 4; ++dt) o[dt] *= wo;
#pragma unroll
    for (int k = 0; k < 3; ++k) if (k < nsel) { const float wk = lk[k] * __builtin_amdgcn_exp2f(mk[k] - Mx); L += wk;
        const bf16_t* po = P.PO() + (slot0 + k) * 128;
#pragma unroll
        for (int dt = 0; dt < 4; ++dt)
#pragma unroll
            for (int g4 = 0; g4 < 4; ++g4) { const u32x2 w = *(const u32x2*)(po + 32 * dt + 8 * g4 + 4 * hi);
                o[dt][4 * g4] += wk * bf_lo(w.x); o[dt][4 * g4 + 1] += wk * bf_hi(w.x); o[dt][4 * g4 + 2] += wk * bf_lo(w.y); o[dt][4 * g4 + 3] += wk * bf_hi(w.y); } }
    const float inv = __builtin_amdgcn_rcpf(L);
#pragma unroll
    for (int dt = 0; dt < 4; ++dt)
#pragma unroll
        for (int g4 = 0; g4 < 4; ++g4) { const int d = 32 * dt + 8 * g4 + 4 * hi;
            const u32x2 gw = *(const u32x2*)(P.PA() + qrow * NA + C_GA + h * 128 + d);
            const float i64 = inv * 16.f; int w8 = 0;
            w8 = __builtin_amdgcn_cvt_pk_fp8_f32(o[dt][4 * g4] * i64 * bf_lo(gw.x), o[dt][4 * g4 + 1] * i64 * bf_hi(gw.x), w8, false); w8 = __builtin_amdgcn_cvt_pk_fp8_f32(o[dt][4 * g4 + 2] * i64 * bf_lo(gw.y), o[dt][4 * g4 + 3] * i64 * bf_hi(gw.y), w8, true);
            *(unsigned*)(P.Y8() + qrow * 2048 + h * 128 + d) = (unsigned)w8; }
    __syncthreads();
}
__device__ const unsigned char MOBA_SCHED[8][3] = {{0 + 32, 9, 255}, {0 + 16 + 32, 10, 13}, {4, 11, 12}, {1 + 32, 8, 14}, {1 + 16 + 32, 7, 255}, {5, 3 + 32, 255}, {2 + 32, 6, 255}, {2 + 16 + 32, 3 + 16 + 32, 255}};

__device__ __forceinline__ void swa_item(LAS unsigned char* lds, const Ptrs& P, int l, int b, int hk, int qblk) {
    const int tid = opq((P.wave << 6) | lane_id()), lane = tid & 63, wid = __builtin_amdgcn_readfirstlane(tid >> 6), r32 = lane & 31, hi = lane >> 5;
    const float SC = 0.125f * LOG2E;
    LAS unsigned char* kb = lds; LAS unsigned char* vb = lds + 36864; LAS float* lut = (LAS float*)(lds + 70144);
    const int kvbase = qblk * 128 - 128;
#pragma unroll
    for (int i = 0; i < 4; ++i) { const int r = (tid >> 3) + 64 * i, c8 = tid & 7, kv = kvbase + r;
        u32x4 w = {0u, 0u, 0u, 0u};
        if (kv >= 0) w = *(const u32x4*)(P.PA() + (size_t)(b * SEQ + kv) * NA + C_KB + hk * 64 + c8 * 8);
        *(LAS u32x4*)(kb + r * 144 + c8 * 16) = w; }
#pragma unroll
    for (int i = 0; i < 4; ++i) { const int d = (tid >> 5) + 16 * i, k8 = tid & 31, kv = kvbase + k8 * 8;
        u32x4 w = {0u, 0u, 0u, 0u};
        if (kv >= 0) w = *(const u32x4*)(P.VTB() + ((size_t)((b * 4 + hk) * 64 + d)) * SEQ + kv);
        *(LAS u32x2*)(vb + d * 520 + k8 * 16) = (u32x2){w.x, w.y}; *(LAS u32x2*)(vb + d * 520 + k8 * 16 + 8) = (u32x2){w.z, w.w}; }
    { const int g = tid >> 7, dist = tid & 127; lut[tid] = P.rpe[t5_bucket(dist) * 24 + 8 + hk * 4 + g] * LOG2E; }
    const int g = wid >> 1, hq = hk * 4 + g;
    const float sink2 = P.sinks[l * 16 + hq] * LOG2E;
    bf16x8 qrs[2][4];
#pragma unroll
    for (int qs = 0; qs < 2; ++qs)
#pragma unroll
        for (int ks = 0; ks < 4; ++ks) qrs[qs][ks] = *(const bf16x8*)(P.PA() + (size_t)(b * SEQ + qblk * 128 + 32 * (2 * (wid & 1) + qs) + r32) * NA + C_QB + hq * 64 + ks * 16 + hi * 8);
    __syncthreads();
#pragma unroll
    for (int qs = 0; qs < 2; ++qs) {
        const int qq = 2 * (wid & 1) + qs, q_local = 32 * qq + r32; const size_t qrow = (size_t)(b * SEQ + qblk * 128 + q_local);
        bf16x8 qr[4];
#pragma unroll
        for (int ks = 0; ks < 4; ++ks) qr[ks] = qrs[qs][ks];
        float m = NEGF, lsum = 0.f; f32x16 o[2]; o[0] = f32x16{}; o[1] = f32x16{};
        const int tk_hi = (32 * qq + 159) >> 6, tk_lo = (32 * qq + 1) >> 6;
#pragma unroll 1
        for (int tk = tk_hi; tk >= tk_lo; --tk) {
            f32x16 p0 = {}, p1 = {};
#pragma unroll
            for (int ks = 0; ks < 4; ++ks) { const bf16x8 k0 = *(const LAS bf16x8*)(kb + (tk * 64 + r32) * 144 + ks * 32 + hi * 16), k1 = *(const LAS bf16x8*)(kb + (tk * 64 + 32 + r32) * 144 + ks * 32 + hi * 16);
                p0 = __builtin_amdgcn_mfma_f32_32x32x16_bf16(k0, qr[ks], p0, 0, 0, 0); p1 = __builtin_amdgcn_mfma_f32_32x32x16_bf16(k1, qr[ks], p1, 0, 0, 0); }
            const int dbase = 128 + q_local - tk * 64;
#pragma unroll
            for (int r = 0; r < 16; ++r) { const int d0 = dbase - crow(r, hi), d1 = d0 - 32;
                const int rb0 = tk * 64 + crow(r, hi), rb1 = rb0 + 32;
                const bool v0 = (d0 >= 0) && (d0 < 128) && (qblk > 0 || rb0 >= 128), v1 = (d1 >= 0) && (d1 < 128) && (qblk > 0 || rb1 >= 128);
                const float b0 = lut[g * 128 + (d0 & 127)], b1 = lut[g * 128 + (d1 & 127)];
                p0[r] = v0 ? p0[r] * SC + b0 : NEGF; p1[r] = v1 ? p1[r] * SC + b1 : NEGF; }
            u32x4 pw[4];
            SOFTMAX_TILE(p0, p1, m, lsum, 2, o, pw);
#pragma unroll
            for (int dt = 0; dt < 2; ++dt)
#pragma unroll
                for (int s = 0; s < 4; ++s) { const LAS unsigned char* vp = vb + (dt * 32 + r32) * 520 + (tk * 64 + 16 * s + 4 * hi) * 2;
                    const u32x2 lo = *(const LAS u32x2*)vp, hh = *(const LAS u32x2*)(vp + 16);
                    const u32x4 vf = {lo.x, lo.y, hh.x, hh.y};
                    o[dt] = __builtin_amdgcn_mfma_f32_32x32x16_bf16(__builtin_bit_cast(bf16x8, vf), __builtin_bit_cast(bf16x8, pw[s]), o[dt], 0, 0, 0); }
        }
        const float lt = lsum + __shfl_xor(lsum, 32) + __builtin_amdgcn_exp2f(sink2 - m); const float inv = __builtin_amdgcn_rcpf(lt);
#pragma unroll
        for (int dt = 0; dt < 2; ++dt)
#pragma unroll
            for (int g4 = 0; g4 < 4; ++g4) { const int d = 32 * dt + 8 * g4 + 4 * hi;
                const u32x2 gw = *(const u32x2*)(P.PA() + qrow * NA + C_GB + hq * 64 + d);
                const float i64 = inv * 16.f; int w8 = 0;
                w8 = __builtin_amdgcn_cvt_pk_fp8_f32(o[dt][4 * g4] * i64 * bf_lo(gw.x), o[dt][4 * g4 + 1] * i64 * bf_hi(gw.x), w8, false); w8 = __builtin_amdgcn_cvt_pk_fp8_f32(o[dt][4 * g4 + 2] * i64 * bf_lo(gw.y), o[dt][4 * g4 + 3] * i64 * bf_hi(gw.y), w8, true);
                *(unsigned*)(P.Y8() + qrow * 2048 + 1024 + hq * 64 + d) = (unsigned)w8; }
    }
    __syncthreads();
}

#define XB_TMO      128
#define XB_XCNT(j)  (256  + 64 * (j))
#define XB_XSUB(j)  (1280 + 64 * (j))
#define XB_XGEN(j)  (2304 + 64 * (j))
#define XB_TOP      3328
#define XB_TOPGEN   3392
#define XCD_BAR_WORDS 3456
#define XB_SPIN_CAP (1u << 18)

__device__ __forceinline__ unsigned xb_ld(unsigned* p)              { return __hip_atomic_load(p, __ATOMIC_RELAXED, __HIP_MEMORY_SCOPE_AGENT); }
__device__ __forceinline__ unsigned xb_add(unsigned* p, unsigned v) { return __hip_atomic_fetch_add(p, v, __ATOMIC_RELAXED, __HIP_MEMORY_SCOPE_AGENT); }
__device__ __forceinline__ unsigned xb_xcc_id() { return (unsigned)__builtin_amdgcn_s_getreg((3 << 11) | 20) & 0xFu; }
#define XB_SPIN(cond, bar) do { unsigned _sp = 0; while (cond) { __builtin_amdgcn_s_sleep(1); \
    if ((++_sp & 255u) == 0u) { if (xb_ld(&(bar)[XB_TMO])) break; if (_sp > XB_SPIN_CAP) { atomicAdd(&(bar)[XB_TMO], 1u); break; } } } } while (0)

struct XcdBarrier {
    unsigned* bar; unsigned x; int wave;
    volatile LAS unsigned* st;
};

__device__ __forceinline__ XcdBarrier xcd_barrier_post(unsigned* bar, volatile LAS unsigned* st, int wave) {
    XcdBarrier b; b.bar = bar; b.x = xb_xcc_id(); b.st = st; b.wave = wave;
    if (wave == 0 && lane_id() == 0) (void)xb_add(&bar[XB_XCNT(b.x)], 1u);
    return b;
}
__device__ __forceinline__ void xcd_barrier_complete(unsigned* bar, unsigned x, unsigned& nloc, unsigned& nx) {
    const unsigned G = gridDim.x * gridDim.y * gridDim.z;
    unsigned sum, cnt, mine, sp = 0u;
    for (;;) {
        sum = 0u; cnt = 0u; mine = 0u;
#pragma unroll
        for (unsigned j = 0; j < 16; ++j) { const unsigned c = xb_ld(&bar[XB_XCNT(j)]); sum += c; cnt += (c > 0u) ? 1u : 0u; mine = (j == x) ? c : mine; }
        if (sum == G) break;
        __builtin_amdgcn_s_sleep(1);
        if ((++sp & 255u) == 0u) { if (xb_ld(&bar[XB_TMO])) break; if (sp > XB_SPIN_CAP) { atomicAdd(&bar[XB_TMO], 1u); break; } }
    }
    nloc = mine > 0u ? mine : 1u; nx = cnt > 0u ? cnt : 1u;
}

__device__ __forceinline__ void xcd_barrier(const XcdBarrier& b) {
    asm volatile("s_waitcnt vmcnt(0)" ::: "memory");
    __syncthreads();
    if (b.wave == 0 && lane_id() == 0) {
        unsigned* bar = launder_s(b.bar);
        __builtin_amdgcn_s_waitcnt(0);
        unsigned nloc = b.st[0], nx = b.st[1];
        if (nloc == 0u) { xcd_barrier_complete(bar, b.x, nloc, nx); b.st[0] = nloc; b.st[1] = nx; }
        const unsigned old = xb_add(&bar[XB_XSUB(b.x)], 1u);
        const unsigned gen = old / nloc;
        if (old + 1u == (gen + 1u) * nloc) {
            __builtin_amdgcn_fence(__ATOMIC_RELEASE, "agent");
            asm volatile("s_waitcnt vmcnt(0)" ::: "memory");
            const unsigned og = xb_add(&bar[XB_TOP], 1u);
            const unsigned tg = og / nx;
            if (og + 1u == (tg + 1u) * nx) xb_add(&bar[XB_TOPGEN], 1u);
            else XB_SPIN(xb_ld(&bar[XB_TOPGEN]) == tg, bar);
            __builtin_amdgcn_fence(__ATOMIC_ACQUIRE, "agent");
            xb_add(&bar[XB_XGEN(b.x)], 1u);
            asm volatile("s_waitcnt vmcnt(0)" ::: "memory");
        } else {
            XB_SPIN(xb_ld(&bar[XB_XGEN(b.x)]) == gen, bar);
            __builtin_amdgcn_fence(__ATOMIC_ACQUIRE, "agent");
            asm volatile("s_waitcnt vmcnt(0)" ::: "memory");
        }
    }
    __syncthreads();
}

template <int l> __device__ __forceinline__ void layer_phases(LAS unsigned char* lds, Ptrs& P, const XcdBarrier& xbar, KArgs kargs, const int lo, const int hi, const int lane0, const int wave, const int G0, const int bx0) {
#define PHASE_BEGIN() P.reload(launder_s(kargs)); const int G = sopq(G0), bx = sopq(bx0); const int lane = opq(lane_id()); const int gw = bx * 8 + wave, NGW = G * 8; (void)gw; (void)NGW; (void)lane
#define IN(k) (lo <= (k) && (k) < hi)
#define SEAM(k) do { if (IN(k) && IN((k) + 1)) xcd_barrier(xbar); } while (0)
        constexpr int pb = 1 + 8 * l;
        if (IN(pb)) {
            PHASE_BEGIN();
#ifndef NO_P1
            { pg8::Gemm g{(const bf16_t*)P.XB8(), (const bf16_t*)(P.WIN8() + (size_t)l * N8 * DM), DM / 2, DM / 2, DM / 2, 0, 0, P.wave}; pg8::StaticOrder S; S.init(M, N8, G, bx);
              pg8::EpiIn E{P.PA(), P.GT(), P.SSQ() + (size_t)(2 * l) * M, 1, 1.f / 512.f};
              pg8::gemm_phase<pg8::EpiIn, pg8::StaticOrder, true, true>(lds, g, S, E); }
            { pg8::Gemm g{P.XB(), P.WINB() + (size_t)l * NB16 * DM, DM, DM, DM, 0, 0, P.wave}; pg8::StaticOrder S; S.init(M, NB16, G, bx);
              pg8::EpiIn E{P.PA(), P.GT(), P.SSQ() + (size_t)(2 * l) * M, 2, 1.f};
              pg8::gemm_phase<pg8::EpiIn, pg8::StaticOrder, true, false>(lds, g, S, E); }
#endif
        }
        SEAM(pb);
        if (IN(pb + 1)) {
            PHASE_BEGIN();
#ifndef NO_P2A
#ifndef REP_P2A
#define REP_P2A 1
#endif
            for (int rep = 0; rep < REP_P2A; ++rep) {
            if (bx == 0) P.SELCNT()[(P.wave << 6) | lane_id()] = 0u;
#ifndef REP_KM
#define REP_KM 1
#endif
#ifndef REP_VT
#define REP_VT 1
#endif
#ifndef REP_LRU
#define REP_LRU 1
#endif
            for (int r2 = 0; r2 < REP_KM; ++r2)
            for (int it = bx; it < BATCH * 8 * 16; it += G) kmean_item(lds, P, it);
            for (int r2 = 0; r2 < REP_VT; ++r2)
            for (int it = gw; it < 5120; it += NGW) vtrans_item(lds + wave * 9216, P, it, lane);
            __syncthreads();
            for (int r2 = 0; r2 < REP_LRU; ++r2)
            lru_local_phase(lds, P, l, bx, G);
            __syncthreads(); }
#endif
        }
        SEAM(pb + 1);
        if (IN(pb + 2)) {
            PHASE_BEGIN();
            for (int it = bx; it < 512; it += G) { const int j = it & 15; if (j > 0) moba_list_item(P, it >> 4, j); }
            for (int it = bx; it < 256; it += G) lru_fix_item(P, it);
            for (int it = bx; it < 512; it += G) swa_item(lds, P, l, it >> 7, (it >> 5) & 3, it & 31);
        }
        SEAM(pb + 2);
        if (IN(pb + 3)) {
            PHASE_BEGIN();
#ifndef REP_KV
#define REP_KV 1
#endif
            for (int rep = 0; rep < REP_KV; ++rep)
            for (int it = bx; it < 256; it += G) { const int bh = it >> 3, sb = it & 7;
#pragma unroll 1
                for (int q = 0; q < 3; ++q) { const int code = MOBA_SCHED[sb][q]; if (code != 255) moba_kv_item(lds, P, bh, code & 15, (code >> 4) & 1, (code & 32) != 0); } }
        }
        SEAM(pb + 3);
        if (IN(pb + 4)) {
            PHASE_BEGIN();
#ifndef REP_OWN
#define REP_OWN 1
#endif
            for (int rep = 0; rep < REP_OWN; ++rep)
            for (int it = bx; it < 256; it += G) { const int bh = it >> 3, sb = it & 7;
                moba_own_item(lds, P, bh >> 3, bh & 7, 15 - sb);
                moba_own_item(lds, P, bh >> 3, bh & 7, sb); }
        }
        SEAM(pb + 4);
        if (IN(pb + 5)) {
            PHASE_BEGIN();
#ifndef NO_P3
            { pg8::Gemm g{(const bf16_t*)P.Y8(), (const bf16_t*)(P.WBR8() + (size_t)l * 2 * DM * 1024), 1024, 512, 512, (size_t)1024, (size_t)DM * 1024, P.wave}; pg8::ZOrder2 S; S.S.init(M, DM, G, bx);
              pg8::EpiMerge E{P.GT(), P.MG(), 1.f / 512.f};
              pg8::gemm_phase<pg8::EpiMerge, pg8::ZOrder2, true, true>(lds, g, S, E); }
            { pg8::Gemm g{P.YC(), P.WBR() + (size_t)(l * 3 + 2) * DM * 1024, 1024, 1024, 1024, 0, 0, P.wave}; pg8::ZFixed S; S.S.init(M, DM, G, bx); S.z = 2;
              pg8::EpiMerge E{P.GT(), P.MG(), 1.f};
              pg8::gemm_phase<pg8::EpiMerge, pg8::ZFixed, true, false>(lds, g, S, E); }
#endif
        }
        SEAM(pb + 5);
        if (IN(pb + 6)) {
            PHASE_BEGIN();
            { pg8::Gemm g{P.MG(), P.WOUT() + (size_t)l * DM * DM, DM, DM, DM, 0, 0, P.wave}; pg8::StaticOrder S; S.init(M, DM, G, bx);
              pg8::EpiOut E{l == 0 ? P.x : P.out, P.X1(), P.XB1(), P.SSQ() + (size_t)(1 + 2 * l) * M};
#ifndef NO_P4
              pg8::gemm_phase<pg8::EpiOut, pg8::StaticOrder, true>(lds, g, S, E);
#endif
            }
            { pg8::Gemm g{P.PB() + (size_t)l * M * PLE, P.WPP() + (size_t)l * DM * PLE, PLE, PLE, PLE, 0, 0, P.wave}; pg8::StaticOrder S; S.init(M, DM, G, bx);
              pg8::EpiPlain E{P.T(), DM};
#ifndef NO_P4T
              pg8::gemm_phase<pg8::EpiPlain, pg8::StaticOrder, true>(lds, g, S, E);
#endif
            }
        }
        SEAM(pb + 6);
        if (IN(pb + 7)) {
            PHASE_BEGIN();
            pg8::Gemm g{P.XB1(), P.WPG() + (size_t)l * DM * DM, DM, DM, DM, 0, 0, P.wave}; pg8::StaticOrder S; S.init(M, DM, G, bx);
            pg8::EpiPle E{P.X1(), P.T(), P.SSQ() + (size_t)(1 + 2 * l) * M, P.out, P.XB(), P.XB8(), P.SSQ() + (size_t)(2 + 2 * l) * M, l + 1 < DEPTH};
#ifndef NO_P5
            pg8::gemm_phase<pg8::EpiPle, pg8::StaticOrder, true>(lds, g, S, E);
#endif
        }
        SEAM(pb + 7);

#undef IN
#undef SEAM
#undef PHASE_BEGIN
}

constexpr int NPH = 18;

__global__ void __launch_bounds__(NTHR, 2) fwd_kernel(Args args) {
    extern __shared__ __attribute__((aligned(16))) unsigned char lds_raw[];
    LAS unsigned char* lds = (LAS unsigned char*)lds_raw;
    cg::grid_group grid = cg::this_grid();
    const int tid = threadIdx.x, lane0 = tid & 63, wave = __builtin_amdgcn_readfirstlane(tid >> 6);
    const int G0 = gridDim.x, bx0 = blockIdx.x;
#define PHASE_BEGIN() P.reload(launder_s(kargs)); const int G = sopq(G0), bx = sopq(bx0); const int lane = opq(lane_id()); const int gw = bx * 8 + wave, NGW = G * 8; (void)gw; (void)NGW; (void)lane
    unsigned char* ws = args.ws;
    Ptrs P;
    KArgs kargs = (KArgs)__builtin_amdgcn_kernarg_segment_ptr();
    P.wave = wave;
    const int lo = args.ph_lo, hi = args.ph_hi;
    volatile LAS unsigned* bst = (volatile LAS unsigned*)(lds + LDS_BYTES - 64);
    if (tid < 2) bst[tid] = 0u;
    __syncthreads();
    const XcdBarrier xbar = xcd_barrier_post((unsigned*)(ws + OFF_BAR), bst, wave);
    if (hi > 1000) grid.sync();
#define IN(k) (lo <= (k) && (k) < hi)
#define SEAM(k) do { if (IN(k) && IN((k) + 1)) xcd_barrier(xbar); } while (0)

#ifndef REP_P0
#define REP_P0 1
#endif
    if (IN(0)) for (int rep0 = 0; rep0 < REP_P0; ++rep0) {
        PHASE_BEGIN();
        LAS float* scr = (LAS float*)(lds + wave * 16640);
        for (int l = 0; l < DEPTH; ++l) {
            { const float* wl = P.w_in + (size_t)l * DM * NIN; const float* ng = P.norm_g + l * DM;
              unsigned char* w8 = P.WIN8() + (size_t)l * N8 * DM; bf16_t* wb = P.WINB() + (size_t)l * NB16 * DM;
              transpose_matrix<true>(wl + 2048, DM, 4608, NIN, w8, ng, 64.f, scr, gw, NGW, lane);
              transpose_matrix<true>(wl + 8704, DM, 6144, NIN, w8 + (size_t)4608 * DM, ng, 64.f, scr, gw, NGW, lane);
              transpose_matrix(wl, DM, 2048, NIN, wb, ng, 1.f, scr, gw, NGW, lane);
              transpose_matrix(wl + 6656, DM, 2048, NIN, wb + (size_t)2048 * DM, ng, 1.f, scr, gw, NGW, lane); }
            for (int z = 0; z < 2; ++z) transpose_matrix<true>(P.w_br + (size_t)(l * 3 + z) * 1024 * DM, 1024, DM, DM, P.WBR8() + (size_t)(l * 2 + z) * DM * 1024, nullptr, 32.f, scr, gw, NGW, lane);
            transpose_matrix(P.w_br + (size_t)(l * 3 + 2) * 1024 * DM, 1024, DM, DM, P.WBR() + (size_t)(l * 3 + 2) * DM * 1024, nullptr, 1.f, scr, gw, NGW, lane);
            transpose_matrix(P.w_out + (size_t)l * DM * DM, DM, DM, DM, P.WOUT() + (size_t)l * DM * DM, nullptr, 1.f, scr, gw, NGW, lane);
            transpose_matrix(P.w_pg + (size_t)l * DM * DM, DM, DM, DM, P.WPG() + (size_t)l * DM * DM, P.ple_g + l * DM, 1.f, scr, gw, NGW, lane);
            transpose_matrix(P.w_pp + (size_t)l * PLE * DM, PLE, DM, DM, P.WPP() + (size_t)l * DM * PLE, nullptr, 1.f, scr, gw, NGW, lane);
            for (int n = 0; n < 8; ++n) {
                transpose_matrix(P.w_r + (size_t)(l * 8 + n) * 16384, 128, 128, 128, P.WR() + (size_t)(l * 8 + n) * 16384, nullptr, 1.f, scr, gw, NGW, lane);
                transpose_matrix(P.w_i + (size_t)(l * 8 + n) * 16384, 128, 128, 128, P.WI() + (size_t)(l * 8 + n) * 16384, nullptr, 1.f, scr, gw, NGW, lane);
            }
        }
        for (int mrow = gw; mrow < M; mrow += NGW) {
            const f32x4* xr = (const f32x4*)(P.x + (size_t)mrow * DM) + lane; u32x2* ob = (u32x2*)(P.XB() + (size_t)mrow * DM) + lane; unsigned* o8 = (unsigned*)(P.XB8() + (size_t)mrow * DM) + lane; float s = 0.f;
            f32x4 xv[8];
#pragma unroll
            for (int jv = 0; jv < 8; ++jv) xv[jv] = xr[64 * jv];
#pragma unroll
            for (int jv = 0; jv < 8; ++jv) { const f32x4 v = xv[jv]; s += (v[0] * v[0] + v[1] * v[1]) + (v[2] * v[2] + v[3] * v[3]); ob[64 * jv] = (u32x2){pk2(v[0], v[1]), pk2(v[2], v[3])};
                int q = 0; q = __builtin_amdgcn_cvt_pk_fp8_f32(v[0] * 8.f, v[1] * 8.f, q, false); q = __builtin_amdgcn_cvt_pk_fp8_f32(v[2] * 8.f, v[3] * 8.f, q, true); o8[64 * jv] = (unsigned)q; }
            s = wave_sum(s);
            if (lane == 0) P.SSQ()[mrow] = s;
        }
        {   const size_t NV = (size_t)DEPTH * M * PLE / 8, stride = (size_t)G * NTHR;
            for (size_t i0 = (size_t)bx * NTHR + tid; i0 < NV; i0 += 4 * stride) {
                f32x4 v0[4], v1[4];
#pragma unroll
                for (int u = 0; u < 4; ++u) { const size_t i = i0 + u * stride; if (i < NV) { v0[u] = *(const f32x4*)(P.p + i * 8); v1[u] = *(const f32x4*)(P.p + i * 8 + 4); } }
#pragma unroll
                for (int u = 0; u < 4; ++u) { const size_t i = i0 + u * stride; if (i < NV) *(u32x4*)(P.PB() + i * 8) = (u32x4){pk2(v0[u][0], v0[u][1]), pk2(v0[u][2], v0[u][3]), pk2(v1[u][0], v1[u][1]), pk2(v1[u][2], v1[u][3])}; }
            } }
        for (int i = bx * NTHR + tid; i < 4 * M; i += G * NTHR) P.SSQ()[M + i] = 0.f;
    }
    SEAM(0);

    layer_phases<0>(lds, P, xbar, kargs, lo, hi, lane0, wave, G0, bx0);
    layer_phases<1>(lds, P, xbar, kargs, lo, hi, lane0, wave, G0, bx0);
    if (IN(17)) {
        PHASE_BEGIN();
        f32x4 gg[8];
        { const f32x4* gr = (const f32x4*)P.fin_g + lane;
#pragma unroll
          for (int jv = 0; jv < 8; ++jv) gg[jv] = gr[64 * jv]; }
        for (int mrow = gw; mrow < M; mrow += 2 * NGW) {
            const int m1 = (mrow + NGW < M) ? mrow + NGW : mrow;
            const float rs0 = rsqrtf(P.SSQ()[(size_t)4 * M + mrow] * (1.f / DM) + EPS), rs1 = rsqrtf(P.SSQ()[(size_t)4 * M + m1] * (1.f / DM) + EPS);
            f32x4* x0 = (f32x4*)(P.out + (size_t)mrow * DM) + lane; f32x4* x1 = (f32x4*)(P.out + (size_t)m1 * DM) + lane;
            f32x4 a[8], b[8];
#pragma unroll
            for (int jv = 0; jv < 8; ++jv) { a[jv] = x0[64 * jv]; b[jv] = x1[64 * jv]; }
#pragma unroll
            for (int jv = 0; jv < 8; ++jv) x0[64 * jv] = a[jv] * rs0 * gg[jv];
            if (m1 != mrow) {
#pragma unroll
                for (int jv = 0; jv < 8; ++jv) x1[64 * jv] = b[jv] * rs1 * gg[jv]; }
        }
    }
#undef IN
#undef SEAM
}

extern "C" void kernel_launch(void* const* d_in, const int* in_sizes, int n_in, void* d_out, int out_size, void* d_ws, size_t ws_size, hipStream_t stream) {
    static int grid = 0;
    if (grid == 0) {
        if (n_in != 19 || out_size != M * DM || ws_size < WS_END) { fprintf(stderr, "kernel_launch: unexpected problem (n_in %d, out %d, ws %zu < %zu)\n", n_in, out_size, ws_size, (size_t)WS_END); grid = -1; return; }
        int dev = 0, cus = 0, per_cu = 0;
        (void)hipGetDevice(&dev); (void)hipDeviceGetAttribute(&cus, hipDeviceAttributeMultiprocessorCount, dev);
        (void)hipFuncSetAttribute((const void*)fwd_kernel, hipFuncAttributeMaxDynamicSharedMemorySize, LDS_BYTES);
        if (hipOccupancyMaxActiveBlocksPerMultiprocessor(&per_cu, (const void*)fwd_kernel, NTHR, LDS_BYTES) != hipSuccess || per_cu < 1) per_cu = 1;
        (void)hipGetLastError();
        grid = cus > 0 ? cus : 256;
    }
    if (grid < 0) return;
    (void)hipMemsetAsync((unsigned char*)d_ws + OFF_BAR, 0, BAR_BYTES, stream);
    Args a{};
    for (int i = 0; i < 19; ++i) a.in[i] = (const float*)d_in[i];
    a.out = (float*)d_out; a.ws = (unsigned char*)d_ws; a.ph_lo = 0; a.ph_hi = NPH;
    void* params[] = {&a};
    hipError_t e = hipLaunchCooperativeKernel((const void*)fwd_kernel, dim3(grid), dim3(NTHR), params, LDS_BYTES, stream);
    if (e != hipSuccess) fprintf(stderr, "cooperative launch failed: %s (grid %d)\n", hipGetErrorString(e), grid);
}
```

```cpp
#include <hip/hip_runtime.h>
#include <hip/hip_cooperative_groups.h>
#include <cstdio>
#include <cstdint>
namespace cg = cooperative_groups;

#define LAS __attribute__((address_space(3)))
typedef unsigned short bf16_t;
typedef short bf16x8 __attribute__((ext_vector_type(8)));
typedef float f32x4 __attribute__((ext_vector_type(4)));
typedef float f32x2 __attribute__((ext_vector_type(2)));
typedef float f32x16 __attribute__((ext_vector_type(16)));
typedef unsigned u32x4 __attribute__((ext_vector_type(4)));
typedef unsigned u32x2 __attribute__((ext_vector_type(2)));
typedef __bf16 bf16x2_t __attribute__((ext_vector_type(2)));

constexpr int BATCH = 4, SEQ = 4096, DM = 2048, M = BATCH * SEQ, DEPTH = 2, PLE = 256;
constexpr int NIN = 14848, NA = 8704, NG = 6144;
constexpr int C_QA = 0, C_KA = 1024, C_VA = 2048, C_GA = 3072, C_QB = 4096, C_KB = 5120, C_VB = 5376, C_GB = 5632, C_XC = 6656, C_GC = 7680;
constexpr float EPS = 1e-6f, LOG2E = 1.4426950408889634f, NEGF = -1e30f;

constexpr size_t SZ_WIN = (size_t)DEPTH * NIN * DM * 2, SZ_WBR = (size_t)DEPTH * 3 * DM * 1024 * 2, SZ_WSQ = (size_t)DEPTH * DM * DM * 2;
constexpr size_t SZ_WPP = (size_t)DEPTH * DM * PLE * 2, SZ_WRI = (size_t)DEPTH * 8 * 128 * 128 * 2;
constexpr int N8 = 10752, NB16 = 4096;
constexpr size_t OFF_WIN = 0, OFF_WIN8 = OFF_WIN, OFF_WINB = OFF_WIN8 + (size_t)DEPTH * N8 * DM, OFF_XB8 = OFF_WINB + (size_t)DEPTH * NB16 * DM * 2, OFF_WBR = OFF_WIN + SZ_WIN, OFF_WOUT = OFF_WBR + SZ_WBR, OFF_WPG = OFF_WOUT + SZ_WSQ, OFF_WPP = OFF_WPG + SZ_WSQ;
constexpr size_t OFF_WR = OFF_WPP + SZ_WPP, OFF_WI = OFF_WR + SZ_WRI;
constexpr size_t OFF_XB = OFF_WI + SZ_WRI;
constexpr size_t OFF_VTA = OFF_XB, OFF_VTB = OFF_XB + (size_t)BATCH * 1024 * SEQ * 2;
constexpr size_t OFF_PA = OFF_XB + (size_t)M * DM * 2;
constexpr size_t OFF_X1 = OFF_PA, OFF_MG = OFF_X1 + (size_t)M * DM * 4, OFF_XB1 = OFF_MG + (size_t)M * DM * 2;
constexpr size_t OFF_GT = OFF_PA + (size_t)M * NA * 2;
constexpr size_t OFF_Y = OFF_GT + (size_t)M * NG * 2;
constexpr size_t OFF_T = OFF_Y;
constexpr size_t OFF_Y8 = OFF_Y, OFF_YC = OFF_Y + (size_t)M * 2048;
constexpr size_t OFF_WBR8 = OFF_XB8 + (size_t)M * DM;
static_assert(OFF_WBR8 + (size_t)DEPTH * 2 * DM * 1024 <= OFF_WBR, "WBR8 fits");
constexpr size_t OFF_PB = OFF_Y + (size_t)M * 3072 * 2;
constexpr size_t OFF_SSQ = OFF_PB + (size_t)DEPTH * M * PLE * 2;
constexpr size_t OFF_KM = OFF_SSQ + (size_t)5 * M * 4;
constexpr size_t OFF_CHA = OFF_KM + (size_t)BATCH * 8 * 16 * 128 * 2, OFF_CHH = OFF_CHA + (size_t)BATCH * 64 * 1024 * 4;
constexpr size_t OFF_BAR = OFF_CHH + (size_t)BATCH * 64 * 1024 * 4, BAR_BYTES = 16384;
constexpr size_t OFF_SELCNT = OFF_BAR + BAR_BYTES;
constexpr size_t OFF_LIST = OFF_SELCNT + 4096;
constexpr size_t OFF_HL = OFF_LIST + (size_t)32 * 16 * 4096 * 4, OFF_CA = OFF_HL + (size_t)M * 1024 * 2;
constexpr size_t OFF_PO = OFF_HL;
constexpr size_t OFF_ML = OFF_PO + (size_t)32 * SEQ * 3 * 128 * 2;
constexpr size_t WS_END = OFF_ML + (size_t)32 * SEQ * 3 * 2 * 4;
static_assert(WS_END <= (size_t)973078528, "workspace budget (4 x largest tensor)");
static_assert(OFF_XB1 + (size_t)M * DM * 2 <= OFF_GT, "overlay fits");
static_assert(OFF_XB8 + (size_t)M * DM <= OFF_WBR, "fp8 / bf16 in-projection weight copies + fp8 x fit the old WIN region");
static_assert(OFF_VTB + (size_t)BATCH * 256 * SEQ * 2 <= OFF_PA, "VT overlay fits");

constexpr int LDS_BYTES = 147456;
constexpr int NTHR = 512;

__device__ __forceinline__ unsigned pk2(float lo, float hi) { f32x2 v = {lo, hi}; bf16x2_t b = __builtin_convertvector(v, bf16x2_t); return __builtin_bit_cast(unsigned, b); }
__device__ __forceinline__ float bf_lo(unsigned u) { return __uint_as_float(u << 16); }
__device__ __forceinline__ float bf_hi(unsigned u) { return __uint_as_float(u & 0xffff0000u); }
__device__ __forceinline__ float sigm(float v) { return __builtin_amdgcn_rcpf(1.f + __expf(-v)); }
__device__ __forceinline__ int opq(int v) { asm volatile("" : "+v"(v)); return v; }
__device__ __forceinline__ int sopq(int v) { asm volatile("" : "+s"(v)); return v; }
template <class T> __device__ __forceinline__ T launder_s(T p) { asm volatile("" : "+s"(p)); return p; }
__device__ __forceinline__ int lane_id() { return (int)__builtin_amdgcn_mbcnt_hi(~0u, __builtin_amdgcn_mbcnt_lo(~0u, 0u)); }
__device__ __forceinline__ int crow(int r, int hi) { return (r & 3) + 8 * (r >> 2) + 4 * hi; }
__device__ __forceinline__ float wave_sum(float v) {
#pragma unroll
    for (int o = 1; o < 64; o <<= 1) v += __shfl_xor(v, o);
    return v;
}
__device__ __forceinline__ int t5_bucket(int n) {
    if (n < 16) return n;
    int b = 16;
    b += (n >= 19); b += (n >= 21); b += (n >= 24); b += (n >= 27); b += (n >= 31); b += (n >= 35); b += (n >= 40); b += (n >= 46);
    b += (n >= 52); b += (n >= 59); b += (n >= 67); b += (n >= 77); b += (n >= 87); b += (n >= 99); b += (n >= 113);
    return b;
}

namespace pg8 {
constexpr int BM = 256, BK = 64, HALF = 128, HTB = HALF * BK * 2, STAGE_BYTES = 8 * HTB, NXCD = 8, WGM = 4;
__device__ __forceinline__ int lds_byte(int r, int c) { const int st = (r >> 4) * 2 + (c >> 5), rr = r & 15, cc = c & 31, ob = rr * 64 + cc * 2; return st * 1024 + (ob ^ (((ob >> 9) & 1) << 5)); }
__device__ __forceinline__ void stage_rc(int b, int& R, int& C) { const int st = b / 1024, sb = b % 1024, swz = sb ^ (((sb >> 9) & 1) << 5); R = (st >> 1) * 16 + swz / 64; C = (st & 1) * 32 + (swz % 64) / 2; }
__device__ __forceinline__ int perm32(int rho) { const int n = rho >> 4, i = rho & 15; return 8 * (i >> 2) + 4 * n + (i & 3); }

typedef int v4i_t __attribute__((ext_vector_type(4)));
typedef int v8i_t __attribute__((ext_vector_type(8)));
__device__ __forceinline__ v8i_t cat8(bf16x8 lo, bf16x8 hi) { return __builtin_shufflevector(__builtin_bit_cast(v4i_t, lo), __builtin_bit_cast(v4i_t, hi), 0, 1, 2, 3, 4, 5, 6, 7); }
__device__ __forceinline__ void glds16_s(const char* sbase, unsigned voff, unsigned ldsbase, int imm) { unsigned keep;
    asm volatile("s_mov_b32 %0, m0\n\ts_add_i32 m0, %3, %4\n\ts_nop 0\n\tglobal_load_lds_dwordx4 %1, %2\n\ts_mov_b32 m0, %0" : "=&s"(keep) : "v"(voff), "s"(sbase), "s"(ldsbase), "i"(imm) : "memory", "scc"); }
struct Unit { int pm, pn, z; };
struct Gemm { const bf16_t* A; const bf16_t* Bt; int lda, ldb, K; size_t zA, zB; int wave; };

struct StaticOrder {
    int nM, nN, nwg, G, c;
    __device__ void init(int M_, int N_, int G_, int c_) { nM = M_ / BM; nN = N_ / BM; nwg = nM * nN; G = G_; c = c_; }
    __device__ bool next(int i, Unit& u) const {
        const long L = (long)i * G + c; if (L >= nwg) return false;
        int wgid = (int)L; { const int q = nwg / NXCD, r = nwg % NXCD, xcd = wgid % NXCD, off = wgid / NXCD; wgid = (xcd < r ? xcd * (q + 1) : r * (q + 1) + (xcd - r) * q) + off; }
        const int nig = WGM * nN, gid = wgid / nig, fm = gid * WGM, gsz = (nM - fm) < WGM ? (nM - fm) : WGM;
        u.pm = fm + ((wgid % nig) % gsz); u.pn = (wgid % nig) / gsz; u.z = 0; return true;
    }
};
struct ZOrder2 {
    StaticOrder S;
    __device__ bool next(int i, Unit& u) const { if (!S.next(i >> 1, u)) return false; u.z = i & 1; return true; }
};
struct ZFixed {
    StaticOrder S; int z;
    __device__ bool next(int i, Unit& u) const { if (!S.next(i, u)) return false; u.z = z; return true; }
};

template <class Epi, class Sched, bool ALIGN_EPI, bool F8 = false>
__device__ __forceinline__ void gemm_phase(LAS unsigned char* lds, const Gemm g, const Sched& S, const Epi& E) {
    const int wid = __builtin_amdgcn_readfirstlane(g.wave), tid = opq((wid << 6) | lane_id()), lane = tid & 63, wr = wid >> 2, wc = wid & 3, fr = lane & 15, fq = lane >> 4;
    const int K = g.K, nt = K / BK;
    unsigned voffA[2], voffB[2];
#pragma unroll
    for (int i = 0; i < 2; ++i) { int R, C; stage_rc(tid * 16 + i * 8192, R, C); const int Rb = (R & ~31) + perm32(R & 31);
        voffA[i] = (unsigned)(R * g.lda + C) * 2u; voffB[i] = (unsigned)(Rb * g.ldb + C) * 2u; }
    const unsigned kstep = (unsigned)(BK * 2);
    const unsigned hstepA = (unsigned)HALF * g.lda * 2u, hstepB = (unsigned)HALF * g.ldb * 2u;
    const unsigned tstepA = 2u * hstepA, tstepB = 2u * hstepB;
    const unsigned ldsw = (unsigned)wid * 1024u;
    const unsigned lds_w32 = (unsigned)__builtin_amdgcn_readfirstlane((int)((unsigned)(uintptr_t)lds + ldsw));
    constexpr int KOFF = F8 ? 16 : 1024;
    const int aoff = lds_byte(wr * 64 + fr, F8 ? fq * 16 : fq * 8), boff = lds_byte(wc * 32 + fr, F8 ? fq * 16 : fq * 8);
#define PG8_SA(b, h) (((b) * 2 + (h)) * HTB)
#define PG8_SB(b, h) ((4 + (b) * 2 + (h)) * HTB)
#define PG8_STAGE_X(bufoff, rs, base, off, voff) do { _Pragma("unroll") for (int _i = 0; _i < 2; ++_i) { \
        if constexpr (F8) __builtin_amdgcn_raw_ptr_buffer_load_lds(rs, (LAS void*)(lds + (bufoff) + ldsw + _i * 8192), 16, (int)(voff)[_i], (int)(unsigned)(off), 0, 0); \
        else __builtin_amdgcn_global_load_lds((const unsigned*)((const char*)(base) + (size_t)((off) + (voff)[_i])), (LAS unsigned*)(lds + (bufoff) + ldsw + _i * 8192), 16, 0, 0); } } while (0)
#define PG8_STAGE_A(bufoff, off) PG8_STAGE_X(bufoff, rsA, g.A, off, voffA)
#define PG8_STAGE_B(bufoff, off) PG8_STAGE_X(bufoff, rsB, g.Bt, off, voffB)
#define PG8_LDA(dst, b, h) do { _Pragma("unroll") for (int m = 0; m < 4; ++m) _Pragma("unroll") for (int k = 0; k < 2; ++k) { const v4i_t f_ = *(const LAS v4i_t*)(lds + PG8_SA(b, h) + aoff + m * 2048 + k * KOFF); dst[m][4 * k] = f_[0]; dst[m][4 * k + 1] = f_[1]; dst[m][4 * k + 2] = f_[2]; dst[m][4 * k + 3] = f_[3]; } } while (0)
#define PG8_LDB(dst, b, h) do { _Pragma("unroll") for (int n = 0; n < 2; ++n) _Pragma("unroll") for (int k = 0; k < 2; ++k) { const v4i_t f_ = *(const LAS v4i_t*)(lds + PG8_SB(b, h) + boff + n * 2048 + k * KOFF); dst[n][4 * k] = f_[0]; dst[n][4 * k + 1] = f_[1]; dst[n][4 * k + 2] = f_[2]; dst[n][4 * k + 3] = f_[3]; } } while (0)
#define PG8_HALF(v, k) __builtin_bit_cast(bf16x8, (v4i_t){v[4 * (k)], v[4 * (k) + 1], v[4 * (k) + 2], v[4 * (k) + 3]})
#define PG8_MMA(ai, bj, At, Bt) do { __builtin_amdgcn_s_setprio(1); \
        if constexpr (F8) { _Pragma("unroll") for (int m = 0; m < 4; ++m) _Pragma("unroll") for (int n = 0; n < 2; ++n) \
            acc[ai][bj][m][n] = __builtin_amdgcn_mfma_scale_f32_16x16x128_f8f6f4(Bt[n], At[m], acc[ai][bj][m][n], 0, 0, 0, 0, 0, 0); }     \
        else { _Pragma("unroll") for (int m = 0; m < 4; ++m) _Pragma("unroll") for (int n = 0; n < 2; ++n) _Pragma("unroll") for (int k = 0; k < 2; ++k) \
            acc[ai][bj][m][n] = __builtin_amdgcn_mfma_f32_16x16x32_bf16(PG8_HALF(Bt[n], k), PG8_HALF(At[m], k), acc[ai][bj][m][n], 0, 0, 0); } \
        __builtin_amdgcn_s_setprio(0); } while (0)
#define PG8_WAIT_V(n) asm volatile("s_waitcnt vmcnt(" #n ")" ::: "memory")
#define PG8_WAIT_L(n) asm volatile("s_waitcnt lgkmcnt(" #n ")" ::: "memory")
#define PG8_BAR __builtin_amdgcn_s_barrier()
#define PG8_SCHED __builtin_amdgcn_sched_barrier(0)
    Unit cur, nxt; int ui = 0;
    if (!S.next(0, cur)) return;
    f32x4 acc[2][2][4][2];
#pragma unroll
    for (int a = 0; a < 2; ++a)
#pragma unroll
        for (int b = 0; b < 2; ++b)
#pragma unroll
            for (int m = 0; m < 4; ++m)
#pragma unroll
                for (int n = 0; n < 2; ++n) acc[a][b][m][n] = (f32x4){0.f, 0.f, 0.f, 0.f};
    v8i_t At[4], B0[2], B1[2];
    unsigned cA = (unsigned)cur.pm * tstepA + (unsigned)cur.z * (unsigned)g.zA, cB = (unsigned)cur.pn * tstepB + (unsigned)cur.z * (unsigned)g.zB;
    __amdgpu_buffer_rsrc_t rsA = __builtin_amdgcn_make_buffer_rsrc((void*)g.A, 0, 0x7fffffff, 0x00020000), rsB = __builtin_amdgcn_make_buffer_rsrc((void*)g.Bt, 0, 0x7fffffff, 0x00020000); (void)rsA; (void)rsB;
    PG8_STAGE_B(PG8_SB(0, 0), cB); PG8_STAGE_B(PG8_SB(0, 1), cB + hstepB); PG8_STAGE_A(PG8_SA(0, 0), cA); PG8_STAGE_A(PG8_SA(0, 1), cA + hstepA);
    if (wr == 1) PG8_BAR;
    PG8_WAIT_V(2); PG8_BAR;
    PG8_STAGE_B(PG8_SB(1, 0), cB + kstep); PG8_STAGE_A(PG8_SA(1, 0), cA + kstep); PG8_STAGE_B(PG8_SB(1, 1), cB + hstepB + kstep);
    PG8_WAIT_V(6); PG8_BAR;
    for (;;) {
        const bool has_next = S.next(ui + 1, nxt);
        const unsigned nA = has_next ? (unsigned)nxt.pm * tstepA + (unsigned)nxt.z * (unsigned)g.zA : cA;
        const unsigned nB = has_next ? (unsigned)nxt.pn * tstepB + (unsigned)nxt.z * (unsigned)g.zB : cB;
#pragma unroll 1
        for (int t = 0; t < nt; t += 2) {
            const bool last = (t == nt - 2);
            const unsigned a1 = cA + (unsigned)(t + 1) * kstep;
            const unsigned a2 = last ? nA : cA + (unsigned)(t + 2) * kstep; const unsigned b2 = last ? nB : cB + (unsigned)(t + 2) * kstep;
            const unsigned a3 = a2 + kstep; const unsigned b3 = b2 + kstep;
            PG8_LDB(B0, 0, 0); PG8_LDB(B1, 0, 1); PG8_SCHED; PG8_LDA(At, 0, 0); PG8_STAGE_A(PG8_SA(1, 1), a1 + hstepA);
            PG8_WAIT_V(8); PG8_WAIT_L(0); PG8_BAR; PG8_MMA(0, 0, At, B0); PG8_MMA(0, 1, At, B1); PG8_BAR; PG8_SCHED;
            PG8_LDA(At, 0, 1); PG8_STAGE_B(PG8_SB(0, 0), b2); PG8_STAGE_B(PG8_SB(0, 1), b2 + hstepB); PG8_STAGE_A(PG8_SA(0, 0), a2);
            PG8_WAIT_V(8); PG8_WAIT_L(0); PG8_BAR; PG8_MMA(1, 0, At, B0); PG8_MMA(1, 1, At, B1); PG8_BAR; PG8_SCHED;
            PG8_LDB(B0, 1, 0); PG8_LDB(B1, 1, 1); PG8_SCHED; PG8_LDA(At, 1, 0); PG8_STAGE_A(PG8_SA(0, 1), a2 + hstepA);
            PG8_WAIT_V(8); PG8_WAIT_L(0); PG8_BAR; PG8_MMA(0, 0, At, B0); PG8_MMA(0, 1, At, B1); PG8_BAR; PG8_SCHED;
            PG8_LDA(At, 1, 1); PG8_STAGE_B(PG8_SB(1, 0), b3); PG8_STAGE_B(PG8_SB(1, 1), b3 + hstepB); PG8_STAGE_A(PG8_SA(1, 0), a3);
            PG8_WAIT_V(8); PG8_WAIT_L(0); PG8_BAR; PG8_MMA(1, 0, At, B0); PG8_MMA(1, 1, At, B1); PG8_BAR; PG8_SCHED;
        }
        if constexpr (ALIGN_EPI) { if (wr == 0) PG8_BAR; }
        { const int l2_ = opq(lane_id()); E(acc, cur, wr, wc, l2_ & 15, l2_ >> 4); }
        if (!has_next) break;
#pragma unroll
        for (int a = 0; a < 2; ++a)
#pragma unroll
            for (int b = 0; b < 2; ++b)
#pragma unroll
                for (int m = 0; m < 4; ++m)
#pragma unroll
                    for (int n = 0; n < 2; ++n) acc[a][b][m][n] = (f32x4){0.f, 0.f, 0.f, 0.f};
        cur = nxt; cA = nA; cB = nB; ++ui;
        if constexpr (ALIGN_EPI) { if (wr == 1) PG8_BAR; }
    }
    PG8_WAIT_V(0);
    if constexpr (!ALIGN_EPI) { if (wr == 0) PG8_BAR; }
    PG8_BAR;
#undef PG8_SA
#undef PG8_SB
#undef PG8_STAGE_X
#undef PG8_STAGE_A
#undef PG8_STAGE_B
#undef PG8_LDA
#undef PG8_LDB
#undef PG8_MMA
#undef PG8_HALF
#undef PG8_WAIT_V
#undef PG8_WAIT_L
#undef PG8_BAR
#undef PG8_SCHED
}

template <int ACT> __device__ __forceinline__ float actf(float v) { if (ACT == 1) return v * sigm(v); if (ACT == 2) return sigm(v); return v; }
template <int ACT> __device__ __forceinline__ u32x4 pack8(f32x4 v0, f32x4 v1, float s) {
    u32x4 w; w.x = pk2(actf<ACT>(v0[0] * s), actf<ACT>(v0[1] * s)); w.y = pk2(actf<ACT>(v0[2] * s), actf<ACT>(v0[3] * s));
    w.z = pk2(actf<ACT>(v1[0] * s), actf<ACT>(v1[1] * s)); w.w = pk2(actf<ACT>(v1[2] * s), actf<ACT>(v1[3] * s)); return w;
}
struct EpiIn {
    bf16_t* PA; bf16_t* GT; const float* ssq; int mode; float oscale;
    template <int ACT> __device__ __forceinline__ void st(const f32x4 (&acc)[2][2][4][2], bf16_t* base, int ldc, int row0, int col0) const {
        float rs[2][4];
#pragma unroll
        for (int ai = 0; ai < 2; ++ai)
#pragma unroll
            for (int m = 0; m < 4; ++m) rs[ai][m] = ssq[row0 + ai * HALF + m * 16];
#pragma unroll
        for (int ai = 0; ai < 2; ++ai)
#pragma unroll
            for (int m = 0; m < 4; ++m) { const int row = row0 + ai * HALF + m * 16; const float r = rsqrtf(rs[ai][m] * (1.f / DM) + EPS) * oscale;
                bf16_t* rowp = base + (size_t)row * ldc + col0;
#pragma unroll
                for (int bj = 0; bj < 2; ++bj) *(u32x4*)(rowp + bj * HALF) = pack8<ACT>(acc[ai][bj][m][0], acc[ai][bj][m][1], r); }
    }
    __device__ __forceinline__ void operator()(const f32x4 (&acc)[2][2][4][2], const Unit& u, int wr, int wc, int fr, int fq) const {
        const int pn = (mode == 1) ? (u.pn < 18 ? u.pn + 8 : u.pn + 16) : (u.pn < 8 ? u.pn : u.pn + 18), row0 = u.pm * BM + wr * 64 + fr;
        if (pn >= 34) { st<2>(acc, GT, NG, row0, (pn - 34) * BM + wc * 32 + 8 * fq); }
        else { const int col0 = pn * BM + wc * 32 + 8 * fq;
            const bool silu = (pn >= 12 && pn < 16) || (pn >= 22 && pn < 26) || (pn >= 30);
            if (silu) st<1>(acc, PA, NA, row0, col0); else st<0>(acc, PA, NA, row0, col0); }
    }
};
struct EpiPlain {
    bf16_t* O; int ldc;
    __device__ __forceinline__ void operator()(const f32x4 (&acc)[2][2][4][2], const Unit& u, int wr, int wc, int fr, int fq) const {
        const int row0 = u.pm * BM + wr * 64 + fr, col0 = u.pn * BM + wc * 32 + 8 * fq;
#pragma unroll
        for (int ai = 0; ai < 2; ++ai)
#pragma unroll
            for (int m = 0; m < 4; ++m) { bf16_t* rowp = O + (size_t)(row0 + ai * HALF + m * 16) * ldc + col0;
#pragma unroll
                for (int bj = 0; bj < 2; ++bj) *(u32x4*)(rowp + bj * HALF) = pack8<0>(acc[ai][bj][m][0], acc[ai][bj][m][1], 1.f); }
    }
};
struct EpiMerge {
    const bf16_t* GT; bf16_t* MG; float oscale;
    __device__ __forceinline__ void operator()(const f32x4 (&acc)[2][2][4][2], const Unit& u, int wr, int wc, int fr, int fq) const {
        const int row0 = u.pm * BM + wr * 64 + fr, col0 = u.pn * BM + wc * 32 + 8 * fq, z = u.z;
#pragma unroll
        for (int ai = 0; ai < 2; ++ai)
#pragma unroll
            for (int bj = 0; bj < 2; ++bj) { const int col = col0 + bj * HALF;
                u32x4 gw[4], tw[4];
#pragma unroll
                for (int m = 0; m < 4; ++m) { const size_t row = (size_t)(row0 + ai * HALF + m * 16);
                    gw[m] = *(const u32x4*)(GT + row * NG + z * DM + col);
                    tw[m] = (z > 0) ? *(const u32x4*)(MG + row * DM + col) : (u32x4){0u, 0u, 0u, 0u}; }
#pragma unroll
                for (int m = 0; m < 4; ++m) { const size_t row = (size_t)(row0 + ai * HALF + m * 16);
                    const f32x4 a0 = acc[ai][bj][m][0] * oscale, a1 = acc[ai][bj][m][1] * oscale; u32x4 w;
                    w.x = pk2(a0[0] * bf_lo(gw[m].x) + bf_lo(tw[m].x), a0[1] * bf_hi(gw[m].x) + bf_hi(tw[m].x));
                    w.y = pk2(a0[2] * bf_lo(gw[m].y) + bf_lo(tw[m].y), a0[3] * bf_hi(gw[m].y) + bf_hi(tw[m].y));
                    w.z = pk2(a1[0] * bf_lo(gw[m].z) + bf_lo(tw[m].z), a1[1] * bf_hi(gw[m].z) + bf_hi(tw[m].z));
                    w.w = pk2(a1[2] * bf_lo(gw[m].w) + bf_lo(tw[m].w), a1[3] * bf_hi(gw[m].w) + bf_hi(tw[m].w));
                    *(u32x4*)(MG + row * DM + col) = w; } }
    }
};
struct EpiOut {
    const float* xin; float* X1; bf16_t* XB1; float* ssq;
    __device__ __forceinline__ void operator()(const f32x4 (&acc)[2][2][4][2], const Unit& u, int wr, int wc, int fr, int fq) const {
        const int row0 = u.pm * BM + wr * 64 + fr, col0 = u.pn * BM + wc * 32 + 8 * fq;
#pragma unroll
        for (int ai = 0; ai < 2; ++ai) { float s[4] = {0.f, 0.f, 0.f, 0.f};
#pragma unroll
            for (int bj = 0; bj < 2; ++bj) { f32x4 x0[4], x1[4];
#pragma unroll
                for (int m = 0; m < 4; ++m) { const size_t o = (size_t)(row0 + ai * HALF + m * 16) * DM + col0 + bj * HALF; x0[m] = *(const f32x4*)(xin + o); x1[m] = *(const f32x4*)(xin + o + 4); }
#pragma unroll
                for (int m = 0; m < 4; ++m) { const size_t o = (size_t)(row0 + ai * HALF + m * 16) * DM + col0 + bj * HALF;
                    const f32x4 v0 = x0[m] + acc[ai][bj][m][0], v1 = x1[m] + acc[ai][bj][m][1];
                    *(f32x4*)(X1 + o) = v0; *(f32x4*)(X1 + o + 4) = v1;
                    u32x4 w; w.x = pk2(v0[0], v0[1]); w.y = pk2(v0[2], v0[3]); w.z = pk2(v1[0], v1[1]); w.w = pk2(v1[2], v1[3]); *(u32x4*)(XB1 + o) = w;
                    s[m] += (v0[0] * v0[0] + v0[1] * v0[1]) + (v0[2] * v0[2] + v0[3] * v0[3]) + (v1[0] * v1[0] + v1[1] * v1[1]) + (v1[2] * v1[2] + v1[3] * v1[3]); } }
#pragma unroll
            for (int m = 0; m < 4; ++m) { float t = s[m]; t += __shfl_xor(t, 16); t += __shfl_xor(t, 32);
                if (fq == 0) atomicAdd(ssq + (row0 + ai * HALF + m * 16), t); } }
    }
};
struct EpiPle {
    const float* X1; const bf16_t* T; const float* ssq1; float* xout; bf16_t* XB; unsigned char* XB8; float* ssq2; bool wxb;
    __device__ __forceinline__ void operator()(const f32x4 (&acc)[2][2][4][2], const Unit& u, int wr, int wc, int fr, int fq) const {
        const int row0 = u.pm * BM + wr * 64 + fr, col0 = u.pn * BM + wc * 32 + 8 * fq;
        float rsv[2][4];
#pragma unroll
        for (int ai = 0; ai < 2; ++ai)
#pragma unroll
            for (int m = 0; m < 4; ++m) rsv[ai][m] = ssq1[row0 + ai * HALF + m * 16];
#pragma unroll
        for (int ai = 0; ai < 2; ++ai) { float s[4] = {0.f, 0.f, 0.f, 0.f};
#pragma unroll
            for (int bj = 0; bj < 2; ++bj)
#pragma unroll
              for (int mh = 0; mh < 2; ++mh) { f32x4 x0[2], x1[2]; u32x4 tw[2];
#pragma unroll
                for (int mm = 0; mm < 2; ++mm) { const int m = 2 * mh + mm; const size_t o = (size_t)(row0 + ai * HALF + m * 16) * DM + col0 + bj * HALF; x0[mm] = *(const f32x4*)(X1 + o); x1[mm] = *(const f32x4*)(X1 + o + 4); tw[mm] = *(const u32x4*)(T + o); }
#pragma unroll
                for (int mm = 0; mm < 2; ++mm) { const int m = 2 * mh + mm; const size_t o = (size_t)(row0 + ai * HALF + m * 16) * DM + col0 + bj * HALF;
                    const float rs = rsqrtf(rsv[ai][m] * (1.f / DM) + EPS);
                    const f32x4 a0 = acc[ai][bj][m][0], a1 = acc[ai][bj][m][1]; f32x4 v0 = x0[mm], v1 = x1[mm];
                    v0[0] += sigm(a0[0] * rs) * bf_lo(tw[mm].x); v0[1] += sigm(a0[1] * rs) * bf_hi(tw[mm].x); v0[2] += sigm(a0[2] * rs) * bf_lo(tw[mm].y); v0[3] += sigm(a0[3] * rs) * bf_hi(tw[mm].y);
                    v1[0] += sigm(a1[0] * rs) * bf_lo(tw[mm].z); v1[1] += sigm(a1[1] * rs) * bf_hi(tw[mm].z); v1[2] += sigm(a1[2] * rs) * bf_lo(tw[mm].w); v1[3] += sigm(a1[3] * rs) * bf_hi(tw[mm].w);
                    *(f32x4*)(xout + o) = v0; *(f32x4*)(xout + o + 4) = v1;
                    if (wxb) { u32x4 w; w.x = pk2(v0[0], v0[1]); w.y = pk2(v0[2], v0[3]); w.z = pk2(v1[0], v1[1]); w.w = pk2(v1[2], v1[3]); *(u32x4*)(XB + o) = w;
                        int q0 = 0, q1 = 0; q0 = __builtin_amdgcn_cvt_pk_fp8_f32(v0[0] * 8.f, v0[1] * 8.f, q0, false); q0 = __builtin_amdgcn_cvt_pk_fp8_f32(v0[2] * 8.f, v0[3] * 8.f, q0, true);
                        q1 = __builtin_amdgcn_cvt_pk_fp8_f32(v1[0] * 8.f, v1[1] * 8.f, q1, false); q1 = __builtin_amdgcn_cvt_pk_fp8_f32(v1[2] * 8.f, v1[3] * 8.f, q1, true);
                        *(u32x2*)(XB8 + o) = (u32x2){(unsigned)q0, (unsigned)q1}; }
                    s[m] += (v0[0] * v0[0] + v0[1] * v0[1]) + (v0[2] * v0[2] + v0[3] * v0[3]) + (v1[0] * v1[0] + v1[1] * v1[1]) + (v1[2] * v1[2] + v1[3] * v1[3]); } }
#pragma unroll
            for (int m = 0; m < 4; ++m) { float t = s[m]; t += __shfl_xor(t, 16); t += __shfl_xor(t, 32);
                if (fq == 0) atomicAdd(ssq2 + (row0 + ai * HALF + m * 16), t); } }
    }
};
}

template <bool F8> __device__ __forceinline__ void transpose_item(const float* W, int K, int N, int ld, void* WTv, const float* kscale, float wscale, LAS float* scr, int item, int lane_) {
    const int lane = opq(lane_);
    const int nblk = N / 64, kb = item / nblk, nb = item % nblk, k0 = 64 * kb, n0 = 64 * nb;
    float v[64];
#pragma unroll
    for (int kk = 0; kk < 64; ++kk) v[kk] = W[(size_t)(k0 + kk) * ld + n0 + lane];
#pragma unroll
    for (int kk = 0; kk < 64; ++kk) { const float sc = (kscale ? kscale[k0 + kk] : 1.f) * wscale; scr[kk * 65 + lane] = v[kk] * sc; }
    if constexpr (F8) {
        unsigned char* WT = (unsigned char*)WTv; const int c = lane & 3;
#pragma unroll
        for (int j = 0; j < 4; ++j) { const int n = (lane >> 2) + 16 * j; const LAS float* s = scr + (16 * c) * 65 + n; int q[4];
#pragma unroll
            for (int d = 0; d < 4; ++d) { int w = 0; w = __builtin_amdgcn_cvt_pk_fp8_f32(s[(4 * d) * 65], s[(4 * d + 1) * 65], w, false); w = __builtin_amdgcn_cvt_pk_fp8_f32(s[(4 * d + 2) * 65], s[(4 * d + 3) * 65], w, true); q[d] = w; }
            *(u32x4*)(WT + (size_t)(n0 + n) * K + k0 + 16 * c) = (u32x4){(unsigned)q[0], (unsigned)q[1], (unsigned)q[2], (unsigned)q[3]}; }
    } else {
        bf16_t* WT = (bf16_t*)WTv; const int c = lane & 7;
#pragma unroll
        for (int j = 0; j < 8; ++j) { const int n = (lane >> 3) + 8 * j; const LAS float* s = scr + (8 * c) * 65 + n;
            u32x4 o; o.x = pk2(s[0 * 65], s[1 * 65]); o.y = pk2(s[2 * 65], s[3 * 65]); o.z = pk2(s[4 * 65], s[5 * 65]); o.w = pk2(s[6 * 65], s[7 * 65]);
            *(u32x4*)(WT + (size_t)(n0 + n) * K + k0 + 8 * c) = o; }
    }
}
template <bool F8 = false> __device__ __forceinline__ void transpose_matrix(const float* W, int K, int N, int ld, void* WT, const float* kscale, float wscale, LAS float* scr, int gw, int NGW, int lane) {
    const int nitems = (K / 64) * (N / 64);
    for (int it = gw; it < nitems; it += NGW) transpose_item<F8>(W, K, N, ld, WT, kscale, wscale, scr, it, lane);
}

struct Args { const float* in[19]; float* out; unsigned char* ws; int ph_lo, ph_hi; };
typedef const __attribute__((address_space(4))) Args* KArgs;
struct Ptrs {
    __device__ __forceinline__ void reload(KArgs a) {
        x = a->in[0]; p = a->in[1]; rpe = a->in[2]; norm_g = a->in[3]; w_in = a->in[4]; sinks = a->in[5]; conv_w = a->in[6]; conv_b = a->in[7]; w_r = a->in[8]; b_r = a->in[9]; w_i = a->in[10];
        b_i = a->in[11]; lam = a->in[12]; w_br = a->in[13]; w_out = a->in[14]; ple_g = a->in[15]; w_pg = a->in[16]; w_pp = a->in[17]; fin_g = a->in[18]; out = a->out; ws = a->ws; }
    const float *x, *p, *rpe, *norm_g, *w_in, *sinks, *conv_w, *conv_b, *w_r, *b_r, *w_i, *b_i, *lam, *w_br, *w_out, *ple_g, *w_pg, *w_pp, *fin_g;
    float* out; unsigned char* ws; int wave;
#define WSP(NAME, TYPE, OFF) __device__ __forceinline__ TYPE* NAME() const { return (TYPE*)(ws + (OFF)); }
    WSP(WIN8, unsigned char, OFF_WIN8) WSP(WINB, bf16_t, OFF_WINB) WSP(XB8, unsigned char, OFF_XB8) WSP(WBR, bf16_t, OFF_WBR) WSP(WOUT, bf16_t, OFF_WOUT) WSP(WPG, bf16_t, OFF_WPG) WSP(WPP, bf16_t, OFF_WPP) WSP(WR, bf16_t, OFF_WR) WSP(WI, bf16_t, OFF_WI)
    WSP(XB, bf16_t, OFF_XB) WSP(VTA, bf16_t, OFF_VTA) WSP(VTB, bf16_t, OFF_VTB) WSP(PA, bf16_t, OFF_PA) WSP(MG, bf16_t, OFF_MG) WSP(XB1, bf16_t, OFF_XB1) WSP(GT, bf16_t, OFF_GT)
    WSP(Y8, unsigned char, OFF_Y8) WSP(YC, bf16_t, OFF_YC) WSP(WBR8, unsigned char, OFF_WBR8) WSP(T, bf16_t, OFF_T) WSP(HL, bf16_t, OFF_HL) WSP(CA, bf16_t, OFF_CA) WSP(PB, bf16_t, OFF_PB) WSP(KM, bf16_t, OFF_KM)
    WSP(X1, float, OFF_X1) WSP(SSQ, float, OFF_SSQ) WSP(CHA, float, OFF_CHA) WSP(CHH, float, OFF_CHH)
    WSP(SELCNT, unsigned, OFF_SELCNT) WSP(LIST, unsigned, OFF_LIST) WSP(PO, bf16_t, OFF_PO) WSP(ML, float, OFF_ML)
#undef WSP
};

__device__ __forceinline__ void kmean_item(LAS unsigned char* lds, const Ptrs& P, int it) {
    const int tid = opq((P.wave << 6) | lane_id()), b = it >> 7, h = (it >> 4) & 7, n = it & 15;
    const int rg = tid >> 4, c8 = tid & 15;
    float s0 = 0.f, s1 = 0.f, s2 = 0.f, s3 = 0.f, s4 = 0.f, s5 = 0.f, s6 = 0.f, s7 = 0.f;
#pragma unroll
    for (int i = 0; i < 8; ++i) { const int row = rg + 32 * i;
        const u32x4 w = *(const u32x4*)(P.PA() + (size_t)(b * SEQ + n * 256 + row) * NA + C_KA + h * 128 + c8 * 8);
        s0 += bf_lo(w.x); s1 += bf_hi(w.x); s2 += bf_lo(w.y); s3 += bf_hi(w.y); s4 += bf_lo(w.z); s5 += bf_hi(w.z); s6 += bf_lo(w.w); s7 += bf_hi(w.w); }
    LAS float* red = (LAS float*)lds;
    LAS float* rp = red + rg * 128 + c8 * 8;
    rp[0] = s0; rp[1] = s1; rp[2] = s2; rp[3] = s3; rp[4] = s4; rp[5] = s5; rp[6] = s6; rp[7] = s7;
    __syncthreads();
    if (tid < 128) { float s = 0.f;
#pragma unroll 8
        for (int r = 0; r < 32; ++r) s += red[r * 128 + tid];
        P.KM()[(size_t)it * 128 + tid] = (bf16_t)(pk2(s * (1.f / 256.f), 0.f) & 0xffffu); }
    __syncthreads();
}
__device__ __forceinline__ void vtrans_item(LAS unsigned char* scr, const Ptrs& P, int it, int lane_) {
    const int lane = opq(lane_);
    int b, tt, colbase; bf16_t* dst0;
    if (it < 4096) { b = it >> 10; const int r = it & 1023; tt = r >> 4; const int ct = r & 15; colbase = C_VA + ct * 64; dst0 = P.VTA() + ((size_t)(b * 1024 + ct * 64) * SEQ + tt * 64); }
    else { it -= 4096; b = it >> 8; const int r = it & 255; tt = r >> 2; const int ct = r & 3; colbase = C_VB + ct * 64; dst0 = P.VTB() + ((size_t)(b * 256 + ct * 64) * SEQ + tt * 64); }
#pragma unroll
    for (int i = 0; i < 8; ++i) { const int row = i * 8 + (lane >> 3), c8 = lane & 7;
        const u32x4 w = *(const u32x4*)(P.PA() + (size_t)(b * SEQ + tt * 64 + row) * NA + colbase + c8 * 8);
        *(LAS u32x4*)(scr + row * 144 + c8 * 16) = w; }
#pragma unroll
    for (int i = 0; i < 8; ++i) { const int c = (lane >> 3) + 8 * i, tg = lane & 7; unsigned e[8];
#pragma unroll
        for (int k = 0; k < 8; ++k) e[k] = *(const LAS unsigned short*)(scr + (tg * 8 + k) * 144 + c * 2);
        u32x4 o; o.x = e[0] | (e[1] << 16); o.y = e[2] | (e[3] << 16); o.z = e[4] | (e[5] << 16); o.w = e[6] | (e[7] << 16);
        *(u32x4*)(dst0 + (size_t)c * SEQ + tg * 8) = o; }
}
__device__ __forceinline__ void lru_local_phase(LAS unsigned char* lds, const Ptrs& P, int l, int bx, int G) {
    const int tid = opq((P.wave << 6) | lane_id()), lane = tid & 63, wid = __builtin_amdgcn_readfirstlane(tid >> 6);
    constexpr int NIT = BATCH * 64 * 8;
    u32x4 xw[4][2];
#define LRU_LOAD(itx) do { const int b_ = (itx) >> 9, c_ = ((itx) >> 3) & 63, n_ = (itx) & 7; \
        _Pragma("unroll") for (int w = 0; w < 4; ++w) { int tt_ = c_ * 64 + (tid >> 3) - 3 + w; tt_ = tt_ < 0 ? 0 : tt_; \
            const bf16_t* src_ = P.PA() + (size_t)(b_ * SEQ + tt_) * NA + C_XC + n_ * 128 + (tid & 7) * 16; \
            xw[w][0] = *(const u32x4*)src_; xw[w][1] = *(const u32x4*)(src_ + 8); } } while (0)
    if (bx < NIT) LRU_LOAD(bx);
    int n_cur = -1; bf16x8 br[4], bi[4]; float brv = 0.f, biv = 0.f, c8sp = 0.f; f32x4 cbv[4], cwv[4][4];
#pragma unroll 1
    for (int it = bx; it < NIT; it += G) {
    const int b = it >> 9, c = (it >> 3) & 63, n = it & 7, t0 = c * 64, ch0 = n * 128;
    const int col = lane & 15, quad = lane >> 4, d0 = 16 * wid, ch = ch0 + d0 + col;
    if (n != n_cur) {
        n_cur = n;
        const size_t wofs = ((size_t)(l * 8 + n) * 128 + d0 + col) * 128 + quad * 8;
#pragma unroll
        for (int ks = 0; ks < 4; ++ks) { br[ks] = *(const bf16x8*)(P.WR() + wofs + ks * 32); bi[ks] = *(const bf16x8*)(P.WI() + wofs + ks * 32); }
        brv = P.b_r[l * 1024 + ch]; biv = P.b_i[l * 1024 + ch]; c8sp = -8.f * log1pf(__expf(-P.lam[l * 1024 + ch]));
        const int chb_ = ch0 + (tid & 7) * 16;
#pragma unroll
        for (int q = 0; q < 4; ++q) cbv[q] = *(const f32x4*)(P.conv_b + l * 1024 + chb_ + 4 * q);
#pragma unroll
        for (int w = 0; w < 4; ++w)
#pragma unroll
            for (int q = 0; q < 4; ++q) cwv[w][q] = *(const f32x4*)(P.conv_w + (size_t)(l * 4 + w) * 1024 + chb_ + 4 * q);
    }
    LAS unsigned char* convb = lds;
    LAS float* convf = (LAS float*)(lds + 17408);
    LAS unsigned char* hlS = lds + 51200;
    LAS unsigned char* caS = lds + 68608;
    {
        const int t = tid >> 3, cg8 = tid & 7, chb = ch0 + cg8 * 16;
        float a[16];
#pragma unroll
        for (int q = 0; q < 4; ++q) { const f32x4 v = cbv[q]; a[4 * q] = v[0]; a[4 * q + 1] = v[1]; a[4 * q + 2] = v[2]; a[4 * q + 3] = v[3]; }
#pragma unroll
        for (int w = 0; w < 4; ++w) { const int tt = t0 + t - 3 + w; const float msk = tt >= 0 ? 1.f : 0.f;
#pragma unroll
            for (int hh = 0; hh < 2; ++hh) { const u32x4 xv = xw[w][hh]; const f32x4 w0 = cwv[w][2 * hh] * msk, w1 = cwv[w][2 * hh + 1] * msk;
                a[8 * hh + 0] += w0[0] * bf_lo(xv.x); a[8 * hh + 1] += w0[1] * bf_hi(xv.x); a[8 * hh + 2] += w0[2] * bf_lo(xv.y); a[8 * hh + 3] += w0[3] * bf_hi(xv.y);
                a[8 * hh + 4] += w1[0] * bf_lo(xv.z); a[8 * hh + 5] += w1[1] * bf_hi(xv.z); a[8 * hh + 6] += w1[2] * bf_lo(xv.w); a[8 * hh + 7] += w1[3] * bf_hi(xv.w); } }
#pragma unroll
        for (int q = 0; q < 4; ++q) *(LAS f32x4*)(convf + t * 132 + cg8 * 16 + 4 * q) = (f32x4){a[4 * q], a[4 * q + 1], a[4 * q + 2], a[4 * q + 3]};
#pragma unroll
        for (int hh = 0; hh < 2; ++hh) { u32x4 o; o.x = pk2(a[8 * hh], a[8 * hh + 1]); o.y = pk2(a[8 * hh + 2], a[8 * hh + 3]); o.z = pk2(a[8 * hh + 4], a[8 * hh + 5]); o.w = pk2(a[8 * hh + 6], a[8 * hh + 7]);
            *(LAS u32x4*)(convb + t * 272 + cg8 * 32 + hh * 16) = o; }
    }
    __syncthreads();
    if (it + G < NIT) LRU_LOAD(it + G);
    f32x4 accr[4], acci[4];
    {
#pragma unroll
        for (int m = 0; m < 4; ++m) { accr[m] = (f32x4){0.f, 0.f, 0.f, 0.f}; acci[m] = (f32x4){0.f, 0.f, 0.f, 0.f};
#pragma unroll
            for (int ks = 0; ks < 4; ++ks) { const bf16x8 av = *(const LAS bf16x8*)(convb + (m * 16 + col) * 272 + (ks * 32 + quad * 8) * 2);
                accr[m] = __builtin_amdgcn_mfma_f32_16x16x32_bf16(av, br[ks], accr[m], 0, 0, 0);
                acci[m] = __builtin_amdgcn_mfma_f32_16x16x32_bf16(av, bi[ks], acci[m], 0, 0, 0); } }
    }
    {
        float Ac = 1.f, Hc = 0.f;
#pragma unroll
        for (int m = 0; m < 4; ++m) {
            float hl[4], Pl[4]; float h = 0.f, Pp = 1.f;
#pragma unroll
            for (int jj = 0; jj < 4; ++jj) { const int tok = m * 16 + quad * 4 + jj;
                const float r = sigm(accr[m][jj] + brv), ig = sigm(acci[m][jj] + biv);
                const float la = c8sp * r, av = __expf(la);
                const float bm = __builtin_amdgcn_sqrtf(fmaxf(1.f - __expf(2.f * la), 0.f));
                const float bb = bm * ig * convf[tok * 132 + d0 + col];
                h = av * h + bb; Pp *= av; hl[jj] = h; Pl[jj] = Pp; }
            const float A0 = __shfl(Pp, col), A1 = __shfl(Pp, col + 16), A2 = __shfl(Pp, col + 32), A3 = __shfl(Pp, col + 48);
            const float H0 = __shfl(h, col), H1 = __shfl(h, col + 16), H2 = __shfl(h, col + 32), H3 = __shfl(h, col + 48);
            float Ain = 1.f, Hin = 0.f;
            if (quad > 0) { Hin = H0; Ain = A0; }
            if (quad > 1) { Hin = A1 * Hin + H1; Ain *= A1; }
            if (quad > 2) { Hin = A2 * Hin + H2; Ain *= A2; }
            const float At = A0 * A1 * A2 * A3, Ht = ((H0 * A1 + H1) * A2 + H2) * A3 + H3;
            const float Hstart = Ain * Hc + Hin, Pstart = Ac * Ain;
#pragma unroll
            for (int jj = 0; jj < 4; ++jj) { const int tok = m * 16 + quad * 4 + jj;
                *(LAS unsigned short*)(hlS + tok * 272 + (d0 + col) * 2) = (unsigned short)(pk2(Pl[jj] * Hstart + hl[jj], 0.f) & 0xffffu);
                *(LAS unsigned short*)(caS + tok * 272 + (d0 + col) * 2) = (unsigned short)(pk2(Pstart * Pl[jj], 0.f) & 0xffffu); }
            Hc = At * Hc + Ht; Ac *= At;
        }
        if (quad == 0) { P.CHA()[(size_t)(b * 64 + c) * 1024 + ch] = Ac; P.CHH()[(size_t)(b * 64 + c) * 1024 + ch] = Hc; }
    }
    __syncthreads();
    {
        const int t = tid >> 3, cg8 = tid & 7; const size_t o = (size_t)(b * SEQ + t0 + t) * 1024 + ch0 + cg8 * 16;
#pragma unroll
        for (int hh = 0; hh < 2; ++hh) { *(u32x4*)(P.HL() + o + 8 * hh) = *(const LAS u32x4*)(hlS + t * 272 + cg8 * 32 + hh * 16); *(u32x4*)(P.CA() + o + 8 * hh) = *(const LAS u32x4*)(caS + t * 272 + cg8 * 32 + hh * 16); }
    }
    }
#undef LRU_LOAD
}

__device__ __forceinline__ void lru_fix_item(const Ptrs& P, int it) {
    const int tid = opq((P.wave << 6) | lane_id()), b = it >> 6, c = it & 63, tg = tid >> 7, c8 = tid & 127;
    f32x4 H0 = {0.f, 0.f, 0.f, 0.f}, H1 = {0.f, 0.f, 0.f, 0.f};
    int cc = 0;
#pragma unroll 1
    for (; cc + 8 <= c; cc += 8) {
        f32x4 a0[8], a1[8], h0[8], h1[8];
#pragma unroll
        for (int u = 0; u < 8; ++u) { const size_t o = (size_t)(b * 64 + cc + u) * 1024 + c8 * 8;
            a0[u] = *(const f32x4*)(P.CHA() + o); a1[u] = *(const f32x4*)(P.CHA() + o + 4); h0[u] = *(const f32x4*)(P.CHH() + o); h1[u] = *(const f32x4*)(P.CHH() + o + 4); }
#pragma unroll
        for (int u = 0; u < 8; ++u) { H0 = a0[u] * H0 + h0[u]; H1 = a1[u] * H1 + h1[u]; }
    }
    for (; cc < c; ++cc) { const size_t o = (size_t)(b * 64 + cc) * 1024 + c8 * 8;
        const f32x4 a0 = *(const f32x4*)(P.CHA() + o), a1 = *(const f32x4*)(P.CHA() + o + 4), h0 = *(const f32x4*)(P.CHH() + o), h1 = *(const f32x4*)(P.CHH() + o + 4);
        H0 = a0 * H0 + h0; H1 = a1 * H1 + h1; }
#pragma unroll 4
    for (int k = 0; k < 16; ++k) { const size_t row = (size_t)(b * SEQ + c * 64 + tg + 4 * k);
        const u32x4 hw = *(const u32x4*)(P.HL() + row * 1024 + c8 * 8), cw = *(const u32x4*)(P.CA() + row * 1024 + c8 * 8), gw = *(const u32x4*)(P.PA() + row * NA + C_GC + c8 * 8);
        u32x4 o;
        o.x = pk2((bf_lo(hw.x) + bf_lo(cw.x) * H0[0]) * bf_lo(gw.x), (bf_hi(hw.x) + bf_hi(cw.x) * H0[1]) * bf_hi(gw.x));
        o.y = pk2((bf_lo(hw.y) + bf_lo(cw.y) * H0[2]) * bf_lo(gw.y), (bf_hi(hw.y) + bf_hi(cw.y) * H0[3]) * bf_hi(gw.y));
        o.z = pk2((bf_lo(hw.z) + bf_lo(cw.z) * H1[0]) * bf_lo(gw.z), (bf_hi(hw.z) + bf_hi(cw.z) * H1[1]) * bf_hi(gw.z));
        o.w = pk2((bf_lo(hw.w) + bf_lo(cw.w) * H1[2]) * bf_lo(gw.w), (bf_hi(hw.w) + bf_hi(cw.w) * H1[3]) * bf_hi(gw.w));
        *(u32x4*)(P.YC() + row * 1024 + c8 * 8) = o; }
}

#define SOFTMAX_TILE(p0, p1, m, l, NO, o, pw) do { \
    float rm_ = fmaxf(p0[0], p1[0]); \
    _Pragma("unroll") for (int r = 1; r < 16; ++r) rm_ = fmaxf(rm_, fmaxf(p0[r], p1[r])); \
    rm_ = fmaxf(rm_, __shfl_xor(rm_, 32)); \
    if (__ballot(rm_ > m + 8.f) != 0ull) {        \
        const float mn_ = fmaxf(m, rm_); const float al_ = __builtin_amdgcn_exp2f(m - mn_); m = mn_; l *= al_; \
        _Pragma("unroll") for (int d_ = 0; d_ < NO; ++d_) o[d_] *= al_; } \
    float ps_ = 0.f; \
    _Pragma("unroll") for (int r = 0; r < 16; ++r) { p0[r] = __builtin_amdgcn_exp2f(p0[r] - m); p1[r] = __builtin_amdgcn_exp2f(p1[r] - m); ps_ += p0[r] + p1[r]; } \
    l += ps_; \
    pw[0] = (u32x4){pk2(p0[0], p0[1]), pk2(p0[2], p0[3]), pk2(p0[4], p0[5]), pk2(p0[6], p0[7])}; \
    pw[1] = (u32x4){pk2(p0[8], p0[9]), pk2(p0[10], p0[11]), pk2(p0[12], p0[13]), pk2(p0[14], p0[15])}; \
    pw[2] = (u32x4){pk2(p1[0], p1[1]), pk2(p1[2], p1[3]), pk2(p1[4], p1[5]), pk2(p1[6], p1[7])}; \
    pw[3] = (u32x4){pk2(p1[8], p1[9]), pk2(p1[10], p1[11]), pk2(p1[12], p1[13]), pk2(p1[14], p1[15])}; } while (0)

__device__ __forceinline__ void moba_load_q(bf16x8 (&qr)[8], const Ptrs& P, size_t qrow, int h, int hi) {
#pragma unroll
    for (int ks = 0; ks < 8; ++ks) qr[ks] = *(const bf16x8*)(P.PA() + qrow * NA + C_QA + h * 128 + ks * 16 + hi * 8);
}
__device__ __forceinline__ void moba_list_item(const Ptrs& P, int bh, int j) {
    const int tid = opq((P.wave << 6) | lane_id()), lane = tid & 63, wid = __builtin_amdgcn_readfirstlane(tid >> 6), r32 = lane & 31, hi = lane >> 5;
    const int b = bh >> 3, h = bh & 7, t = j * 256 + 32 * wid + r32;
    bf16x8 qr[8]; moba_load_q(qr, P, (size_t)(b * SEQ + t), h, hi);
    f32x16 ga = {};
#pragma unroll
    for (int ks = 0; ks < 8; ++ks) { const bf16x8 kf = *(const bf16x8*)(P.KM() + ((size_t)(bh * 16 + (r32 & 15))) * 128 + ks * 16 + hi * 8);
        ga = __builtin_amdgcn_mfma_f32_32x32x16_bf16(kf, qr[ks], ga, 0, 0, 0); }
    float g[16];
#pragma unroll
    for (int e = 0; e < 8; ++e) { const float mine = ga[e], oth = __shfl_xor(mine, 32);
        const float lo = hi ? oth : mine, hh = hi ? mine : oth;
        g[(e & 3) + 8 * (e >> 2)] = lo; g[4 + (e & 3) + 8 * (e >> 2)] = hh; }
    const float NI = -3.0e38f;
    unsigned sel = 0u;
#pragma unroll
    for (int pass = 0; pass < 3; ++pass) { float best = NI; int bi = -1;
#pragma unroll
        for (int n = 0; n < 16; ++n) { const bool ok = (n < j) && (((sel >> n) & 1u) == 0u) && (g[n] > best); best = ok ? g[n] : best; bi = ok ? n : bi; }
        if (bi >= 0) sel |= 1u << bi; }
    for (int n = 0; n < j; ++n) {
        const bool sb = (((sel >> n) & 1u) != 0u) && (hi == 0);
        const unsigned long long mk = __ballot(sb);
        if (mk != 0ull) {
            unsigned base = 0u;
            if (lane == 0) base = atomicAdd(P.SELCNT() + bh * 16 + n, (unsigned)__popcll(mk));
            base = (unsigned)__builtin_amdgcn_readfirstlane((int)base);
            if (sb) { const unsigned pos = base + (unsigned)__popcll(mk & ((1ull << lane) - 1ull)); const unsigned k = (unsigned)__popc(sel & ((1u << n) - 1u));
                if (pos < 4096u) P.LIST()[(size_t)(bh * 16 + n) * 4096 + pos] = (unsigned)t | (k << 12); }
        }
    }
}
__device__ __forceinline__ void moba_kv_item(LAS unsigned char* lds, const Ptrs& P, int bh, int n, int part, bool split) {
    const int tid = opq((P.wave << 6) | lane_id()), lane = tid & 63, wid = __builtin_amdgcn_readfirstlane(tid >> 6), r32 = lane & 31, hi = lane >> 5;
    const int b = bh >> 3, h = bh & 7;
    const float SC = 0.08838834764831845f * LOG2E;
    LAS unsigned char* kb = lds; LAS unsigned char* vb = lds + 69632; LAS float* lut = (LAS float*)(lds + 136192);
    if (tid < 129) lut[tid] = P.rpe[t5_bucket(tid) * 24 + h] * LOG2E;
    const float cbias = P.rpe[31 * 24 + h] * LOG2E;
    {   const int kr = tid >> 4, kc8 = tid & 15, vd = tid >> 5, vk8 = tid & 31;
        u32x4 rg[8], rv[8];
#pragma unroll
        for (int i = 0; i < 8; ++i) rg[i] = *(const u32x4*)(P.PA() + (size_t)(b * SEQ + n * 256 + kr + 32 * i) * NA + C_KA + h * 128 + kc8 * 8);
#pragma unroll
        for (int i = 0; i < 8; ++i) rv[i] = *(const u32x4*)(P.VTA() + ((size_t)(bh * 128 + vd + 16 * i)) * SEQ + n * 256 + vk8 * 8);
#pragma unroll
        for (int i = 0; i < 8; ++i) *(LAS u32x4*)(kb + (kr + 32 * i) * 272 + kc8 * 16) = rg[i];
#pragma unroll
        for (int i = 0; i < 8; ++i) { *(LAS u32x2*)(vb + (vd + 16 * i) * 520 + vk8 * 16) = (u32x2){rv[i].x, rv[i].y}; *(LAS u32x2*)(vb + (vd + 16 * i) * 520 + vk8 * 16 + 8) = (u32x2){rv[i].z, rv[i].w}; }
    }
    int cnt = (int)P.SELCNT()[bh * 16 + n]; cnt = cnt < 4096 ? cnt : 4096; cnt = __builtin_amdgcn_readfirstlane(cnt);
    int beg = 0, end = cnt;
    if (split) { int half = ((cnt >> 1) + 31) & ~31; half = half < cnt ? half : cnt; if (part == 0) end = half; else beg = half; }
    __syncthreads();
    const int ntile = (end - beg + 31) >> 5;
    const unsigned* list = P.LIST() + (size_t)(bh * 16 + n) * 4096;
    bf16x8 qn[8]; unsigned en = 0u; bool vn = false;
    if (wid < ntile) { const int idx = beg + wid * 32 + r32; vn = idx < end; en = list[vn ? idx : beg]; moba_load_q(qn, P, (size_t)(b * SEQ + (int)(en & 4095u)), h, hi); }
#pragma unroll 1
    for (int qt = wid; qt < ntile; qt += 8) {
        const bool valid = vn; const unsigned e = en;
        const int t = (int)(e & 4095u), k = (int)(e >> 12);
        bf16x8 qr[8];
#pragma unroll
        for (int ks = 0; ks < 8; ++ks) qr[ks] = qn[ks];
        if (qt + 8 < ntile) { const int idx = beg + (qt + 8) * 32 + r32; vn = idx < end; en = list[vn ? idx : beg]; moba_load_q(qn, P, (size_t)(b * SEQ + (int)(en & 4095u)), h, hi); }
        float m = NEGF, l = 0.f; f32x16 o[4]; o[0] = f32x16{}; o[1] = f32x16{}; o[2] = f32x16{}; o[3] = f32x16{};
        const bool allfar = (__ballot(t < n * 256 + 383) == 0ull);
#pragma unroll 1
        for (int kvt = 0; kvt < 4; ++kvt) {
            f32x16 p0 = {}, p1 = {};
#pragma unroll
            for (int ks = 0; ks < 8; ++ks) { const bf16x8 k0 = *(const LAS bf16x8*)(kb + (kvt * 64 + r32) * 272 + ks * 32 + hi * 16), k1 = *(const LAS bf16x8*)(kb + (kvt * 64 + 32 + r32) * 272 + ks * 32 + hi * 16);
                p0 = __builtin_amdgcn_mfma_f32_32x32x16_bf16(k0, qr[ks], p0, 0, 0, 0); p1 = __builtin_amdgcn_mfma_f32_32x32x16_bf16(k1, qr[ks], p1, 0, 0, 0); }
            if (allfar) {
#pragma unroll
                for (int r = 0; r < 16; ++r) { p0[r] = p0[r] * SC + cbias; p1[r] = p1[r] * SC + cbias; }
            } else {
                const int dbase = t - n * 256 - 64 * kvt;
#pragma unroll
                for (int g4 = 0; g4 < 4; ++g4) {
#pragma unroll
                    for (int e4 = 0; e4 < 4; ++e4) { const int r = 4 * g4 + e4; const int d0 = dbase - crow(r, hi), d1 = d0 - 32;
                        p0[r] = p0[r] * SC + lut[min(max(d0, 0), 128)]; p1[r] = p1[r] * SC + lut[min(max(d1, 0), 128)]; }
                    __builtin_amdgcn_sched_barrier(0);
                }
            }
            u32x4 pw[4];
            SOFTMAX_TILE(p0, p1, m, l, 4, o, pw);
#pragma unroll
            for (int sl = 0; sl < 4; ++sl)
#pragma unroll
                for (int dt = 0; dt < 4; ++dt) { const LAS unsigned char* vp = vb + (dt * 32 + r32) * 520 + (kvt * 64 + 16 * sl + 4 * hi) * 2;
                    const u32x2 lo = *(const LAS u32x2*)vp, hh = *(const LAS u32x2*)(vp + 16);
                    const u32x4 vf = {lo.x, lo.y, hh.x, hh.y};
                    o[dt] = __builtin_amdgcn_mfma_f32_32x32x16_bf16(__builtin_bit_cast(bf16x8, vf), __builtin_bit_cast(bf16x8, pw[sl]), o[dt], 0, 0, 0); }
        }
        const float lt = l + __shfl_xor(l, 32); const float inv = __builtin_amdgcn_rcpf(lt);
        if (valid) {
            const size_t slot = ((size_t)bh * SEQ + t) * 3 + k;
            if (hi == 0) *(f32x2*)(P.ML() + slot * 2) = (f32x2){m, lt};
            bf16_t* po = P.PO() + slot * 128;
#pragma unroll
            for (int dt = 0; dt < 4; ++dt)
#pragma unroll
                for (int g4 = 0; g4 < 4; ++g4) { const int d = 32 * dt + 8 * g4 + 4 * hi;
                    *(u32x2*)(po + d) = (u32x2){pk2(o[dt][4 * g4] * inv, o[dt][4 * g4 + 1] * inv), pk2(o[dt][4 * g4 + 2] * inv, o[dt][4 * g4 + 3] * inv)}; }
        }
    }
    __syncthreads();
}
__device__ __forceinline__ void moba_own_item(LAS unsigned char* lds, const Ptrs& P, int b, int h, int j) {
    const int tid = opq((P.wave << 6) | lane_id()), lane = tid & 63, wid = __builtin_amdgcn_readfirstlane(tid >> 6), r32 = lane & 31, hi = lane >> 5;
    const float SC = 0.08838834764831845f * LOG2E;
    LAS unsigned char* kb = lds; LAS unsigned char* vb = lds + 69632; LAS float* lut = (LAS float*)(lds + 136192);
    if (tid < 129) lut[tid] = P.rpe[t5_bucket(tid) * 24 + h] * LOG2E;
    const int bh = b * 8 + h;
    const int q_local = 32 * wid + r32, t = j * 256 + q_local; const size_t qrow = (size_t)(b * SEQ + t);
    bf16x8 qr[8]; moba_load_q(qr, P, qrow, h, hi);
    {   const int kr = tid >> 4, kc8 = tid & 15, vd = tid >> 5, vk8 = tid & 31;
        u32x4 rg[8], rv[8];
#pragma unroll
        for (int i = 0; i < 8; ++i) rg[i] = *(const u32x4*)(P.PA() + (size_t)(b * SEQ + j * 256 + kr + 32 * i) * NA + C_KA + h * 128 + kc8 * 8);
#pragma unroll
        for (int i = 0; i < 8; ++i) rv[i] = *(const u32x4*)(P.VTA() + ((size_t)(bh * 128 + vd + 16 * i)) * SEQ + j * 256 + vk8 * 8);
#pragma unroll
        for (int i = 0; i < 8; ++i) *(LAS u32x4*)(kb + (kr + 32 * i) * 272 + kc8 * 16) = rg[i];
#pragma unroll
        for (int i = 0; i < 8; ++i) { *(LAS u32x2*)(vb + (vd + 16 * i) * 520 + vk8 * 16) = (u32x2){rv[i].x, rv[i].y}; *(LAS u32x2*)(vb + (vd + 16 * i) * 520 + vk8 * 16 + 8) = (u32x2){rv[i].z, rv[i].w}; }
    }
    const int nsel = j < 3 ? j : 3;
    const size_t slot0 = ((size_t)bh * SEQ + t) * 3;
    float mk[3], lk[3];
#pragma unroll
    for (int k = 0; k < 3; ++k) { mk[k] = NEGF; lk[k] = 0.f;
        if (k < nsel) { const f32x2 v = *(const f32x2*)(P.ML() + (slot0 + k) * 2); mk[k] = v[0]; lk[k] = v[1]; } }
    __syncthreads();
    float m = NEGF, l = 0.f; f32x16 o[4]; o[0] = f32x16{}; o[1] = f32x16{}; o[2] = f32x16{}; o[3] = f32x16{};
    const int ntt = ((32 * wid + 31) >> 6) + 1;
#pragma unroll 1
    for (int tt = 0; tt < ntt; ++tt) {
        f32x16 p0 = {}, p1 = {};
#pragma unroll
        for (int ks = 0; ks < 8; ++ks) { const bf16x8 k0 = *(const LAS bf16x8*)(kb + (tt * 64 + r32) * 272 + ks * 32 + hi * 16), k1 = *(const LAS bf16x8*)(kb + (tt * 64 + 32 + r32) * 272 + ks * 32 + hi * 16);
            p0 = __builtin_amdgcn_mfma_f32_32x32x16_bf16(k0, qr[ks], p0, 0, 0, 0); p1 = __builtin_amdgcn_mfma_f32_32x32x16_bf16(k1, qr[ks], p1, 0, 0, 0); }
        const int dbase = q_local - 64 * tt;
#pragma unroll
        for (int g4 = 0; g4 < 4; ++g4) {
#pragma unroll
            for (int e4 = 0; e4 < 4; ++e4) { const int r = 4 * g4 + e4; const int d0 = dbase - crow(r, hi), d1 = d0 - 32;
                const float b0 = lut[min(max(d0, 0), 128)], b1 = lut[min(max(d1, 0), 128)];
                p0[r] = (d0 >= 0) ? p0[r] * SC + b0 : NEGF; p1[r] = (d1 >= 0) ? p1[r] * SC + b1 : NEGF; }
            __builtin_amdgcn_sched_barrier(0);
        }
        u32x4 pw[4];
        SOFTMAX_TILE(p0, p1, m, l, 4, o, pw);
#pragma unroll
        for (int sl = 0; sl < 4; ++sl)
#pragma unroll
            for (int dt = 0; dt < 4; ++dt) { const LAS unsigned char* vp = vb + (dt * 32 + r32) * 520 + (tt * 64 + 16 * sl + 4 * hi) * 2;
                const u32x2 lo = *(const LAS u32x2*)vp, hh = *(const LAS u32x2*)(vp + 16);
                const u32x4 vf = {lo.x, lo.y, hh.x, hh.y};
                o[dt] = __builtin_amdgcn_mfma_f32_32x32x16_bf16(__builtin_bit_cast(bf16x8, vf), __builtin_bit_cast(bf16x8, pw[sl]), o[dt], 0, 0, 0); }
    }
    float lown = l + __shfl_xor(l, 32);
    float Mx = m;
#pragma unroll
    for (int k = 0; k < 3; ++k) if (k < nsel) Mx = fmaxf(Mx, mk[k]);
    const float wo = __builtin_amdgcn_exp2f(m - Mx); float L = lown * wo;
#pragma unroll
    for (int dt = 0; dt < 4; ++dt) o[dt] *= wo;
#pragma unroll
    for (int k = 0; k < 3; ++k) if (k < nsel) { const float wk = lk[k] * __builtin_amdgcn_exp2f(mk[k] - Mx); L += wk;
        const bf16_t* po = P.PO() + (slot0 + k) * 128;
#pragma unroll
        for (int dt = 0; dt < 4; ++dt)
#pragma unroll
            for (int g4 = 0; g4 < 4; ++g4) { const u32x2 w = *(const u32x2*)(po + 32 * dt + 8 * g4 + 4 * hi);
                o[dt][4 * g4] += wk * bf_lo(w.x); o[dt][4 * g4 + 1] += wk * bf_hi(w.x); o[dt][4 * g4 + 2] += wk * bf_lo(w.y); o[dt][4 * g4 + 3] += wk * bf_hi(w.y); } }
    const float inv = __builtin_amdgcn_rcpf(L);
#pragma unroll
    for (int dt = 0; dt < 4; ++dt)
#pragma unroll
        for (int g4 = 0; g4 < 4; ++g4) { const int d = 32 * dt + 8 * g4 + 4 * hi;
            const u32x2 gw = *(const u32x2*)(P.PA() + qrow * NA + C_GA + h * 128 + d);
            const float i64 = inv * 16.f; int w8 = 0;
            w8 = __builtin_amdgcn_cvt_pk_fp8_f32(o[dt][4 * g4] * i64 * bf_lo(gw.x), o[dt][4 * g4 + 1] * i64 * bf_hi(gw.x), w8, false); w8 = __builtin_amdgcn_cvt_pk_fp8_f32(o[dt][4 * g4 + 2] * i64 * bf_lo(gw.y), o[dt][4 * g4 + 3] * i64 * bf_hi(gw.y), w8, true);
            *(unsigned*)(P.Y8() + qrow * 2048 + h * 128 + d) = (unsigned)w8; }
    __syncthreads();
}
__device__ const unsigned char MOBA_SCHED[8][3] = {{0 + 32, 9, 255}, {0 + 16 + 32, 10, 13}, {4, 11, 12}, {1 + 32, 8, 14}, {1 + 16 + 32, 7, 255}, {5, 3 + 32, 255}, {2 + 32, 6, 255}, {2 + 16 + 32, 3 + 16 + 32, 255}};

__device__ __forceinline__ void swa_item(LAS unsigned char* lds, const Ptrs& P, int l, int b, int hk, int qblk) {
    const int tid = opq((P.wave << 6) | lane_id()), lane = tid & 63, wid = __builtin_amdgcn_readfirstlane(tid >> 6), r32 = lane & 31, hi = lane >> 5;
    const float SC = 0.125f * LOG2E;
    LAS unsigned char* kb = lds; LAS unsigned char* vb = lds + 36864; LAS float* lut = (LAS float*)(lds + 70144);
    const int kvbase = qblk * 128 - 128;
#pragma unroll
    for (int i = 0; i < 4; ++i) { const int r = (tid >> 3) + 64 * i, c8 = tid & 7, kv = kvbase + r;
        u32x4 w = {0u, 0u, 0u, 0u};
        if (kv >= 0) w = *(const u32x4*)(P.PA() + (size_t)(b * SEQ + kv) * NA + C_KB + hk * 64 + c8 * 8);
        *(LAS u32x4*)(kb + r * 144 + c8 * 16) = w; }
#pragma unroll
    for (int i = 0; i < 4; ++i) { const int d = (tid >> 5) + 16 * i, k8 = tid & 31, kv = kvbase + k8 * 8;
        u32x4 w = {0u, 0u, 0u, 0u};
        if (kv >= 0) w = *(const u32x4*)(P.VTB() + ((size_t)((b * 4 + hk) * 64 + d)) * SEQ + kv);
        *(LAS u32x2*)(vb + d * 520 + k8 * 16) = (u32x2){w.x, w.y}; *(LAS u32x2*)(vb + d * 520 + k8 * 16 + 8) = (u32x2){w.z, w.w}; }
    { const int g = tid >> 7, dist = tid & 127; lut[tid] = P.rpe[t5_bucket(dist) * 24 + 8 + hk * 4 + g] * LOG2E; }
    const int g = wid >> 1, hq = hk * 4 + g;
    const float sink2 = P.sinks[l * 16 + hq] * LOG2E;
    bf16x8 qrs[2][4];
#pragma unroll
    for (int qs = 0; qs < 2; ++qs)
#pragma unroll
        for (int ks = 0; ks < 4; ++ks) qrs[qs][ks] = *(const bf16x8*)(P.PA() + (size_t)(b * SEQ + qblk * 128 + 32 * (2 * (wid & 1) + qs) + r32) * NA + C_QB + hq * 64 + ks * 16 + hi * 8);
    __syncthreads();
#pragma unroll
    for (int qs = 0; qs < 2; ++qs) {
        const int qq = 2 * (wid & 1) + qs, q_local = 32 * qq + r32; const size_t qrow = (size_t)(b * SEQ + qblk * 128 + q_local);
        bf16x8 qr[4];
#pragma unroll
        for (int ks = 0; ks < 4; ++ks) qr[ks] = qrs[qs][ks];
        float m = NEGF, lsum = 0.f; f32x16 o[2]; o[0] = f32x16{}; o[1] = f32x16{};
        const int tk_hi = (32 * qq + 159) >> 6, tk_lo = (32 * qq + 1) >> 6;
#pragma unroll 1
        for (int tk = tk_hi; tk >= tk_lo; --tk) {
            f32x16 p0 = {}, p1 = {};
#pragma unroll
            for (int ks = 0; ks < 4; ++ks) { const bf16x8 k0 = *(const LAS bf16x8*)(kb + (tk * 64 + r32) * 144 + ks * 32 + hi * 16), k1 = *(const LAS bf16x8*)(kb + (tk * 64 + 32 + r32) * 144 + ks * 32 + hi * 16);
                p0 = __builtin_amdgcn_mfma_f32_32x32x16_bf16(k0, qr[ks], p0, 0, 0, 0); p1 = __builtin_amdgcn_mfma_f32_32x32x16_bf16(k1, qr[ks], p1, 0, 0, 0); }
            const int dbase = 128 + q_local - tk * 64;
#pragma unroll
            for (int r = 0; r < 16; ++r) { const int d0 = dbase - crow(r, hi), d1 = d0 - 32;
                const int rb0 = tk * 64 + crow(r, hi), rb1 = rb0 + 32;
                const bool v0 = (d0 >= 0) && (d0 < 128) && (qblk > 0 || rb0 >= 128), v1 = (d1 >= 0) && (d1 < 128) && (qblk > 0 || rb1 >= 128);
                const float b0 = lut[g * 128 + (d0 & 127)], b1 = lut[g * 128 + (d1 & 127)];
                p0[r] = v0 ? p0[r] * SC + b0 : NEGF; p1[r] = v1 ? p1[r] * SC + b1 : NEGF; }
            u32x4 pw[4];
            SOFTMAX_TILE(p0, p1, m, lsum, 2, o, pw);
#pragma unroll
            for (int dt = 0; dt < 2; ++dt)
#pragma unroll
                for (int s = 0; s < 4; ++s) { const LAS unsigned char* vp = vb + (dt * 32 + r32) * 520 + (tk * 64 + 16 * s + 4 * hi) * 2;
                    const u32x2 lo = *(const LAS u32x2*)vp, hh = *(const LAS u32x2*)(vp + 16);
                    const u32x4 vf = {lo.x, lo.y, hh.x, hh.y};
                    o[dt] = __builtin_amdgcn_mfma_f32_32x32x16_bf16(__builtin_bit_cast(bf16x8, vf), __builtin_bit_cast(bf16x8, pw[s]), o[dt], 0, 0, 0); }
        }
        const float lt = lsum + __shfl_xor(lsum, 32) + __builtin_amdgcn_exp2f(sink2 - m); const float inv = __builtin_amdgcn_rcpf(lt);
#pragma unroll
        for (int dt = 0; dt < 2; ++dt)
#pragma unroll
            for (int g4 = 0; g4 < 4; ++g4) { const int d = 32 * dt + 8 * g4 + 4 * hi;
                const u32x2 gw = *(const u32x2*)(P.PA() + qrow * NA + C_GB + hq * 64 + d);
                const float i64 = inv * 16.f; int w8 = 0;
                w8 = __builtin_amdgcn_cvt_pk_fp8_f32(o[dt][4 * g4] * i64 * bf_lo(gw.x), o[dt][4 * g4 + 1] * i64 * bf_hi(gw.x), w8, false); w8 = __builtin_amdgcn_cvt_pk_fp8_f32(o[dt][4 * g4 + 2] * i64 * bf_lo(gw.y), o[dt][4 * g4 + 3] * i64 * bf_hi(gw.y), w8, true);
                *(unsigned*)(P.Y8() + qrow * 2048 + 1024 + hq * 64 + d) = (unsigned)w8; }
    }
    __syncthreads();
}

#define XB_TMO      128
#define XB_XCNT(j)  (256  + 64 * (j))
#define XB_XSUB(j)  (1280 + 64 * (j))
#define XB_XGEN(j)  (2304 + 64 * (j))
#define XB_TOP      3328
#define XB_TOPGEN   3392
#define XCD_BAR_WORDS 3456
#define XB_SPIN_CAP (1u << 18)

__device__ __forceinline__ unsigned xb_ld(unsigned* p)              { return __hip_atomic_load(p, __ATOMIC_RELAXED, __HIP_MEMORY_SCOPE_AGENT); }
__device__ __forceinline__ unsigned xb_add(unsigned* p, unsigned v) { return __hip_atomic_fetch_add(p, v, __ATOMIC_RELAXED, __HIP_MEMORY_SCOPE_AGENT); }
__device__ __forceinline__ unsigned xb_xcc_id() { return (unsigned)__builtin_amdgcn_s_getreg((3 << 11) | 20) & 0xFu; }
#define XB_SPIN(cond, bar) do { unsigned _sp = 0; while (cond) { __builtin_amdgcn_s_sleep(1); \
    if ((++_sp & 255u) == 0u) { if (xb_ld(&(bar)[XB_TMO])) break; if (_sp > XB_SPIN_CAP) { atomicAdd(&(bar)[XB_TMO], 1u); break; } } } } while (0)

struct XcdBarrier {
    unsigned* bar; unsigned x; int wave;
    volatile LAS unsigned* st;
};

__device__ __forceinline__ XcdBarrier xcd_barrier_post(unsigned* bar, volatile LAS unsigned* st, int wave) {
    XcdBarrier b; b.bar = bar; b.x = xb_xcc_id(); b.st = st; b.wave = wave;
    if (wave == 0 && lane_id() == 0) (void)xb_add(&bar[XB_XCNT(b.x)], 1u);
    return b;
}
__device__ __forceinline__ void xcd_barrier_complete(unsigned* bar, unsigned x, unsigned& nloc, unsigned& nx) {
    const unsigned G = gridDim.x * gridDim.y * gridDim.z;
    unsigned sum, cnt, mine, sp = 0u;
    for (;;) {
        sum = 0u; cnt = 0u; mine = 0u;
#pragma unroll
        for (unsigned j = 0; j < 16; ++j) { const unsigned c = xb_ld(&bar[XB_XCNT(j)]); sum += c; cnt += (c > 0u) ? 1u : 0u; mine = (j == x) ? c : mine; }
        if (sum == G) break;
        __builtin_amdgcn_s_sleep(1);
        if ((++sp & 255u) == 0u) { if (xb_ld(&bar[XB_TMO])) break; if (sp > XB_SPIN_CAP) { atomicAdd(&bar[XB_TMO], 1u); break; } }
    }
    nloc = mine > 0u ? mine : 1u; nx = cnt > 0u ? cnt : 1u;
}

__device__ __forceinline__ void xcd_barrier(const XcdBarrier& b) {
    asm volatile("s_waitcnt vmcnt(0)" ::: "memory");
    __syncthreads();
    if (b.wave == 0 && lane_id() == 0) {
        unsigned* bar = launder_s(b.bar);
        __builtin_amdgcn_s_waitcnt(0);
        unsigned nloc = b.st[0], nx = b.st[1];
        if (nloc == 0u) { xcd_barrier_complete(bar, b.x, nloc, nx); b.st[0] = nloc; b.st[1] = nx; }
        const unsigned old = xb_add(&bar[XB_XSUB(b.x)], 1u);
        const unsigned gen = old / nloc;
        if (old + 1u == (gen + 1u) * nloc) {
            __builtin_amdgcn_fence(__ATOMIC_RELEASE, "agent");
            asm volatile("s_waitcnt vmcnt(0)" ::: "memory");
            const unsigned og = xb_add(&bar[XB_TOP], 1u);
            const unsigned tg = og / nx;
            if (og + 1u == (tg + 1u) * nx) xb_add(&bar[XB_TOPGEN], 1u);
            else XB_SPIN(xb_ld(&bar[XB_TOPGEN]) == tg, bar);
            __builtin_amdgcn_fence(__ATOMIC_ACQUIRE, "agent");
            xb_add(&bar[XB_XGEN(b.x)], 1u);
            asm volatile("s_waitcnt vmcnt(0)" ::: "memory");
        } else {
            XB_SPIN(xb_ld(&bar[XB_XGEN(b.x)]) == gen, bar);
            __builtin_amdgcn_fence(__ATOMIC_ACQUIRE, "agent");
            asm volatile("s_waitcnt vmcnt(0)" ::: "memory");
        }
    }
    __syncthreads();
}

template <int l> __device__ __forceinline__ void layer_phases(LAS unsigned char* lds, Ptrs& P, const XcdBarrier& xbar, KArgs kargs, const int lo, const int hi, const int lane0, const int wave, const int G0, const int bx0) {
#define PHASE_BEGIN() P.reload(launder_s(kargs)); const int G = sopq(G0), bx = sopq(bx0); const int lane = opq(lane_id()); const int gw = bx * 8 + wave, NGW = G * 8; (void)gw; (void)NGW; (void)lane
#define IN(k) (lo <= (k) && (k) < hi)
#define SEAM(k) do { if (IN(k) && IN((k) + 1)) xcd_barrier(xbar); } while (0)
        constexpr int pb = 1 + 8 * l;
        if (IN(pb)) {
            PHASE_BEGIN();
#ifndef NO_P1
            { pg8::Gemm g{(const bf16_t*)P.XB8(), (const bf16_t*)(P.WIN8() + (size_t)l * N8 * DM), DM / 2, DM / 2, DM / 2, 0, 0, P.wave}; pg8::StaticOrder S; S.init(M, N8, G, bx);
              pg8::EpiIn E{P.PA(), P.GT(), P.SSQ() + (size_t)(2 * l) * M, 1, 1.f / 512.f};
              pg8::gemm_phase<pg8::EpiIn, pg8::StaticOrder, true, true>(lds, g, S, E); }
            { pg8::Gemm g{P.XB(), P.WINB() + (size_t)l * NB16 * DM, DM, DM, DM, 0, 0, P.wave}; pg8::StaticOrder S; S.init(M, NB16, G, bx);
              pg8::EpiIn E{P.PA(), P.GT(), P.SSQ() + (size_t)(2 * l) * M, 2, 1.f};
              pg8::gemm_phase<pg8::EpiIn, pg8::StaticOrder, true, false>(lds, g, S, E); }
#endif
        }
        SEAM(pb);
        if (IN(pb + 1)) {
            PHASE_BEGIN();
#ifndef NO_P2A
#ifndef REP_P2A
#define REP_P2A 1
#endif
            for (int rep = 0; rep < REP_P2A; ++rep) {
            if (bx == 0) P.SELCNT()[(P.wave << 6) | lane_id()] = 0u;
#ifndef REP_KM
#define REP_KM 1
#endif
#ifndef REP_VT
#define REP_VT 1
#endif
#ifndef REP_LRU
#define REP_LRU 1
#endif
            for (int r2 = 0; r2 < REP_KM; ++r2)
            for (int it = bx; it < BATCH * 8 * 16; it += G) kmean_item(lds, P, it);
            for (int r2 = 0; r2 < REP_VT; ++r2)
            for (int it = gw; it < 5120; it += NGW) vtrans_item(lds + wave * 9216, P, it, lane);
            __syncthreads();
            for (int r2 = 0; r2 < REP_LRU; ++r2)
            lru_local_phase(lds, P, l, bx, G);
            __syncthreads(); }
#endif
        }
        SEAM(pb + 1);
        if (IN(pb + 2)) {
            PHASE_BEGIN();
            for (int it = bx; it < 512; it += G) { const int j = it & 15; if (j > 0) moba_list_item(P, it >> 4, j); }
            for (int it = bx; it < 256; it += G) lru_fix_item(P, it);
            for (int it = bx; it < 512; it += G) swa_item(lds, P, l, it >> 7, (it >> 5) & 3, it & 31);
        }
        SEAM(pb + 2);
        if (IN(pb + 3)) {
            PHASE_BEGIN();
#ifndef REP_KV
#define REP_KV 1
#endif
            for (int rep = 0; rep < REP_KV; ++rep)
            for (int it = bx; it < 256; it += G) { const int bh = it >> 3, sb = it & 7;
#pragma unroll 1
                for (int q = 0; q < 3; ++q) { const int code = MOBA_SCHED[sb][q]; if (code != 255) moba_kv_item(lds, P, bh, code & 15, (code >> 4) & 1, (code & 32) != 0); } }
        }
        SEAM(pb + 3);
        if (IN(pb + 4)) {
            PHASE_BEGIN();
#ifndef REP_OWN
#define REP_OWN 1
#endif
            for (int rep = 0; rep < REP_OWN; ++rep)
            for (int it = bx; it < 256; it += G) { const int bh = it >> 3, sb = it & 7;
                moba_own_item(lds, P, bh >> 3, bh & 7, 15 - sb);
                moba_own_item(lds, P, bh >> 3, bh & 7, sb); }
        }
        SEAM(pb + 4);
        if (IN(pb + 5)) {
            PHASE_BEGIN();
#ifndef NO_P3
            { pg8::Gemm g{(const bf16_t*)P.Y8(), (const bf16_t*)(P.WBR8() + (size_t)l * 2 * DM * 1024), 1024, 512, 512, (size_t)1024, (size_t)DM * 1024, P.wave}; pg8::ZOrder2 S; S.S.init(M, DM, G, bx);
              pg8::EpiMerge E{P.GT(), P.MG(), 1.f / 512.f};
              pg8::gemm_phase<pg8::EpiMerge, pg8::ZOrder2, true, true>(lds, g, S, E); }
            { pg8::Gemm g{P.YC(), P.WBR() + (size_t)(l * 3 + 2) * DM * 1024, 1024, 1024, 1024, 0, 0, P.wave}; pg8::ZFixed S; S.S.init(M, DM, G, bx); S.z = 2;
              pg8::EpiMerge E{P.GT(), P.MG(), 1.f};
              pg8::gemm_phase<pg8::EpiMerge, pg8::ZFixed, true, false>(lds, g, S, E); }
#endif
        }
        SEAM(pb + 5);
        if (IN(pb + 6)) {
            PHASE_BEGIN();
            { pg8::Gemm g{P.MG(), P.WOUT() + (size_t)l * DM * DM, DM, DM, DM, 0, 0, P.wave}; pg8::StaticOrder S; S.init(M, DM, G, bx);
              pg8::EpiOut E{l == 0 ? P.x : P.out, P.X1(), P.XB1(), P.SSQ() + (size_t)(1 + 2 * l) * M};
#ifndef NO_P4
              pg8::gemm_phase<pg8::EpiOut, pg8::StaticOrder, true>(lds, g, S, E);
#endif
            }
            { pg8::Gemm g{P.PB() + (size_t)l * M * PLE, P.WPP() + (size_t)l * DM * PLE, PLE, PLE, PLE, 0, 0, P.wave}; pg8::StaticOrder S; S.init(M, DM, G, bx);
              pg8::EpiPlain E{P.T(), DM};
#ifndef NO_P4T
              pg8::gemm_phase<pg8::EpiPlain, pg8::StaticOrder, true>(lds, g, S, E);
#endif
            }
        }
        SEAM(pb + 6);
        if (IN(pb + 7)) {
            PHASE_BEGIN();
            pg8::Gemm g{P.XB1(), P.WPG() + (size_t)l * DM * DM, DM, DM, DM, 0, 0, P.wave}; pg8::StaticOrder S; S.init(M, DM, G, bx);
            pg8::EpiPle E{P.X1(), P.T(), P.SSQ() + (size_t)(1 + 2 * l) * M, P.out, P.XB(), P.XB8(), P.SSQ() + (size_t)(2 + 2 * l) * M, l + 1 < DEPTH};
#ifndef NO_P5
            pg8::gemm_phase<pg8::EpiPle, pg8::StaticOrder, true>(lds, g, S, E);
#endif
        }
        SEAM(pb + 7);

#undef IN
#undef SEAM
#undef PHASE_BEGIN
}

constexpr int NPH = 18;

__global__ void __launch_bounds__(NTHR, 2) fwd_kernel(Args args) {
    extern __shared__ __attribute__((aligned(16))) unsigned char lds_raw[];
    LAS unsigned char* lds = (LAS unsigned char*)lds_raw;
    cg::grid_group grid = cg::this_grid();
    const int tid = threadIdx.x, lane0 = tid & 63, wave = __builtin_amdgcn_readfirstlane(tid >> 6);
    const int G0 = gridDim.x, bx0 = blockIdx.x;
#define PHASE_BEGIN() P.reload(launder_s(kargs)); const int G = sopq(G0), bx = sopq(bx0); const int lane = opq(lane_id()); const int gw = bx * 8 + wave, NGW = G * 8; (void)gw; (void)NGW; (void)lane
    unsigned char* ws = args.ws;
    Ptrs P;
    KArgs kargs = (KArgs)__builtin_amdgcn_kernarg_segment_ptr();
    P.wave = wave;
    const int lo = args.ph_lo, hi = args.ph_hi;
    volatile LAS unsigned* bst = (volatile LAS unsigned*)(lds + LDS_BYTES - 64);
    if (tid < 2) bst[tid] = 0u;
    __syncthreads();
    const XcdBarrier xbar = xcd_barrier_post((unsigned*)(ws + OFF_BAR), bst, wave);
    if (hi > 1000) grid.sync();
#define IN(k) (lo <= (k) && (k) < hi)
#define SEAM(k) do { if (IN(k) && IN((k) + 1)) xcd_barrier(xbar); } while (0)

#ifndef REP_P0
#define REP_P0 1
#endif
    if (IN(0)) for (int rep0 = 0; rep0 < REP_P0; ++rep0) {
        PHASE_BEGIN();
        LAS float* scr = (LAS float*)(lds + wave * 16640);
        for (int l = 0; l < DEPTH; ++l) {
            { const float* wl = P.w_in + (size_t)l * DM * NIN; const float* ng = P.norm_g + l * DM;
              unsigned char* w8 = P.WIN8() + (size_t)l * N8 * DM; bf16_t* wb = P.WINB() + (size_t)l * NB16 * DM;
              transpose_matrix<true>(wl + 2048, DM, 4608, NIN, w8, ng, 64.f, scr, gw, NGW, lane);
              transpose_matrix<true>(wl + 8704, DM, 6144, NIN, w8 + (size_t)4608 * DM, ng, 64.f, scr, gw, NGW, lane);
              transpose_matrix(wl, DM, 2048, NIN, wb, ng, 1.f, scr, gw, NGW, lane);
              transpose_matrix(wl + 6656, DM, 2048, NIN, wb + (size_t)2048 * DM, ng, 1.f, scr, gw, NGW, lane); }
            for (int z = 0; z < 2; ++z) transpose_matrix<true>(P.w_br + (size_t)(l * 3 + z) * 1024 * DM, 1024, DM, DM, P.WBR8() + (size_t)(l * 2 + z) * DM * 1024, nullptr, 32.f, scr, gw, NGW, lane);
            transpose_matrix(P.w_br + (size_t)(l * 3 + 2) * 1024 * DM, 1024, DM, DM, P.WBR() + (size_t)(l * 3 + 2) * DM * 1024, nullptr, 1.f, scr, gw, NGW, lane);
            transpose_matrix(P.w_out + (size_t)l * DM * DM, DM, DM, DM, P.WOUT() + (size_t)l * DM * DM, nullptr, 1.f, scr, gw, NGW, lane);
            transpose_matrix(P.w_pg + (size_t)l * DM * DM, DM, DM, DM, P.WPG() + (size_t)l * DM * DM, P.ple_g + l * DM, 1.f, scr, gw, NGW, lane);
            transpose_matrix(P.w_pp + (size_t)l * PLE * DM, PLE, DM, DM, P.WPP() + (size_t)l * DM * PLE, nullptr, 1.f, scr, gw, NGW, lane);
            for (int n = 0; n < 8; ++n) {
                transpose_matrix(P.w_r + (size_t)(l * 8 + n) * 16384, 128, 128, 128, P.WR() + (size_t)(l * 8 + n) * 16384, nullptr, 1.f, scr, gw, NGW, lane);
                transpose_matrix(P.w_i + (size_t)(l * 8 + n) * 16384, 128, 128, 128, P.WI() + (size_t)(l * 8 + n) * 16384, nullptr, 1.f, scr, gw, NGW, lane);
            }
        }
        for (int mrow = gw; mrow < M; mrow += NGW) {
            const f32x4* xr = (const f32x4*)(P.x + (size_t)mrow * DM) + lane; u32x2* ob = (u32x2*)(P.XB() + (size_t)mrow * DM) + lane; unsigned* o8 = (unsigned*)(P.XB8() + (size_t)mrow * DM) + lane; float s = 0.f;
#pragma unroll
            for (int jv = 0; jv < 8; ++jv) { const f32x4 v = xr[64 * jv]; s += (v[0] * v[0] + v[1] * v[1]) + (v[2] * v[2] + v[3] * v[3]); ob[64 * jv] = (u32x2){pk2(v[0], v[1]), pk2(v[2], v[3])};
                int q = 0; q = __builtin_amdgcn_cvt_pk_fp8_f32(v[0] * 8.f, v[1] * 8.f, q, false); q = __builtin_amdgcn_cvt_pk_fp8_f32(v[2] * 8.f, v[3] * 8.f, q, true); o8[64 * jv] = (unsigned)q; }
            s = wave_sum(s);
            if (lane == 0) P.SSQ()[mrow] = s;
        }
        for (size_t i = (size_t)bx * NTHR + tid; i < (size_t)DEPTH * M * PLE / 8; i += (size_t)G * NTHR) {
            const f32x4 v0 = *(const f32x4*)(P.p + i * 8), v1 = *(const f32x4*)(P.p + i * 8 + 4);
            *(u32x4*)(P.PB() + i * 8) = (u32x4){pk2(v0[0], v0[1]), pk2(v0[2], v0[3]), pk2(v1[0], v1[1]), pk2(v1[2], v1[3])}; }
        for (int i = bx * NTHR + tid; i < 4 * M; i += G * NTHR) P.SSQ()[M + i] = 0.f;
    }
    SEAM(0);

    layer_phases<0>(lds, P, xbar, kargs, lo, hi, lane0, wave, G0, bx0);
    layer_phases<1>(lds, P, xbar, kargs, lo, hi, lane0, wave, G0, bx0);
    if (IN(17)) {
        PHASE_BEGIN();
        for (int mrow = gw; mrow < M; mrow += NGW) {
            const float rs = rsqrtf(P.SSQ()[(size_t)4 * M + mrow] * (1.f / DM) + EPS);
            f32x4* xr = (f32x4*)(P.out + (size_t)mrow * DM) + lane; const f32x4* gr = (const f32x4*)P.fin_g + lane;
#pragma unroll
            for (int jv = 0; jv < 8; ++jv) { const f32x4 v = xr[64 * jv], gg = gr[64 * jv]; xr[64 * jv] = v * rs * gg; }
        }
    }
#undef IN
#undef SEAM
}

extern "C" void kernel_launch(void* const* d_in, const int* in_sizes, int n_in, void* d_out, int out_size, void* d_ws, size_t ws_size, hipStream_t stream) {
    static int grid = 0;
    if (grid == 0) {
        if (n_in != 19 || out_size != M * DM || ws_size < WS_END) { fprintf(stderr, "kernel_launch: unexpected problem (n_in %d, out %d, ws %zu < %zu)\n", n_in, out_size, ws_size, (size_t)WS_END); grid = -1; return; }
        int dev = 0, cus = 0, per_cu = 0;
        (void)hipGetDevice(&dev); (void)hipDeviceGetAttribute(&cus, hipDeviceAttributeMultiprocessorCount, dev);
        (void)hipFuncSetAttribute((const void*)fwd_kernel, hipFuncAttributeMaxDynamicSharedMemorySize, LDS_BYTES);
        if (hipOccupancyMaxActiveBlocksPerMultiprocessor(&per_cu, (const void*)fwd_kernel, NTHR, LDS_BYTES) != hipSuccess || per_cu < 1) per_cu = 1;
        (void)hipGetLastError();
        grid = cus > 0 ? cus : 256;
    }
    if (grid < 0) return;
    (void)hipMemsetAsync((unsigned char*)d_ws + OFF_BAR, 0, BAR_BYTES, stream);
    Args a{};
    for (int i = 0; i < 19; ++i) a.in[i] = (const float*)d_in[i];
    a.out = (float*)d_out; a.ws = (unsigned char*)d_ws; a.ph_lo = 0; a.ph_hi = NPH;
    void* params[] = {&a};
    hipError_t e = hipLaunchCooperativeKernel((const void*)fwd_kernel, dim3(grid), dim3(NTHR), params, LDS_BYTES, stream);
    if (e != hipSuccess) fprintf(stderr, "cooperative launch failed: %s (grid %d)\n", hipGetErrorString(e), grid);
}
```

```cpp
#include <hip/hip_runtime.h>
#include <hip/hip_cooperative_groups.h>
#include <cstdio>
#include <cstdint>
namespace cg = cooperative_groups;

#define LAS __attribute__((address_space(3)))
typedef unsigned short bf16_t;
typedef short bf16x8 __attribute__((ext_vector_type(8)));
typedef float f32x4 __attribute__((ext_vector_type(4)));
typedef float f32x2 __attribute__((ext_vector_type(2)));
typedef float f32x16 __attribute__((ext_vector_type(16)));
typedef unsigned u32x4 __attribute__((ext_vector_type(4)));
typedef unsigned u32x2 __attribute__((ext_vector_type(2)));
typedef __bf16 bf16x2_t __attribute__((ext_vector_type(2)));

constexpr int BATCH = 4, SEQ = 4096, DM = 2048, M = BATCH * SEQ, DEPTH = 2, PLE = 256;
constexpr int NIN = 14848, NA = 8704, NG = 6144;
constexpr int C_QA = 0, C_KA = 1024, C_VA = 2048, C_GA = 3072, C_QB = 4096, C_KB = 5120, C_VB = 5376, C_GB = 5632, C_XC = 6656, C_GC = 7680;
constexpr float EPS = 1e-6f, LOG2E = 1.4426950408889634f, NEGF = -1e30f;

constexpr size_t SZ_WIN = (size_t)DEPTH * NIN * DM * 2, SZ_WBR = (size_t)DEPTH * 3 * DM * 1024 * 2, SZ_WSQ = (size_t)DEPTH * DM * DM * 2;
constexpr size_t SZ_WPP = (size_t)DEPTH * DM * PLE * 2, SZ_WRI = (size_t)DEPTH * 8 * 128 * 128 * 2;
constexpr int N8 = 10752, NB16 = 4096;
constexpr size_t OFF_WIN = 0, OFF_WIN8 = OFF_WIN, OFF_WINB = OFF_WIN8 + (size_t)DEPTH * N8 * DM, OFF_XB8 = OFF_WINB + (size_t)DEPTH * NB16 * DM * 2, OFF_WBR = OFF_WIN + SZ_WIN, OFF_WOUT = OFF_WBR + SZ_WBR, OFF_WPG = OFF_WOUT + SZ_WSQ, OFF_WPP = OFF_WPG + SZ_WSQ;
constexpr size_t OFF_WR = OFF_WPP + SZ_WPP, OFF_WI = OFF_WR + SZ_WRI;
constexpr size_t OFF_XB = OFF_WI + SZ_WRI;
constexpr size_t OFF_VTA = OFF_XB, OFF_VTB = OFF_XB + (size_t)BATCH * 1024 * SEQ * 2;
constexpr size_t OFF_PA = OFF_XB + (size_t)M * DM * 2;
constexpr size_t OFF_X1 = OFF_PA, OFF_MG = OFF_X1 + (size_t)M * DM * 4, OFF_XB1 = OFF_MG + (size_t)M * DM * 2;
constexpr size_t OFF_GT = OFF_PA + (size_t)M * NA * 2;
constexpr size_t OFF_Y = OFF_GT + (size_t)M * NG * 2;
constexpr size_t OFF_T = OFF_Y;
constexpr size_t OFF_Y8 = OFF_Y, OFF_YC = OFF_Y + (size_t)M * 2048;
constexpr size_t OFF_WBR8 = OFF_XB8 + (size_t)M * DM;
static_assert(OFF_WBR8 + (size_t)DEPTH * 2 * DM * 1024 <= OFF_WBR, "WBR8 fits");
constexpr size_t OFF_PB = OFF_Y + (size_t)M * 3072 * 2;
constexpr size_t OFF_SSQ = OFF_PB + (size_t)DEPTH * M * PLE * 2;
constexpr size_t OFF_KM = OFF_SSQ + (size_t)5 * M * 4;
constexpr size_t OFF_CHA = OFF_KM + (size_t)BATCH * 8 * 16 * 128 * 2, OFF_CHH = OFF_CHA + (size_t)BATCH * 64 * 1024 * 4;
constexpr size_t OFF_BAR = OFF_CHH + (size_t)BATCH * 64 * 1024 * 4, BAR_BYTES = 16384;
constexpr size_t OFF_SELCNT = OFF_BAR + BAR_BYTES;
constexpr size_t OFF_LIST = OFF_SELCNT + 4096;
constexpr size_t OFF_HL = OFF_LIST + (size_t)32 * 16 * 4096 * 4, OFF_CA = OFF_HL + (size_t)M * 1024 * 2;
constexpr size_t OFF_PO = OFF_HL;
constexpr size_t OFF_ML = OFF_PO + (size_t)32 * SEQ * 3 * 128 * 2;
constexpr size_t WS_END = OFF_ML + (size_t)32 * SEQ * 3 * 2 * 4;
static_assert(WS_END <= (size_t)973078528, "workspace budget (4 x largest tensor)");
static_assert(OFF_XB1 + (size_t)M * DM * 2 <= OFF_GT, "overlay fits");
static_assert(OFF_XB8 + (size_t)M * DM <= OFF_WBR, "fp8 / bf16 in-projection weight copies + fp8 x fit the old WIN region");
static_assert(OFF_VTB + (size_t)BATCH * 256 * SEQ * 2 <= OFF_PA, "VT overlay fits");

constexpr int LDS_BYTES = 147456;
#ifndef WGM_BF
#define WGM_BF 4
#endif
constexpr int NTHR = 512;

__device__ __forceinline__ unsigned pk2(float lo, float hi) { f32x2 v = {lo, hi}; bf16x2_t b = __builtin_convertvector(v, bf16x2_t); return __builtin_bit_cast(unsigned, b); }
__device__ __forceinline__ float bf_lo(unsigned u) { return __uint_as_float(u << 16); }
__device__ __forceinline__ float bf_hi(unsigned u) { return __uint_as_float(u & 0xffff0000u); }
__device__ __forceinline__ float sigm(float v) { return __builtin_amdgcn_rcpf(1.f + __expf(-v)); }
__device__ __forceinline__ int opq(int v) { asm volatile("" : "+v"(v)); return v; }
__device__ __forceinline__ int sopq(int v) { asm volatile("" : "+s"(v)); return v; }
template <class T> __device__ __forceinline__ T launder_s(T p) { asm volatile("" : "+s"(p)); return p; }
__device__ __forceinline__ int lane_id() { return (int)__builtin_amdgcn_mbcnt_hi(~0u, __builtin_amdgcn_mbcnt_lo(~0u, 0u)); }
__device__ __forceinline__ int crow(int r, int hi) { return (r & 3) + 8 * (r >> 2) + 4 * hi; }
__device__ __forceinline__ float wave_sum(float v) {
#pragma unroll
    for (int o = 1; o < 64; o <<= 1) v += __shfl_xor(v, o);
    return v;
}
__device__ __forceinline__ int t5_bucket(int n) {
    if (n < 16) return n;
    int b = 16;
    b += (n >= 19); b += (n >= 21); b += (n >= 24); b += (n >= 27); b += (n >= 31); b += (n >= 35); b += (n >= 40); b += (n >= 46);
    b += (n >= 52); b += (n >= 59); b += (n >= 67); b += (n >= 77); b += (n >= 87); b += (n >= 99); b += (n >= 113);
    return b;
}

namespace pg8 {
constexpr int BM = 256, BK = 64, HALF = 128, HTB = HALF * BK * 2, STAGE_BYTES = 8 * HTB, NXCD = 8, WGM = 4;
__device__ __forceinline__ int lds_byte(int r, int c) { const int st = (r >> 4) * 2 + (c >> 5), rr = r & 15, cc = c & 31, ob = rr * 64 + cc * 2; return st * 1024 + (ob ^ (((ob >> 9) & 1) << 5)); }
__device__ __forceinline__ void stage_rc(int b, int& R, int& C) { const int st = b / 1024, sb = b % 1024, swz = sb ^ (((sb >> 9) & 1) << 5); R = (st >> 1) * 16 + swz / 64; C = (st & 1) * 32 + (swz % 64) / 2; }
__device__ __forceinline__ int perm32(int rho) { const int n = rho >> 4, i = rho & 15; return 8 * (i >> 2) + 4 * n + (i & 3); }

typedef int v4i_t __attribute__((ext_vector_type(4)));
typedef int v8i_t __attribute__((ext_vector_type(8)));
__device__ __forceinline__ v8i_t cat8(bf16x8 lo, bf16x8 hi) { return __builtin_shufflevector(__builtin_bit_cast(v4i_t, lo), __builtin_bit_cast(v4i_t, hi), 0, 1, 2, 3, 4, 5, 6, 7); }
__device__ __forceinline__ void glds16_s(const char* sbase, unsigned voff, unsigned ldsbase, int imm) { unsigned keep;
    asm volatile("s_mov_b32 %0, m0\n\ts_add_i32 m0, %3, %4\n\ts_nop 0\n\tglobal_load_lds_dwordx4 %1, %2\n\ts_mov_b32 m0, %0" : "=&s"(keep) : "v"(voff), "s"(sbase), "s"(ldsbase), "i"(imm) : "memory", "scc"); }
struct Unit { int pm, pn, z; };
struct Gemm { const bf16_t* A; const bf16_t* Bt; int lda, ldb, K; size_t zA, zB; int wave; };

struct StaticOrder {
    int nM, nN, nwg, G, c, wgm; bool tr;
    __device__ void init(int M_, int N_, int G_, int c_, int wgm_ = 4, bool tr_ = false) { nM = M_ / BM; nN = N_ / BM; nwg = nM * nN; G = G_; c = c_; wgm = wgm_; tr = tr_; }
    __device__ bool next(int i, Unit& u) const {
        const long L = (long)i * G + c; if (L >= nwg) return false;
        int wgid = (int)L; { const int q = nwg / NXCD, r = nwg % NXCD, xcd = wgid % NXCD, off = wgid / NXCD; wgid = (xcd < r ? xcd * (q + 1) : r * (q + 1) + (xcd - r) * q) + off; }
        const int nR = tr ? nN : nM, nS = tr ? nM : nN;
        const int nig = wgm * nS, gid = wgid / nig, f0 = gid * wgm, gsz = (nR - f0) < wgm ? (nR - f0) : wgm;
        const int pr = f0 + ((wgid % nig) % gsz), ps = (wgid % nig) / gsz;
        u.pm = tr ? ps : pr; u.pn = tr ? pr : ps; u.z = 0; return true;
    }
};
struct ZOrder2 {
    StaticOrder S;
    __device__ bool next(int i, Unit& u) const { if (!S.next(i >> 1, u)) return false; u.z = i & 1; return true; }
};
struct ZFixed {
    StaticOrder S; int z;
    __device__ bool next(int i, Unit& u) const { if (!S.next(i, u)) return false; u.z = z; return true; }
};

template <class Epi, class Sched, bool ALIGN_EPI, bool F8 = false>
__device__ __forceinline__ void gemm_phase(LAS unsigned char* lds, const Gemm g, const Sched& S, const Epi& E) {
    const int wid = __builtin_amdgcn_readfirstlane(g.wave), tid = opq((wid << 6) | lane_id()), lane = tid & 63, wr = wid >> 2, wc = wid & 3, fr = lane & 15, fq = lane >> 4;
    const int K = g.K, nt = K / BK;
    unsigned voffA[2], voffB[2];
#pragma unroll
    for (int i = 0; i < 2; ++i) { int R, C; stage_rc(tid * 16 + i * 8192, R, C); const int Rb = (R & ~31) + perm32(R & 31);
        voffA[i] = (unsigned)(R * g.lda + C) * 2u; voffB[i] = (unsigned)(Rb * g.ldb + C) * 2u; }
    const unsigned kstep = (unsigned)(BK * 2);
    const unsigned hstepA = (unsigned)HALF * g.lda * 2u, hstepB = (unsigned)HALF * g.ldb * 2u;
    const unsigned tstepA = 2u * hstepA, tstepB = 2u * hstepB;
    const unsigned ldsw = (unsigned)wid * 1024u;
    const unsigned lds_w32 = (unsigned)__builtin_amdgcn_readfirstlane((int)((unsigned)(uintptr_t)lds + ldsw));
    constexpr int KOFF = F8 ? 16 : 1024;
    const int aoff = lds_byte(wr * 64 + fr, F8 ? fq * 16 : fq * 8), boff = lds_byte(wc * 32 + fr, F8 ? fq * 16 : fq * 8);
#define PG8_SA(b, h) (((b) * 2 + (h)) * HTB)
#define PG8_SB(b, h) ((4 + (b) * 2 + (h)) * HTB)
#define PG8_STAGE_X(bufoff, rs, base, off, voff) do { _Pragma("unroll") for (int _i = 0; _i < 2; ++_i) { \
        if constexpr (F8) __builtin_amdgcn_raw_ptr_buffer_load_lds(rs, (LAS void*)(lds + (bufoff) + ldsw + _i * 8192), 16, (int)(voff)[_i], (int)(unsigned)(off), 0, 0); \
        else __builtin_amdgcn_global_load_lds((const unsigned*)((const char*)(base) + (size_t)((off) + (voff)[_i])), (LAS unsigned*)(lds + (bufoff) + ldsw + _i * 8192), 16, 0, 0); } } while (0)
#define PG8_STAGE_A(bufoff, off) PG8_STAGE_X(bufoff, rsA, g.A, off, voffA)
#define PG8_STAGE_B(bufoff, off) PG8_STAGE_X(bufoff, rsB, g.Bt, off, voffB)
#define PG8_LDA(dst, b, h) do { _Pragma("unroll") for (int m = 0; m < 4; ++m) _Pragma("unroll") for (int k = 0; k < 2; ++k) { const v4i_t f_ = *(const LAS v4i_t*)(lds + PG8_SA(b, h) + aoff + m * 2048 + k * KOFF); dst[m][4 * k] = f_[0]; dst[m][4 * k + 1] = f_[1]; dst[m][4 * k + 2] = f_[2]; dst[m][4 * k + 3] = f_[3]; } } while (0)
#define PG8_LDB(dst, b, h) do { _Pragma("unroll") for (int n = 0; n < 2; ++n) _Pragma("unroll") for (int k = 0; k < 2; ++k) { const v4i_t f_ = *(const LAS v4i_t*)(lds + PG8_SB(b, h) + boff + n * 2048 + k * KOFF); dst[n][4 * k] = f_[0]; dst[n][4 * k + 1] = f_[1]; dst[n][4 * k + 2] = f_[2]; dst[n][4 * k + 3] = f_[3]; } } while (0)
#define PG8_HALF(v, k) __builtin_bit_cast(bf16x8, (v4i_t){v[4 * (k)], v[4 * (k) + 1], v[4 * (k) + 2], v[4 * (k) + 3]})
#define PG8_MMA(ai, bj, At, Bt) do { __builtin_amdgcn_s_setprio(1); \
        if constexpr (F8) { _Pragma("unroll") for (int m = 0; m < 4; ++m) _Pragma("unroll") for (int n = 0; n < 2; ++n) \
            acc[ai][bj][m][n] = __builtin_amdgcn_mfma_scale_f32_16x16x128_f8f6f4(Bt[n], At[m], acc[ai][bj][m][n], 0, 0, 0, 0, 0, 0); }     \
        else { _Pragma("unroll") for (int m = 0; m < 4; ++m) _Pragma("unroll") for (int n = 0; n < 2; ++n) _Pragma("unroll") for (int k = 0; k < 2; ++k) \
            acc[ai][bj][m][n] = __builtin_amdgcn_mfma_f32_16x16x32_bf16(PG8_HALF(Bt[n], k), PG8_HALF(At[m], k), acc[ai][bj][m][n], 0, 0, 0); } \
        __builtin_amdgcn_s_setprio(0); } while (0)
#define PG8_WAIT_V(n) asm volatile("s_waitcnt vmcnt(" #n ")" ::: "memory")
#define PG8_WAIT_L(n) asm volatile("s_waitcnt lgkmcnt(" #n ")" ::: "memory")
#define PG8_BAR __builtin_amdgcn_s_barrier()
#define PG8_SCHED __builtin_amdgcn_sched_barrier(0)
    Unit cur, nxt; int ui = 0;
    if (!S.next(0, cur)) return;
    f32x4 acc[2][2][4][2];
#pragma unroll
    for (int a = 0; a < 2; ++a)
#pragma unroll
        for (int b = 0; b < 2; ++b)
#pragma unroll
            for (int m = 0; m < 4; ++m)
#pragma unroll
                for (int n = 0; n < 2; ++n) acc[a][b][m][n] = (f32x4){0.f, 0.f, 0.f, 0.f};
    v8i_t At[4], B0[2], B1[2];
    unsigned cA = (unsigned)cur.pm * tstepA + (unsigned)cur.z * (unsigned)g.zA, cB = (unsigned)cur.pn * tstepB + (unsigned)cur.z * (unsigned)g.zB;
    __amdgpu_buffer_rsrc_t rsA = __builtin_amdgcn_make_buffer_rsrc((void*)g.A, 0, 0x7fffffff, 0x00020000), rsB = __builtin_amdgcn_make_buffer_rsrc((void*)g.Bt, 0, 0x7fffffff, 0x00020000); (void)rsA; (void)rsB;
    PG8_STAGE_B(PG8_SB(0, 0), cB); PG8_STAGE_B(PG8_SB(0, 1), cB + hstepB); PG8_STAGE_A(PG8_SA(0, 0), cA); PG8_STAGE_A(PG8_SA(0, 1), cA + hstepA);
    if (wr == 1) PG8_BAR;
    PG8_WAIT_V(2); PG8_BAR;
    PG8_STAGE_B(PG8_SB(1, 0), cB + kstep); PG8_STAGE_A(PG8_SA(1, 0), cA + kstep); PG8_STAGE_B(PG8_SB(1, 1), cB + hstepB + kstep);
    PG8_WAIT_V(6); PG8_BAR;
    for (;;) {
        const bool has_next = S.next(ui + 1, nxt);
        const unsigned nA = has_next ? (unsigned)nxt.pm * tstepA + (unsigned)nxt.z * (unsigned)g.zA : cA;
        const unsigned nB = has_next ? (unsigned)nxt.pn * tstepB + (unsigned)nxt.z * (unsigned)g.zB : cB;
#pragma unroll 1
        for (int t = 0; t < nt; t += 2) {
            const bool last = (t == nt - 2);
            const unsigned a1 = cA + (unsigned)(t + 1) * kstep;
            const unsigned a2 = last ? nA : cA + (unsigned)(t + 2) * kstep; const unsigned b2 = last ? nB : cB + (unsigned)(t + 2) * kstep;
            const unsigned a3 = a2 + kstep; const unsigned b3 = b2 + kstep;
            PG8_LDB(B0, 0, 0); PG8_LDB(B1, 0, 1); PG8_SCHED; PG8_LDA(At, 0, 0); PG8_STAGE_A(PG8_SA(1, 1), a1 + hstepA);
            PG8_WAIT_V(8); PG8_WAIT_L(0); PG8_BAR; PG8_MMA(0, 0, At, B0); PG8_MMA(0, 1, At, B1); PG8_BAR; PG8_SCHED;
            PG8_LDA(At, 0, 1); PG8_STAGE_B(PG8_SB(0, 0), b2); PG8_STAGE_B(PG8_SB(0, 1), b2 + hstepB); PG8_STAGE_A(PG8_SA(0, 0), a2);
            PG8_WAIT_V(8); PG8_WAIT_L(0); PG8_BAR; PG8_MMA(1, 0, At, B0); PG8_MMA(1, 1, At, B1); PG8_BAR; PG8_SCHED;
            PG8_LDB(B0, 1, 0); PG8_LDB(B1, 1, 1); PG8_SCHED; PG8_LDA(At, 1, 0); PG8_STAGE_A(PG8_SA(0, 1), a2 + hstepA);
            PG8_WAIT_V(8); PG8_WAIT_L(0); PG8_BAR; PG8_MMA(0, 0, At, B0); PG8_MMA(0, 1, At, B1); PG8_BAR; PG8_SCHED;
            PG8_LDA(At, 1, 1); PG8_STAGE_B(PG8_SB(1, 0), b3); PG8_STAGE_B(PG8_SB(1, 1), b3 + hstepB); PG8_STAGE_A(PG8_SA(1, 0), a3);
            PG8_WAIT_V(8); PG8_WAIT_L(0); PG8_BAR; PG8_MMA(1, 0, At, B0); PG8_MMA(1, 1, At, B1); PG8_BAR; PG8_SCHED;
        }
        if constexpr (ALIGN_EPI) { if (wr == 0) PG8_BAR; }
        { const int l2_ = opq(lane_id()); E(acc, cur, wr, wc, l2_ & 15, l2_ >> 4); }
        if (!has_next) break;
#pragma unroll
        for (int a = 0; a < 2; ++a)
#pragma unroll
            for (int b = 0; b < 2; ++b)
#pragma unroll
                for (int m = 0; m < 4; ++m)
#pragma unroll
                    for (int n = 0; n < 2; ++n) acc[a][b][m][n] = (f32x4){0.f, 0.f, 0.f, 0.f};
        cur = nxt; cA = nA; cB = nB; ++ui;
        if constexpr (ALIGN_EPI) { if (wr == 1) PG8_BAR; }
    }
    PG8_WAIT_V(0);
    if constexpr (!ALIGN_EPI) { if (wr == 0) PG8_BAR; }
    PG8_BAR;
#undef PG8_SA
#undef PG8_SB
#undef PG8_STAGE_X
#undef PG8_STAGE_A
#undef PG8_STAGE_B
#undef PG8_LDA
#undef PG8_LDB
#undef PG8_MMA
#undef PG8_HALF
#undef PG8_WAIT_V
#undef PG8_WAIT_L
#undef PG8_BAR
#undef PG8_SCHED
}

template <int ACT> __device__ __forceinline__ float actf(float v) { if (ACT == 1) return v * sigm(v); if (ACT == 2) return sigm(v); return v; }
template <int ACT> __device__ __forceinline__ u32x4 pack8(f32x4 v0, f32x4 v1, float s) {
    u32x4 w; w.x = pk2(actf<ACT>(v0[0] * s), actf<ACT>(v0[1] * s)); w.y = pk2(actf<ACT>(v0[2] * s), actf<ACT>(v0[3] * s));
    w.z = pk2(actf<ACT>(v1[0] * s), actf<ACT>(v1[1] * s)); w.w = pk2(actf<ACT>(v1[2] * s), actf<ACT>(v1[3] * s)); return w;
}
struct EpiIn {
    bf16_t* PA; bf16_t* GT; const float* ssq; int mode; float oscale;
    template <int ACT> __device__ __forceinline__ void st(const f32x4 (&acc)[2][2][4][2], bf16_t* base, int ldc, int row0, int col0) const {
        float rs[2][4];
#pragma unroll
        for (int ai = 0; ai < 2; ++ai)
#pragma unroll
            for (int m = 0; m < 4; ++m) rs[ai][m] = ssq[row0 + ai * HALF + m * 16];
#pragma unroll
        for (int ai = 0; ai < 2; ++ai)
#pragma unroll
            for (int m = 0; m < 4; ++m) { const int row = row0 + ai * HALF + m * 16; const float r = rsqrtf(rs[ai][m] * (1.f / DM) + EPS) * oscale;
                bf16_t* rowp = base + (size_t)row * ldc + col0;
#pragma unroll
                for (int bj = 0; bj < 2; ++bj) *(u32x4*)(rowp + bj * HALF) = pack8<ACT>(acc[ai][bj][m][0], acc[ai][bj][m][1], r); }
    }
    __device__ __forceinline__ void operator()(const f32x4 (&acc)[2][2][4][2], const Unit& u, int wr, int wc, int fr, int fq) const {
        const int pn = (mode == 1) ? (u.pn < 18 ? u.pn + 8 : u.pn + 16) : (u.pn < 8 ? u.pn : u.pn + 18), row0 = u.pm * BM + wr * 64 + fr;
        if (pn >= 34) { st<2>(acc, GT, NG, row0, (pn - 34) * BM + wc * 32 + 8 * fq); }
        else { const int col0 = pn * BM + wc * 32 + 8 * fq;
            const bool silu = (pn >= 12 && pn < 16) || (pn >= 22 && pn < 26) || (pn >= 30);
            if (silu) st<1>(acc, PA, NA, row0, col0); else st<0>(acc, PA, NA, row0, col0); }
    }
};
struct EpiPlain {
    bf16_t* O; int ldc;
    __device__ __forceinline__ void operator()(const f32x4 (&acc)[2][2][4][2], const Unit& u, int wr, int wc, int fr, int fq) const {
        const int row0 = u.pm * BM + wr * 64 + fr, col0 = u.pn * BM + wc * 32 + 8 * fq;
#pragma unroll
        for (int ai = 0; ai < 2; ++ai)
#pragma unroll
            for (int m = 0; m < 4; ++m) { bf16_t* rowp = O + (size_t)(row0 + ai * HALF + m * 16) * ldc + col0;
#pragma unroll
                for (int bj = 0; bj < 2; ++bj) *(u32x4*)(rowp + bj * HALF) = pack8<0>(acc[ai][bj][m][0], acc[ai][bj][m][1], 1.f); }
    }
};
struct EpiMerge {
    const bf16_t* GT; bf16_t* MG; float oscale;
    __device__ __forceinline__ void operator()(const f32x4 (&acc)[2][2][4][2], const Unit& u, int wr, int wc, int fr, int fq) const {
        const int row0 = u.pm * BM + wr * 64 + fr, col0 = u.pn * BM + wc * 32 + 8 * fq, z = u.z;
#pragma unroll
        for (int ai = 0; ai < 2; ++ai)
#pragma unroll
            for (int bj = 0; bj < 2; ++bj) { const int col = col0 + bj * HALF;
                u32x4 gw[4], tw[4];
#pragma unroll
                for (int m = 0; m < 4; ++m) { const size_t row = (size_t)(row0 + ai * HALF + m * 16);
                    gw[m] = *(const u32x4*)(GT + row * NG + z * DM + col);
                    tw[m] = (z > 0) ? *(const u32x4*)(MG + row * DM + col) : (u32x4){0u, 0u, 0u, 0u}; }
#pragma unroll
                for (int m = 0; m < 4; ++m) { const size_t row = (size_t)(row0 + ai * HALF + m * 16);
                    const f32x4 a0 = acc[ai][bj][m][0] * oscale, a1 = acc[ai][bj][m][1] * oscale; u32x4 w;
                    w.x = pk2(a0[0] * bf_lo(gw[m].x) + bf_lo(tw[m].x), a0[1] * bf_hi(gw[m].x) + bf_hi(tw[m].x));
                    w.y = pk2(a0[2] * bf_lo(gw[m].y) + bf_lo(tw[m].y), a0[3] * bf_hi(gw[m].y) + bf_hi(tw[m].y));
                    w.z = pk2(a1[0] * bf_lo(gw[m].z) + bf_lo(tw[m].z), a1[1] * bf_hi(gw[m].z) + bf_hi(tw[m].z));
                    w.w = pk2(a1[2] * bf_lo(gw[m].w) + bf_lo(tw[m].w), a1[3] * bf_hi(gw[m].w) + bf_hi(tw[m].w));
                    *(u32x4*)(MG + row * DM + col) = w; } }
    }
};
struct EpiOut {
    const float* xin; float* X1; bf16_t* XB1; float* ssq;
    __device__ __forceinline__ void operator()(const f32x4 (&acc)[2][2][4][2], const Unit& u, int wr, int wc, int fr, int fq) const {
        const int row0 = u.pm * BM + wr * 64 + fr, col0 = u.pn * BM + wc * 32 + 8 * fq;
#pragma unroll
        for (int ai = 0; ai < 2; ++ai) { float s[4] = {0.f, 0.f, 0.f, 0.f};
#pragma unroll
            for (int bj = 0; bj < 2; ++bj) { f32x4 x0[4], x1[4];
#pragma unroll
                for (int m = 0; m < 4; ++m) { const size_t o = (size_t)(row0 + ai * HALF + m * 16) * DM + col0 + bj * HALF; x0[m] = *(const f32x4*)(xin + o); x1[m] = *(const f32x4*)(xin + o + 4); }
#pragma unroll
                for (int m = 0; m < 4; ++m) { const size_t o = (size_t)(row0 + ai * HALF + m * 16) * DM + col0 + bj * HALF;
                    const f32x4 v0 = x0[m] + acc[ai][bj][m][0], v1 = x1[m] + acc[ai][bj][m][1];
                    *(f32x4*)(X1 + o) = v0; *(f32x4*)(X1 + o + 4) = v1;
                    u32x4 w; w.x = pk2(v0[0], v0[1]); w.y = pk2(v0[2], v0[3]); w.z = pk2(v1[0], v1[1]); w.w = pk2(v1[2], v1[3]); *(u32x4*)(XB1 + o) = w;
                    s[m] += (v0[0] * v0[0] + v0[1] * v0[1]) + (v0[2] * v0[2] + v0[3] * v0[3]) + (v1[0] * v1[0] + v1[1] * v1[1]) + (v1[2] * v1[2] + v1[3] * v1[3]); } }
#pragma unroll
            for (int m = 0; m < 4; ++m) { float t = s[m]; t += __shfl_xor(t, 16); t += __shfl_xor(t, 32);
                if (fq == 0) atomicAdd(ssq + (row0 + ai * HALF + m * 16), t); } }
    }
};
struct EpiPle {
    const float* X1; const bf16_t* T; const float* ssq1; float* xout; bf16_t* XB; unsigned char* XB8; float* ssq2; bool wxb;
    __device__ __forceinline__ void operator()(const f32x4 (&acc)[2][2][4][2], const Unit& u, int wr, int wc, int fr, int fq) const {
        const int row0 = u.pm * BM + wr * 64 + fr, col0 = u.pn * BM + wc * 32 + 8 * fq;
        float rsv[2][4];
#pragma unroll
        for (int ai = 0; ai < 2; ++ai)
#pragma unroll
            for (int m = 0; m < 4; ++m) rsv[ai][m] = ssq1[row0 + ai * HALF + m * 16];
#pragma unroll
        for (int ai = 0; ai < 2; ++ai) { float s[4] = {0.f, 0.f, 0.f, 0.f};
#pragma unroll
            for (int bj = 0; bj < 2; ++bj)
#pragma unroll
              for (int mh = 0; mh < 2; ++mh) { f32x4 x0[2], x1[2]; u32x4 tw[2];
#pragma unroll
                for (int mm = 0; mm < 2; ++mm) { const int m = 2 * mh + mm; const size_t o = (size_t)(row0 + ai * HALF + m * 16) * DM + col0 + bj * HALF; x0[mm] = *(const f32x4*)(X1 + o); x1[mm] = *(const f32x4*)(X1 + o + 4); tw[mm] = *(const u32x4*)(T + o); }
#pragma unroll
                for (int mm = 0; mm < 2; ++mm) { const int m = 2 * mh + mm; const size_t o = (size_t)(row0 + ai * HALF + m * 16) * DM + col0 + bj * HALF;
                    const float rs = rsqrtf(rsv[ai][m] * (1.f / DM) + EPS);
                    const f32x4 a0 = acc[ai][bj][m][0], a1 = acc[ai][bj][m][1]; f32x4 v0 = x0[mm], v1 = x1[mm];
                    v0[0] += sigm(a0[0] * rs) * bf_lo(tw[mm].x); v0[1] += sigm(a0[1] * rs) * bf_hi(tw[mm].x); v0[2] += sigm(a0[2] * rs) * bf_lo(tw[mm].y); v0[3] += sigm(a0[3] * rs) * bf_hi(tw[mm].y);
                    v1[0] += sigm(a1[0] * rs) * bf_lo(tw[mm].z); v1[1] += sigm(a1[1] * rs) * bf_hi(tw[mm].z); v1[2] += sigm(a1[2] * rs) * bf_lo(tw[mm].w); v1[3] += sigm(a1[3] * rs) * bf_hi(tw[mm].w);
                    *(f32x4*)(xout + o) = v0; *(f32x4*)(xout + o + 4) = v1;
                    if (wxb) { u32x4 w; w.x = pk2(v0[0], v0[1]); w.y = pk2(v0[2], v0[3]); w.z = pk2(v1[0], v1[1]); w.w = pk2(v1[2], v1[3]); *(u32x4*)(XB + o) = w;
                        int q0 = 0, q1 = 0; q0 = __builtin_amdgcn_cvt_pk_fp8_f32(v0[0] * 8.f, v0[1] * 8.f, q0, false); q0 = __builtin_amdgcn_cvt_pk_fp8_f32(v0[2] * 8.f, v0[3] * 8.f, q0, true);
                        q1 = __builtin_amdgcn_cvt_pk_fp8_f32(v1[0] * 8.f, v1[1] * 8.f, q1, false); q1 = __builtin_amdgcn_cvt_pk_fp8_f32(v1[2] * 8.f, v1[3] * 8.f, q1, true);
                        *(u32x2*)(XB8 + o) = (u32x2){(unsigned)q0, (unsigned)q1}; }
                    s[m] += (v0[0] * v0[0] + v0[1] * v0[1]) + (v0[2] * v0[2] + v0[3] * v0[3]) + (v1[0] * v1[0] + v1[1] * v1[1]) + (v1[2] * v1[2] + v1[3] * v1[3]); } }
#pragma unroll
            for (int m = 0; m < 4; ++m) { float t = s[m]; t += __shfl_xor(t, 16); t += __shfl_xor(t, 32);
                if (fq == 0) atomicAdd(ssq2 + (row0 + ai * HALF + m * 16), t); } }
    }
};
}

template <bool F8> __device__ __forceinline__ void transpose_item(const float* W, int K, int N, int ld, void* WTv, const float* kscale, float wscale, LAS float* scr, int item, int lane_) {
    const int lane = opq(lane_);
    const int nblk = N / 64, kb = item / nblk, nb = item % nblk, k0 = 64 * kb, n0 = 64 * nb;
    float v[64];
#pragma unroll
    for (int kk = 0; kk < 64; ++kk) v[kk] = W[(size_t)(k0 + kk) * ld + n0 + lane];
#pragma unroll
    for (int kk = 0; kk < 64; ++kk) { const float sc = (kscale ? kscale[k0 + kk] : 1.f) * wscale; scr[kk * 65 + lane] = v[kk] * sc; }
    if constexpr (F8) {
        unsigned char* WT = (unsigned char*)WTv; const int c = lane & 3;
#pragma unroll
        for (int j = 0; j < 4; ++j) { const int n = (lane >> 2) + 16 * j; const LAS float* s = scr + (16 * c) * 65 + n; int q[4];
#pragma unroll
            for (int d = 0; d < 4; ++d) { int w = 0; w = __builtin_amdgcn_cvt_pk_fp8_f32(s[(4 * d) * 65], s[(4 * d + 1) * 65], w, false); w = __builtin_amdgcn_cvt_pk_fp8_f32(s[(4 * d + 2) * 65], s[(4 * d + 3) * 65], w, true); q[d] = w; }
            *(u32x4*)(WT + (size_t)(n0 + n) * K + k0 + 16 * c) = (u32x4){(unsigned)q[0], (unsigned)q[1], (unsigned)q[2], (unsigned)q[3]}; }
    } else {
        bf16_t* WT = (bf16_t*)WTv; const int c = lane & 7;
#pragma unroll
        for (int j = 0; j < 8; ++j) { const int n = (lane >> 3) + 8 * j; const LAS float* s = scr + (8 * c) * 65 + n;
            u32x4 o; o.x = pk2(s[0 * 65], s[1 * 65]); o.y = pk2(s[2 * 65], s[3 * 65]); o.z = pk2(s[4 * 65], s[5 * 65]); o.w = pk2(s[6 * 65], s[7 * 65]);
            *(u32x4*)(WT + (size_t)(n0 + n) * K + k0 + 8 * c) = o; }
    }
}
template <bool F8 = false> __device__ __forceinline__ void transpose_matrix(const float* W, int K, int N, int ld, void* WT, const float* kscale, float wscale, LAS float* scr, int gw, int NGW, int lane) {
    const int nitems = (K / 64) * (N / 64);
    for (int it = gw; it < nitems; it += NGW) transpose_item<F8>(W, K, N, ld, WT, kscale, wscale, scr, it, lane);
}

struct Args { const float* in[19]; float* out; unsigned char* ws; int ph_lo, ph_hi; };
typedef const __attribute__((address_space(4))) Args* KArgs;
struct Ptrs {
    __device__ __forceinline__ void reload(KArgs a) {
        x = a->in[0]; p = a->in[1]; rpe = a->in[2]; norm_g = a->in[3]; w_in = a->in[4]; sinks = a->in[5]; conv_w = a->in[6]; conv_b = a->in[7]; w_r = a->in[8]; b_r = a->in[9]; w_i = a->in[10];
        b_i = a->in[11]; lam = a->in[12]; w_br = a->in[13]; w_out = a->in[14]; ple_g = a->in[15]; w_pg = a->in[16]; w_pp = a->in[17]; fin_g = a->in[18]; out = a->out; ws = a->ws; }
    const float *x, *p, *rpe, *norm_g, *w_in, *sinks, *conv_w, *conv_b, *w_r, *b_r, *w_i, *b_i, *lam, *w_br, *w_out, *ple_g, *w_pg, *w_pp, *fin_g;
    float* out; unsigned char* ws; int wave;
#define WSP(NAME, TYPE, OFF) __device__ __forceinline__ TYPE* NAME() const { return (TYPE*)(ws + (OFF)); }
    WSP(WIN8, unsigned char, OFF_WIN8) WSP(WINB, bf16_t, OFF_WINB) WSP(XB8, unsigned char, OFF_XB8) WSP(WBR, bf16_t, OFF_WBR) WSP(WOUT, bf16_t, OFF_WOUT) WSP(WPG, bf16_t, OFF_WPG) WSP(WPP, bf16_t, OFF_WPP) WSP(WR, bf16_t, OFF_WR) WSP(WI, bf16_t, OFF_WI)
    WSP(XB, bf16_t, OFF_XB) WSP(VTA, bf16_t, OFF_VTA) WSP(VTB, bf16_t, OFF_VTB) WSP(PA, bf16_t, OFF_PA) WSP(MG, bf16_t, OFF_MG) WSP(XB1, bf16_t, OFF_XB1) WSP(GT, bf16_t, OFF_GT)
    WSP(Y8, unsigned char, OFF_Y8) WSP(YC, bf16_t, OFF_YC) WSP(WBR8, unsigned char, OFF_WBR8) WSP(T, bf16_t, OFF_T) WSP(HL, bf16_t, OFF_HL) WSP(CA, bf16_t, OFF_CA) WSP(PB, bf16_t, OFF_PB) WSP(KM, bf16_t, OFF_KM)
    WSP(X1, float, OFF_X1) WSP(SSQ, float, OFF_SSQ) WSP(CHA, float, OFF_CHA) WSP(CHH, float, OFF_CHH)
    WSP(SELCNT, unsigned, OFF_SELCNT) WSP(LIST, unsigned, OFF_LIST) WSP(PO, bf16_t, OFF_PO) WSP(ML, float, OFF_ML)
#undef WSP
};

__device__ __forceinline__ void kmean_item(LAS unsigned char* lds, const Ptrs& P, int it) {
    const int tid = opq((P.wave << 6) | lane_id()), b = it >> 7, h = (it >> 4) & 7, n = it & 15;
    const int rg = tid >> 4, c8 = tid & 15;
    float s0 = 0.f, s1 = 0.f, s2 = 0.f, s3 = 0.f, s4 = 0.f, s5 = 0.f, s6 = 0.f, s7 = 0.f;
#pragma unroll
    for (int i = 0; i < 8; ++i) { const int row = rg + 32 * i;
        const u32x4 w = *(const u32x4*)(P.PA() + (size_t)(b * SEQ + n * 256 + row) * NA + C_KA + h * 128 + c8 * 8);
        s0 += bf_lo(w.x); s1 += bf_hi(w.x); s2 += bf_lo(w.y); s3 += bf_hi(w.y); s4 += bf_lo(w.z); s5 += bf_hi(w.z); s6 += bf_lo(w.w); s7 += bf_hi(w.w); }
    LAS float* red = (LAS float*)lds;
    LAS float* rp = red + rg * 128 + c8 * 8;
    rp[0] = s0; rp[1] = s1; rp[2] = s2; rp[3] = s3; rp[4] = s4; rp[5] = s5; rp[6] = s6; rp[7] = s7;
    __syncthreads();
    if (tid < 128) { float s = 0.f;
#pragma unroll 8
        for (int r = 0; r < 32; ++r) s += red[r * 128 + tid];
        P.KM()[(size_t)it * 128 + tid] = (bf16_t)(pk2(s * (1.f / 256.f), 0.f) & 0xffffu); }
    __syncthreads();
}
__device__ __forceinline__ void vtrans_item(LAS unsigned char* scr, const Ptrs& P, int it, int lane_) {
    const int lane = opq(lane_);
    int b, tt, colbase; bf16_t* dst0;
    if (it < 4096) { b = it >> 10; const int r = it & 1023; tt = r >> 4; const int ct = r & 15; colbase = C_VA + ct * 64; dst0 = P.VTA() + ((size_t)(b * 1024 + ct * 64) * SEQ + tt * 64); }
    else { it -= 4096; b = it >> 8; const int r = it & 255; tt = r >> 2; const int ct = r & 3; colbase = C_VB + ct * 64; dst0 = P.VTB() + ((size_t)(b * 256 + ct * 64) * SEQ + tt * 64); }
#pragma unroll
    for (int i = 0; i < 8; ++i) { const int row = i * 8 + (lane >> 3), c8 = lane & 7;
        const u32x4 w = *(const u32x4*)(P.PA() + (size_t)(b * SEQ + tt * 64 + row) * NA + colbase + c8 * 8);
        *(LAS u32x4*)(scr + row * 144 + c8 * 16) = w; }
#pragma unroll
    for (int i = 0; i < 8; ++i) { const int c = (lane >> 3) + 8 * i, tg = lane & 7; unsigned e[8];
#pragma unroll
        for (int k = 0; k < 8; ++k) e[k] = *(const LAS unsigned short*)(scr + (tg * 8 + k) * 144 + c * 2);
        u32x4 o; o.x = e[0] | (e[1] << 16); o.y = e[2] | (e[3] << 16); o.z = e[4] | (e[5] << 16); o.w = e[6] | (e[7] << 16);
        *(u32x4*)(dst0 + (size_t)c * SEQ + tg * 8) = o; }
}
__device__ __forceinline__ void lru_local_phase(LAS unsigned char* lds, const Ptrs& P, int l, int bx, int G) {
    const int tid = opq((P.wave << 6) | lane_id()), lane = tid & 63, wid = __builtin_amdgcn_readfirstlane(tid >> 6);
    constexpr int NIT = BATCH * 64 * 8;
    u32x4 xw[4][2];
#define LRU_LOAD(itx) do { const int b_ = (itx) >> 9, c_ = ((itx) >> 3) & 63, n_ = (itx) & 7; \
        _Pragma("unroll") for (int w = 0; w < 4; ++w) { int tt_ = c_ * 64 + (tid >> 3) - 3 + w; tt_ = tt_ < 0 ? 0 : tt_; \
            const bf16_t* src_ = P.PA() + (size_t)(b_ * SEQ + tt_) * NA + C_XC + n_ * 128 + (tid & 7) * 16; \
            xw[w][0] = *(const u32x4*)src_; xw[w][1] = *(const u32x4*)(src_ + 8); } } while (0)
    if (bx < NIT) LRU_LOAD(bx);
    int n_cur = -1; bf16x8 br[4], bi[4]; float brv = 0.f, biv = 0.f, c8sp = 0.f; f32x4 cbv[4], cwv[4][4];
#pragma unroll 1
    for (int it = bx; it < NIT; it += G) {
    const int b = it >> 9, c = (it >> 3) & 63, n = it & 7, t0 = c * 64, ch0 = n * 128;
    const int col = lane & 15, quad = lane >> 4, d0 = 16 * wid, ch = ch0 + d0 + col;
    if (n != n_cur) {
        n_cur = n;
        const size_t wofs = ((size_t)(l * 8 + n) * 128 + d0 + col) * 128 + quad * 8;
#pragma unroll
        for (int ks = 0; ks < 4; ++ks) { br[ks] = *(const bf16x8*)(P.WR() + wofs + ks * 32); bi[ks] = *(const bf16x8*)(P.WI() + wofs + ks * 32); }
        brv = P.b_r[l * 1024 + ch]; biv = P.b_i[l * 1024 + ch]; c8sp = -8.f * log1pf(__expf(-P.lam[l * 1024 + ch]));
        const int chb_ = ch0 + (tid & 7) * 16;
#pragma unroll
        for (int q = 0; q < 4; ++q) cbv[q] = *(const f32x4*)(P.conv_b + l * 1024 + chb_ + 4 * q);
#pragma unroll
        for (int w = 0; w < 4; ++w)
#pragma unroll
            for (int q = 0; q < 4; ++q) cwv[w][q] = *(const f32x4*)(P.conv_w + (size_t)(l * 4 + w) * 1024 + chb_ + 4 * q);
    }
    LAS unsigned char* convb = lds;
    LAS float* convf = (LAS float*)(lds + 17408);
    LAS unsigned char* hlS = lds + 51200;
    LAS unsigned char* caS = lds + 68608;
    {
        const int t = tid >> 3, cg8 = tid & 7, chb = ch0 + cg8 * 16;
        float a[16];
#pragma unroll
        for (int q = 0; q < 4; ++q) { const f32x4 v = cbv[q]; a[4 * q] = v[0]; a[4 * q + 1] = v[1]; a[4 * q + 2] = v[2]; a[4 * q + 3] = v[3]; }
#pragma unroll
        for (int w = 0; w < 4; ++w) { const int tt = t0 + t - 3 + w; const float msk = tt >= 0 ? 1.f : 0.f;
#pragma unroll
            for (int hh = 0; hh < 2; ++hh) { const u32x4 xv = xw[w][hh]; const f32x4 w0 = cwv[w][2 * hh] * msk, w1 = cwv[w][2 * hh + 1] * msk;
                a[8 * hh + 0] += w0[0] * bf_lo(xv.x); a[8 * hh + 1] += w0[1] * bf_hi(xv.x); a[8 * hh + 2] += w0[2] * bf_lo(xv.y); a[8 * hh + 3] += w0[3] * bf_hi(xv.y);
                a[8 * hh + 4] += w1[0] * bf_lo(xv.z); a[8 * hh + 5] += w1[1] * bf_hi(xv.z); a[8 * hh + 6] += w1[2] * bf_lo(xv.w); a[8 * hh + 7] += w1[3] * bf_hi(xv.w); } }
#pragma unroll
        for (int q = 0; q < 4; ++q) *(LAS f32x4*)(convf + t * 132 + cg8 * 16 + 4 * q) = (f32x4){a[4 * q], a[4 * q + 1], a[4 * q + 2], a[4 * q + 3]};
#pragma unroll
        for (int hh = 0; hh < 2; ++hh) { u32x4 o; o.x = pk2(a[8 * hh], a[8 * hh + 1]); o.y = pk2(a[8 * hh + 2], a[8 * hh + 3]); o.z = pk2(a[8 * hh + 4], a[8 * hh + 5]); o.w = pk2(a[8 * hh + 6], a[8 * hh + 7]);
            *(LAS u32x4*)(convb + t * 272 + cg8 * 32 + hh * 16) = o; }
    }
    __syncthreads();
    if (it + G < NIT) LRU_LOAD(it + G);
    f32x4 accr[4], acci[4];
    {
#pragma unroll
        for (int m = 0; m < 4; ++m) { accr[m] = (f32x4){0.f, 0.f, 0.f, 0.f}; acci[m] = (f32x4){0.f, 0.f, 0.f, 0.f};
#pragma unroll
            for (int ks = 0; ks < 4; ++ks) { const bf16x8 av = *(const LAS bf16x8*)(convb + (m * 16 + col) * 272 + (ks * 32 + quad * 8) * 2);
                accr[m] = __builtin_amdgcn_mfma_f32_16x16x32_bf16(av, br[ks], accr[m], 0, 0, 0);
                acci[m] = __builtin_amdgcn_mfma_f32_16x16x32_bf16(av, bi[ks], acci[m], 0, 0, 0); } }
    }
    {
        float Ac = 1.f, Hc = 0.f;
#pragma unroll
        for (int m = 0; m < 4; ++m) {
            float hl[4], Pl[4]; float h = 0.f, Pp = 1.f;
#pragma unroll
            for (int jj = 0; jj < 4; ++jj) { const int tok = m * 16 + quad * 4 + jj;
                const float r = sigm(accr[m][jj] + brv), ig = sigm(acci[m][jj] + biv);
                const float la = c8sp * r, av = __expf(la);
                const float bm = __builtin_amdgcn_sqrtf(fmaxf(1.f - __expf(2.f * la), 0.f));
                const float bb = bm * ig * convf[tok * 132 + d0 + col];
                h = av * h + bb; Pp *= av; hl[jj] = h; Pl[jj] = Pp; }
            const float A0 = __shfl(Pp, col), A1 = __shfl(Pp, col + 16), A2 = __shfl(Pp, col + 32), A3 = __shfl(Pp, col + 48);
            const float H0 = __shfl(h, col), H1 = __shfl(h, col + 16), H2 = __shfl(h, col + 32), H3 = __shfl(h, col + 48);
            float Ain = 1.f, Hin = 0.f;
            if (quad > 0) { Hin = H0; Ain = A0; }
            if (quad > 1) { Hin = A1 * Hin + H1; Ain *= A1; }
            if (quad > 2) { Hin = A2 * Hin + H2; Ain *= A2; }
            const float At = A0 * A1 * A2 * A3, Ht = ((H0 * A1 + H1) * A2 + H2) * A3 + H3;
            const float Hstart = Ain * Hc + Hin, Pstart = Ac * Ain;
#pragma unroll
            for (int jj = 0; jj < 4; ++jj) { const int tok = m * 16 + quad * 4 + jj;
                *(LAS unsigned short*)(hlS + tok * 272 + (d0 + col) * 2) = (unsigned short)(pk2(Pl[jj] * Hstart + hl[jj], 0.f) & 0xffffu);
                *(LAS unsigned short*)(caS + tok * 272 + (d0 + col) * 2) = (unsigned short)(pk2(Pstart * Pl[jj], 0.f) & 0xffffu); }
            Hc = At * Hc + Ht; Ac *= At;
        }
        if (quad == 0) { P.CHA()[(size_t)(b * 64 + c) * 1024 + ch] = Ac; P.CHH()[(size_t)(b * 64 + c) * 1024 + ch] = Hc; }
    }
    __syncthreads();
    {
        const int t = tid >> 3, cg8 = tid & 7; const size_t o = (size_t)(b * SEQ + t0 + t) * 1024 + ch0 + cg8 * 16;
#pragma unroll
        for (int hh = 0; hh < 2; ++hh) { *(u32x4*)(P.HL() + o + 8 * hh) = *(const LAS u32x4*)(hlS + t * 272 + cg8 * 32 + hh * 16); *(u32x4*)(P.CA() + o + 8 * hh) = *(const LAS u32x4*)(caS + t * 272 + cg8 * 32 + hh * 16); }
    }
    }
#undef LRU_LOAD
}

__device__ __forceinline__ void lru_fix_item(const Ptrs& P, int it) {
    const int tid = opq((P.wave << 6) | lane_id()), b = it >> 6, c = it & 63, tg = tid >> 7, c8 = tid & 127;
    f32x4 H0 = {0.f, 0.f, 0.f, 0.f}, H1 = {0.f, 0.f, 0.f, 0.f};
    int cc = 0;
#pragma unroll 1
    for (; cc + 8 <= c; cc += 8) {
        f32x4 a0[8], a1[8], h0[8], h1[8];
#pragma unroll
        for (int u = 0; u < 8; ++u) { const size_t o = (size_t)(b * 64 + cc + u) * 1024 + c8 * 8;
            a0[u] = *(const f32x4*)(P.CHA() + o); a1[u] = *(const f32x4*)(P.CHA() + o + 4); h0[u] = *(const f32x4*)(P.CHH() + o); h1[u] = *(const f32x4*)(P.CHH() + o + 4); }
#pragma unroll
        for (int u = 0; u < 8; ++u) { H0 = a0[u] * H0 + h0[u]; H1 = a1[u] * H1 + h1[u]; }
    }
    for (; cc < c; ++cc) { const size_t o = (size_t)(b * 64 + cc) * 1024 + c8 * 8;
        const f32x4 a0 = *(const f32x4*)(P.CHA() + o), a1 = *(const f32x4*)(P.CHA() + o + 4), h0 = *(const f32x4*)(P.CHH() + o), h1 = *(const f32x4*)(P.CHH() + o + 4);
        H0 = a0 * H0 + h0; H1 = a1 * H1 + h1; }
#pragma unroll 4
    for (int k = 0; k < 16; ++k) { const size_t row = (size_t)(b * SEQ + c * 64 + tg + 4 * k);
        const u32x4 hw = *(const u32x4*)(P.HL() + row * 1024 + c8 * 8), cw = *(const u32x4*)(P.CA() + row * 1024 + c8 * 8), gw = *(const u32x4*)(P.PA() + row * NA + C_GC + c8 * 8);
        u32x4 o;
        o.x = pk2((bf_lo(hw.x) + bf_lo(cw.x) * H0[0]) * bf_lo(gw.x), (bf_hi(hw.x) + bf_hi(cw.x) * H0[1]) * bf_hi(gw.x));
        o.y = pk2((bf_lo(hw.y) + bf_lo(cw.y) * H0[2]) * bf_lo(gw.y), (bf_hi(hw.y) + bf_hi(cw.y) * H0[3]) * bf_hi(gw.y));
        o.z = pk2((bf_lo(hw.z) + bf_lo(cw.z) * H1[0]) * bf_lo(gw.z), (bf_hi(hw.z) + bf_hi(cw.z) * H1[1]) * bf_hi(gw.z));
        o.w = pk2((bf_lo(hw.w) + bf_lo(cw.w) * H1[2]) * bf_lo(gw.w), (bf_hi(hw.w) + bf_hi(cw.w) * H1[3]) * bf_hi(gw.w));
        *(u32x4*)(P.YC() + row * 1024 + c8 * 8) = o; }
}

#define SOFTMAX_TILE(p0, p1, m, l, NO, o, pw) do { \
    float rm_ = fmaxf(p0[0], p1[0]); \
    _Pragma("unroll") for (int r = 1; r < 16; ++r) rm_ = fmaxf(rm_, fmaxf(p0[r], p1[r])); \
    rm_ = fmaxf(rm_, __shfl_xor(rm_, 32)); \
    if (__ballot(rm_ > m + 8.f) != 0ull) {        \
        const float mn_ = fmaxf(m, rm_); const float al_ = __builtin_amdgcn_exp2f(m - mn_); m = mn_; l *= al_; \
        _Pragma("unroll") for (int d_ = 0; d_ < NO; ++d_) o[d_] *= al_; } \
    float ps_ = 0.f; \
    _Pragma("unroll") for (int r = 0; r < 16; ++r) { p0[r] = __builtin_amdgcn_exp2f(p0[r] - m); p1[r] = __builtin_amdgcn_exp2f(p1[r] - m); ps_ += p0[r] + p1[r]; } \
    l += ps_; \
    pw[0] = (u32x4){pk2(p0[0], p0[1]), pk2(p0[2], p0[3]), pk2(p0[4], p0[5]), pk2(p0[6], p0[7])}; \
    pw[1] = (u32x4){pk2(p0[8], p0[9]), pk2(p0[10], p0[11]), pk2(p0[12], p0[13]), pk2(p0[14], p0[15])}; \
    pw[2] = (u32x4){pk2(p1[0], p1[1]), pk2(p1[2], p1[3]), pk2(p1[4], p1[5]), pk2(p1[6], p1[7])}; \
    pw[3] = (u32x4){pk2(p1[8], p1[9]), pk2(p1[10], p1[11]), pk2(p1[12], p1[13]), pk2(p1[14], p1[15])}; } while (0)

__device__ __forceinline__ void moba_load_q(bf16x8 (&qr)[8], const Ptrs& P, size_t qrow, int h, int hi) {
#pragma unroll
    for (int ks = 0; ks < 8; ++ks) qr[ks] = *(const bf16x8*)(P.PA() + qrow * NA + C_QA + h * 128 + ks * 16 + hi * 8);
}
__device__ __forceinline__ void moba_list_item(const Ptrs& P, int bh, int j) {
    const int tid = opq((P.wave << 6) | lane_id()), lane = tid & 63, wid = __builtin_amdgcn_readfirstlane(tid >> 6), r32 = lane & 31, hi = lane >> 5;
    const int b = bh >> 3, h = bh & 7, t = j * 256 + 32 * wid + r32;
    bf16x8 qr[8]; moba_load_q(qr, P, (size_t)(b * SEQ + t), h, hi);
    f32x16 ga = {};
#pragma unroll
    for (int ks = 0; ks < 8; ++ks) { const bf16x8 kf = *(const bf16x8*)(P.KM() + ((size_t)(bh * 16 + (r32 & 15))) * 128 + ks * 16 + hi * 8);
        ga = __builtin_amdgcn_mfma_f32_32x32x16_bf16(kf, qr[ks], ga, 0, 0, 0); }
    float g[16];
#pragma unroll
    for (int e = 0; e < 8; ++e) { const float mine = ga[e], oth = __shfl_xor(mine, 32);
        const float lo = hi ? oth : mine, hh = hi ? mine : oth;
        g[(e & 3) + 8 * (e >> 2)] = lo; g[4 + (e & 3) + 8 * (e >> 2)] = hh; }
    const float NI = -3.0e38f;
    unsigned sel = 0u;
#pragma unroll
    for (int pass = 0; pass < 3; ++pass) { float best = NI; int bi = -1;
#pragma unroll
        for (int n = 0; n < 16; ++n) { const bool ok = (n < j) && (((sel >> n) & 1u) == 0u) && (g[n] > best); best = ok ? g[n] : best; bi = ok ? n : bi; }
        if (bi >= 0) sel |= 1u << bi; }
    for (int n = 0; n < j; ++n) {
        const bool sb = (((sel >> n) & 1u) != 0u) && (hi == 0);
        const unsigned long long mk = __ballot(sb);
        if (mk != 0ull) {
            unsigned base = 0u;
            if (lane == 0) base = atomicAdd(P.SELCNT() + bh * 16 + n, (unsigned)__popcll(mk));
            base = (unsigned)__builtin_amdgcn_readfirstlane((int)base);
            if (sb) { const unsigned pos = base + (unsigned)__popcll(mk & ((1ull << lane) - 1ull)); const unsigned k = (unsigned)__popc(sel & ((1u << n) - 1u));
                if (pos < 4096u) P.LIST()[(size_t)(bh * 16 + n) * 4096 + pos] = (unsigned)t | (k << 12); }
        }
    }
}
__device__ __forceinline__ void moba_kv_item(LAS unsigned char* lds, const Ptrs& P, int bh, int n, int part, bool split) {
    const int tid = opq((P.wave << 6) | lane_id()), lane = tid & 63, wid = __builtin_amdgcn_readfirstlane(tid >> 6), r32 = lane & 31, hi = lane >> 5;
    const int b = bh >> 3, h = bh & 7;
    const float SC = 0.08838834764831845f * LOG2E;
    LAS unsigned char* kb = lds; LAS unsigned char* vb = lds + 69632; LAS float* lut = (LAS float*)(lds + 136192);
    if (tid < 129) lut[tid] = P.rpe[t5_bucket(tid) * 24 + h] * LOG2E;
    const float cbias = P.rpe[31 * 24 + h] * LOG2E;
    {   const int kr = tid >> 4, kc8 = tid & 15, vd = tid >> 5, vk8 = tid & 31;
        u32x4 rg[8], rv[8];
#pragma unroll
        for (int i = 0; i < 8; ++i) rg[i] = *(const u32x4*)(P.PA() + (size_t)(b * SEQ + n * 256 + kr + 32 * i) * NA + C_KA + h * 128 + kc8 * 8);
#pragma unroll
        for (int i = 0; i < 8; ++i) rv[i] = *(const u32x4*)(P.VTA() + ((size_t)(bh * 128 + vd + 16 * i)) * SEQ + n * 256 + vk8 * 8);
#pragma unroll
        for (int i = 0; i < 8; ++i) *(LAS u32x4*)(kb + (kr + 32 * i) * 272 + kc8 * 16) = rg[i];
#pragma unroll
        for (int i = 0; i < 8; ++i) { *(LAS u32x2*)(vb + (vd + 16 * i) * 520 + vk8 * 16) = (u32x2){rv[i].x, rv[i].y}; *(LAS u32x2*)(vb + (vd + 16 * i) * 520 + vk8 * 16 + 8) = (u32x2){rv[i].z, rv[i].w}; }
    }
    int cnt = (int)P.SELCNT()[bh * 16 + n]; cnt = cnt < 4096 ? cnt : 4096; cnt = __builtin_amdgcn_readfirstlane(cnt);
    int beg = 0, end = cnt;
    if (split) { int half = ((cnt >> 1) + 31) & ~31; half = half < cnt ? half : cnt; if (part == 0) end = half; else beg = half; }
    __syncthreads();
    const int ntile = (end - beg + 31) >> 5;
    const unsigned* list = P.LIST() + (size_t)(bh * 16 + n) * 4096;
    bf16x8 qn[8]; unsigned en = 0u; bool vn = false;
    if (wid < ntile) { const int idx = beg + wid * 32 + r32; vn = idx < end; en = list[vn ? idx : beg]; moba_load_q(qn, P, (size_t)(b * SEQ + (int)(en & 4095u)), h, hi); }
#pragma unroll 1
    for (int qt = wid; qt < ntile; qt += 8) {
        const bool valid = vn; const unsigned e = en;
        const int t = (int)(e & 4095u), k = (int)(e >> 12);
        bf16x8 qr[8];
#pragma unroll
        for (int ks = 0; ks < 8; ++ks) qr[ks] = qn[ks];
        if (qt + 8 < ntile) { const int idx = beg + (qt + 8) * 32 + r32; vn = idx < end; en = list[vn ? idx : beg]; moba_load_q(qn, P, (size_t)(b * SEQ + (int)(en & 4095u)), h, hi); }
        float m = NEGF, l = 0.f; f32x16 o[4]; o[0] = f32x16{}; o[1] = f32x16{}; o[2] = f32x16{}; o[3] = f32x16{};
        const bool allfar = (__ballot(t < n * 256 + 383) == 0ull);
#pragma unroll 1
        for (int kvt = 0; kvt < 4; ++kvt) {
            f32x16 p0 = {}, p1 = {};
#pragma unroll
            for (int ks = 0; ks < 8; ++ks) { const bf16x8 k0 = *(const LAS bf16x8*)(kb + (kvt * 64 + r32) * 272 + ks * 32 + hi * 16), k1 = *(const LAS bf16x8*)(kb + (kvt * 64 + 32 + r32) * 272 + ks * 32 + hi * 16);
                p0 = __builtin_amdgcn_mfma_f32_32x32x16_bf16(k0, qr[ks], p0, 0, 0, 0); p1 = __builtin_amdgcn_mfma_f32_32x32x16_bf16(k1, qr[ks], p1, 0, 0, 0); }
            if (allfar) {
#pragma unroll
                for (int r = 0; r < 16; ++r) { p0[r] = p0[r] * SC + cbias; p1[r] = p1[r] * SC + cbias; }
            } else {
                const int dbase = t - n * 256 - 64 * kvt;
#pragma unroll
                for (int g4 = 0; g4 < 4; ++g4) {
#pragma unroll
                    for (int e4 = 0; e4 < 4; ++e4) { const int r = 4 * g4 + e4; const int d0 = dbase - crow(r, hi), d1 = d0 - 32;
                        p0[r] = p0[r] * SC + lut[min(max(d0, 0), 128)]; p1[r] = p1[r] * SC + lut[min(max(d1, 0), 128)]; }
                    __builtin_amdgcn_sched_barrier(0);
                }
            }
            u32x4 pw[4];
            SOFTMAX_TILE(p0, p1, m, l, 4, o, pw);
#pragma unroll
            for (int sl = 0; sl < 4; ++sl)
#pragma unroll
                for (int dt = 0; dt < 4; ++dt) { const LAS unsigned char* vp = vb + (dt * 32 + r32) * 520 + (kvt * 64 + 16 * sl + 4 * hi) * 2;
                    const u32x2 lo = *(const LAS u32x2*)vp, hh = *(const LAS u32x2*)(vp + 16);
                    const u32x4 vf = {lo.x, lo.y, hh.x, hh.y};
                    o[dt] = __builtin_amdgcn_mfma_f32_32x32x16_bf16(__builtin_bit_cast(bf16x8, vf), __builtin_bit_cast(bf16x8, pw[sl]), o[dt], 0, 0, 0); }
        }
        const float lt = l + __shfl_xor(l, 32); const float inv = __builtin_amdgcn_rcpf(lt);
        if (valid) {
            const size_t slot = ((size_t)bh * SEQ + t) * 3 + k;
            if (hi == 0) *(f32x2*)(P.ML() + slot * 2) = (f32x2){m, lt};
            bf16_t* po = P.PO() + slot * 128;
#pragma unroll
            for (int dt = 0; dt < 4; ++dt)
#pragma unroll
                for (int g4 = 0; g4 < 4; ++g4) { const int d = 32 * dt + 8 * g4 + 4 * hi;
                    *(u32x2*)(po + d) = (u32x2){pk2(o[dt][4 * g4] * inv, o[dt][4 * g4 + 1] * inv), pk2(o[dt][4 * g4 + 2] * inv, o[dt][4 * g4 + 3] * inv)}; }
        }
    }
    __syncthreads();
}
__device__ __forceinline__ void moba_own_item(LAS unsigned char* lds, const Ptrs& P, int b, int h, int j) {
    const int tid = opq((P.wave << 6) | lane_id()), lane = tid & 63, wid = __builtin_amdgcn_readfirstlane(tid >> 6), r32 = lane & 31, hi = lane >> 5;
    const float SC = 0.08838834764831845f * LOG2E;
    LAS unsigned char* kb = lds; LAS unsigned char* vb = lds + 69632; LAS float* lut = (LAS float*)(lds + 136192);
    if (tid < 129) lut[tid] = P.rpe[t5_bucket(tid) * 24 + h] * LOG2E;
    const int bh = b * 8 + h;
    const int q_local = 32 * wid + r32, t = j * 256 + q_local; const size_t qrow = (size_t)(b * SEQ + t);
    bf16x8 qr[8]; moba_load_q(qr, P, qrow, h, hi);
    {   const int kr = tid >> 4, kc8 = tid & 15, vd = tid >> 5, vk8 = tid & 31;
        u32x4 rg[8], rv[8];
#pragma unroll
        for (int i = 0; i < 8; ++i) rg[i] = *(const u32x4*)(P.PA() + (size_t)(b * SEQ + j * 256 + kr + 32 * i) * NA + C_KA + h * 128 + kc8 * 8);
#pragma unroll
        for (int i = 0; i < 8; ++i) rv[i] = *(const u32x4*)(P.VTA() + ((size_t)(bh * 128 + vd + 16 * i)) * SEQ + j * 256 + vk8 * 8);
#pragma unroll
        for (int i = 0; i < 8; ++i) *(LAS u32x4*)(kb + (kr + 32 * i) * 272 + kc8 * 16) = rg[i];
#pragma unroll
        for (int i = 0; i < 8; ++i) { *(LAS u32x2*)(vb + (vd + 16 * i) * 520 + vk8 * 16) = (u32x2){rv[i].x, rv[i].y}; *(LAS u32x2*)(vb + (vd + 16 * i) * 520 + vk8 * 16 + 8) = (u32x2){rv[i].z, rv[i].w}; }
    }
    const int nsel = j < 3 ? j : 3;
    const size_t slot0 = ((size_t)bh * SEQ + t) * 3;
    float mk[3], lk[3];
#pragma unroll
    for (int k = 0; k < 3; ++k) { mk[k] = NEGF; lk[k] = 0.f;
        if (k < nsel) { const f32x2 v = *(const f32x2*)(P.ML() + (slot0 + k) * 2); mk[k] = v[0]; lk[k] = v[1]; } }
    __syncthreads();
    float m = NEGF, l = 0.f; f32x16 o[4]; o[0] = f32x16{}; o[1] = f32x16{}; o[2] = f32x16{}; o[3] = f32x16{};
    const int ntt = ((32 * wid + 31) >> 6) + 1;
#pragma unroll 1
    for (int tt = 0; tt < ntt; ++tt) {
        f32x16 p0 = {}, p1 = {};
#pragma unroll
        for (int ks = 0; ks < 8; ++ks) { const bf16x8 k0 = *(const LAS bf16x8*)(kb + (tt * 64 + r32) * 272 + ks * 32 + hi * 16), k1 = *(const LAS bf16x8*)(kb + (tt * 64 + 32 + r32) * 272 + ks * 32 + hi * 16);
            p0 = __builtin_amdgcn_mfma_f32_32x32x16_bf16(k0, qr[ks], p0, 0, 0, 0); p1 = __builtin_amdgcn_mfma_f32_32x32x16_bf16(k1, qr[ks], p1, 0, 0, 0); }
        const int dbase = q_local - 64 * tt;
#pragma unroll
        for (int g4 = 0; g4 < 4; ++g4) {
#pragma unroll
            for (int e4 = 0; e4 < 4; ++e4) { const int r = 4 * g4 + e4; const int d0 = dbase - crow(r, hi), d1 = d0 - 32;
                const float b0 = lut[min(max(d0, 0), 128)], b1 = lut[min(max(d1, 0), 128)];
                p0[r] = (d0 >= 0) ? p0[r] * SC + b0 : NEGF; p1[r] = (d1 >= 0) ? p1[r] * SC + b1 : NEGF; }
            __builtin_amdgcn_sched_barrier(0);
        }
        u32x4 pw[4];
        SOFTMAX_TILE(p0, p1, m, l, 4, o, pw);
#pragma unroll
        for (int sl = 0; sl < 4; ++sl)
#pragma unroll
            for (int dt = 0; dt < 4; ++dt) { const LAS unsigned char* vp = vb + (dt * 32 + r32) * 520 + (tt * 64 + 16 * sl + 4 * hi) * 2;
                const u32x2 lo = *(const LAS u32x2*)vp, hh = *(const LAS u32x2*)(vp + 16);
                const u32x4 vf = {lo.x, lo.y, hh.x, hh.y};
                o[dt] = __builtin_amdgcn_mfma_f32_32x32x16_bf16(__builtin_bit_cast(bf16x8, vf), __builtin_bit_cast(bf16x8, pw[sl]), o[dt], 0, 0, 0); }
    }
    float lown = l + __shfl_xor(l, 32);
    float Mx = m;
#pragma unroll
    for (int k = 0; k < 3; ++k) if (k < nsel) Mx = fmaxf(Mx, mk[k]);
    const float wo = __builtin_amdgcn_exp2f(m - Mx); float L = lown * wo;
#pragma unroll
    for (int dt = 0; dt < 4; ++dt) o[dt] *= wo;
#pragma unroll
    for (int k = 0; k < 3; ++k) if (k < nsel) { const float wk = lk[k] * __builtin_amdgcn_exp2f(mk[k] - Mx); L += wk;
        const bf16_t* po = P.PO() + (slot0 + k) * 128;
#pragma unroll
        for (int dt = 0; dt < 4; ++dt)
#pragma unroll
            for (int g4 = 0; g4 < 4; ++g4) { const u32x2 w = *(const u32x2*)(po + 32 * dt + 8 * g4 + 4 * hi);
                o[dt][4 * g4] += wk * bf_lo(w.x); o[dt][4 * g4 + 1] += wk * bf_hi(w.x); o[dt][4 * g4 + 2] += wk * bf_lo(w.y); o[dt][4 * g4 + 3] += wk * bf_hi(w.y); } }
    const float inv = __builtin_amdgcn_rcpf(L);
#pragma unroll
    for (int dt = 0; dt < 4; ++dt)
#pragma unroll
        for (int g4 = 0; g4 < 4; ++g4) { const int d = 32 * dt + 8 * g4 + 4 * hi;
            const u32x2 gw = *(const u32x2*)(P.PA() + qrow * NA + C_GA + h * 128 + d);
            const float i64 = inv * 16.f; int w8 = 0;
            w8 = __builtin_amdgcn_cvt_pk_fp8_f32(o[dt][4 * g4] * i64 * bf_lo(gw.x), o[dt][4 * g4 + 1] * i64 * bf_hi(gw.x), w8, false); w8 = __builtin_amdgcn_cvt_pk_fp8_f32(o[dt][4 * g4 + 2] * i64 * bf_lo(gw.y), o[dt][4 * g4 + 3] * i64 * bf_hi(gw.y), w8, true);
            *(unsigned*)(P.Y8() + qrow * 2048 + h * 128 + d) = (unsigned)w8; }
    __syncthreads();
}
__device__ const unsigned char MOBA_SCHED[8][3] = {{0 + 32, 9, 255}, {0 + 16 + 32, 10, 13}, {4, 11, 12}, {1 + 32, 8, 14}, {1 + 16 + 32, 7, 255}, {5, 3 + 32, 255}, {2 + 32, 6, 255}, {2 + 16 + 32, 3 + 16 + 32, 255}};

__device__ __forceinline__ void swa_item(LAS unsigned char* lds, const Ptrs& P, int l, int b, int hk, int qblk) {
    const int tid = opq((P.wave << 6) | lane_id()), lane = tid & 63, wid = __builtin_amdgcn_readfirstlane(tid >> 6), r32 = lane & 31, hi = lane >> 5;
    const float SC = 0.125f * LOG2E;
    LAS unsigned char* kb = lds; LAS unsigned char* vb = lds + 36864; LAS float* lut = (LAS float*)(lds + 70144);
    const int kvbase = qblk * 128 - 128;
#pragma unroll
    for (int i = 0; i < 4; ++i) { const int r = (tid >> 3) + 64 * i, c8 = tid & 7, kv = kvbase + r;
        u32x4 w = {0u, 0u, 0u, 0u};
        if (kv >= 0) w = *(const u32x4*)(P.PA() + (size_t)(b * SEQ + kv) * NA + C_KB + hk * 64 + c8 * 8);
        *(LAS u32x4*)(kb + r * 144 + c8 * 16) = w; }
#pragma unroll
    for (int i = 0; i < 4; ++i) { const int d = (tid >> 5) + 16 * i, k8 = tid & 31, kv = kvbase + k8 * 8;
        u32x4 w = {0u, 0u, 0u, 0u};
        if (kv >= 0) w = *(const u32x4*)(P.VTB() + ((size_t)((b * 4 + hk) * 64 + d)) * SEQ + kv);
        *(LAS u32x2*)(vb + d * 520 + k8 * 16) = (u32x2){w.x, w.y}; *(LAS u32x2*)(vb + d * 520 + k8 * 16 + 8) = (u32x2){w.z, w.w}; }
    { const int g = tid >> 7, dist = tid & 127; lut[tid] = P.rpe[t5_bucket(dist) * 24 + 8 + hk * 4 + g] * LOG2E; }
    const int g = wid >> 1, hq = hk * 4 + g;
    const float sink2 = P.sinks[l * 16 + hq] * LOG2E;
    bf16x8 qrs[2][4];
#pragma unroll
    for (int qs = 0; qs < 2; ++qs)
#pragma unroll
        for (int ks = 0; ks < 4; ++ks) qrs[qs][ks] = *(const bf16x8*)(P.PA() + (size_t)(b * SEQ + qblk * 128 + 32 * (2 * (wid & 1) + qs) + r32) * NA + C_QB + hq * 64 + ks * 16 + hi * 8);
    __syncthreads();
#pragma unroll
    for (int qs = 0; qs < 2; ++qs) {
        const int qq = 2 * (wid & 1) + qs, q_local = 32 * qq + r32; const size_t qrow = (size_t)(b * SEQ + qblk * 128 + q_local);
        bf16x8 qr[4];
#pragma unroll
        for (int ks = 0; ks < 4; ++ks) qr[ks] = qrs[qs][ks];
        float m = NEGF, lsum = 0.f; f32x16 o[2]; o[0] = f32x16{}; o[1] = f32x16{};
        const int tk_hi = (32 * qq + 159) >> 6, tk_lo = (32 * qq + 1) >> 6;
#pragma unroll 1
        for (int tk = tk_hi; tk >= tk_lo; --tk) {
            f32x16 p0 = {}, p1 = {};
#pragma unroll
            for (int ks = 0; ks < 4; ++ks) { const bf16x8 k0 = *(const LAS bf16x8*)(kb + (tk * 64 + r32) * 144 + ks * 32 + hi * 16), k1 = *(const LAS bf16x8*)(kb + (tk * 64 + 32 + r32) * 144 + ks * 32 + hi * 16);
                p0 = __builtin_amdgcn_mfma_f32_32x32x16_bf16(k0, qr[ks], p0, 0, 0, 0); p1 = __builtin_amdgcn_mfma_f32_32x32x16_bf16(k1, qr[ks], p1, 0, 0, 0); }
            const int dbase = 128 + q_local - tk * 64;
#pragma unroll
            for (int r = 0; r < 16; ++r) { const int d0 = dbase - crow(r, hi), d1 = d0 - 32;
                const int rb0 = tk * 64 + crow(r, hi), rb1 = rb0 + 32;
                const bool v0 = (d0 >= 0) && (d0 < 128) && (qblk > 0 || rb0 >= 128), v1 = (d1 >= 0) && (d1 < 128) && (qblk > 0 || rb1 >= 128);
                const float b0 = lut[g * 128 + (d0 & 127)], b1 = lut[g * 128 + (d1 & 127)];
                p0[r] = v0 ? p0[r] * SC + b0 : NEGF; p1[r] = v1 ? p1[r] * SC + b1 : NEGF; }
            u32x4 pw[4];
            SOFTMAX_TILE(p0, p1, m, lsum, 2, o, pw);
#pragma unroll
            for (int dt = 0; dt < 2; ++dt)
#pragma unroll
                for (int s = 0; s < 4; ++s) { const LAS unsigned char* vp = vb + (dt * 32 + r32) * 520 + (tk * 64 + 16 * s + 4 * hi) * 2;
                    const u32x2 lo = *(const LAS u32x2*)vp, hh = *(const LAS u32x2*)(vp + 16);
                    const u32x4 vf = {lo.x, lo.y, hh.x, hh.y};
                    o[dt] = __builtin_amdgcn_mfma_f32_32x32x16_bf16(__builtin_bit_cast(bf16x8, vf), __builtin_bit_cast(bf16x8, pw[s]), o[dt], 0, 0, 0); }
        }
        const float lt = lsum + __shfl_xor(lsum, 32) + __builtin_amdgcn_exp2f(sink2 - m); const float inv = __builtin_amdgcn_rcpf(lt);
#pragma unroll
        for (int dt = 0; dt < 2; ++dt)
#pragma unroll
            for (int g4 = 0; g4 < 4; ++g4) { const int d = 32 * dt + 8 * g4 + 4 * hi;
                const u32x2 gw = *(const u32x2*)(P.PA() + qrow * NA + C_GB + hq * 64 + d);
                const float i64 = inv * 16.f; int w8 = 0;
                w8 = __builtin_amdgcn_cvt_pk_fp8_f32(o[dt][4 * g4] * i64 * bf_lo(gw.x), o[dt][4 * g4 + 1] * i64 * bf_hi(gw.x), w8, false); w8 = __builtin_amdgcn_cvt_pk_fp8_f32(o[dt][4 * g4 + 2] * i64 * bf_lo(gw.y), o[dt][4 * g4 + 3] * i64 * bf_hi(gw.y), w8, true);
                *(unsigned*)(P.Y8() + qrow * 2048 + 1024 + hq * 64 + d) = (unsigned)w8; }
    }
    __syncthreads();
}

#define XB_TMO      128
#define XB_XCNT(j)  (256  + 64 * (j))
#define XB_XSUB(j)  (1280 + 64 * (j))
#define XB_XGEN(j)  (2304 + 64 * (j))
#define XB_TOP      3328
#define XB_TOPGEN   3392
#define XCD_BAR_WORDS 3456
#define XB_SPIN_CAP (1u << 18)

__device__ __forceinline__ unsigned xb_ld(unsigned* p)              { return __hip_atomic_load(p, __ATOMIC_RELAXED, __HIP_MEMORY_SCOPE_AGENT); }
__device__ __forceinline__ unsigned xb_add(unsigned* p, unsigned v) { return __hip_atomic_fetch_add(p, v, __ATOMIC_RELAXED, __HIP_MEMORY_SCOPE_AGENT); }
__device__ __forceinline__ unsigned xb_xcc_id() { return (unsigned)__builtin_amdgcn_s_getreg((3 << 11) | 20) & 0xFu; }
#define XB_SPIN(cond, bar) do { unsigned _sp = 0; while (cond) { __builtin_amdgcn_s_sleep(1); \
    if ((++_sp & 255u) == 0u) { if (xb_ld(&(bar)[XB_TMO])) break; if (_sp > XB_SPIN_CAP) { atomicAdd(&(bar)[XB_TMO], 1u); break; } } } } while (0)

struct XcdBarrier {
    unsigned* bar; unsigned x; int wave;
    volatile LAS unsigned* st;
};

__device__ __forceinline__ XcdBarrier xcd_barrier_post(unsigned* bar, volatile LAS unsigned* st, int wave) {
    XcdBarrier b; b.bar = bar; b.x = xb_xcc_id(); b.st = st; b.wave = wave;
    if (wave == 0 && lane_id() == 0) (void)xb_add(&bar[XB_XCNT(b.x)], 1u);
    return b;
}
__device__ __forceinline__ void xcd_barrier_complete(unsigned* bar, unsigned x, unsigned& nloc, unsigned& nx) {
    const unsigned G = gridDim.x * gridDim.y * gridDim.z;
    unsigned sum, cnt, mine, sp = 0u;
    for (;;) {
        sum = 0u; cnt = 0u; mine = 0u;
#pragma unroll
        for (unsigned j = 0; j < 16; ++j) { const unsigned c = xb_ld(&bar[XB_XCNT(j)]); sum += c; cnt += (c > 0u) ? 1u : 0u; mine = (j == x) ? c : mine; }
        if (sum == G) break;
        __builtin_amdgcn_s_sleep(1);
        if ((++sp & 255u) == 0u) { if (xb_ld(&bar[XB_TMO])) break; if (sp > XB_SPIN_CAP) { atomicAdd(&bar[XB_TMO], 1u); break; } }
    }
    nloc = mine > 0u ? mine : 1u; nx = cnt > 0u ? cnt : 1u;
}

__device__ __forceinline__ void xcd_barrier(const XcdBarrier& b) {
    asm volatile("s_waitcnt vmcnt(0)" ::: "memory");
    __syncthreads();
    if (b.wave == 0 && lane_id() == 0) {
        unsigned* bar = launder_s(b.bar);
        __builtin_amdgcn_s_waitcnt(0);
        unsigned nloc = b.st[0], nx = b.st[1];
        if (nloc == 0u) { xcd_barrier_complete(bar, b.x, nloc, nx); b.st[0] = nloc; b.st[1] = nx; }
        const unsigned old = xb_add(&bar[XB_XSUB(b.x)], 1u);
        const unsigned gen = old / nloc;
        if (old + 1u == (gen + 1u) * nloc) {
            __builtin_amdgcn_fence(__ATOMIC_RELEASE, "agent");
            asm volatile("s_waitcnt vmcnt(0)" ::: "memory");
            const unsigned og = xb_add(&bar[XB_TOP], 1u);
            const unsigned tg = og / nx;
            if (og + 1u == (tg + 1u) * nx) xb_add(&bar[XB_TOPGEN], 1u);
            else XB_SPIN(xb_ld(&bar[XB_TOPGEN]) == tg, bar);
            __builtin_amdgcn_fence(__ATOMIC_ACQUIRE, "agent");
            xb_add(&bar[XB_XGEN(b.x)], 1u);
            asm volatile("s_waitcnt vmcnt(0)" ::: "memory");
        } else {
            XB_SPIN(xb_ld(&bar[XB_XGEN(b.x)]) == gen, bar);
            __builtin_amdgcn_fence(__ATOMIC_ACQUIRE, "agent");
            asm volatile("s_waitcnt vmcnt(0)" ::: "memory");
        }
    }
    __syncthreads();
}

template <int l> __device__ __forceinline__ void layer_phases(LAS unsigned char* lds, Ptrs& P, const XcdBarrier& xbar, KArgs kargs, const int lo, const int hi, const int lane0, const int wave, const int G0, const int bx0) {
#define PHASE_BEGIN() P.reload(launder_s(kargs)); const int G = sopq(G0), bx = sopq(bx0); const int lane = opq(lane_id()); const int gw = bx * 8 + wave, NGW = G * 8; (void)gw; (void)NGW; (void)lane
#define IN(k) (lo <= (k) && (k) < hi)
#define SEAM(k) do { if (IN(k) && IN((k) + 1)) xcd_barrier(xbar); } while (0)
        constexpr int pb = 1 + 8 * l;
        if (IN(pb)) {
            PHASE_BEGIN();
#ifndef NO_P1
            { pg8::Gemm g{(const bf16_t*)P.XB8(), (const bf16_t*)(P.WIN8() + (size_t)l * N8 * DM), DM / 2, DM / 2, DM / 2, 0, 0, P.wave}; pg8::StaticOrder S; S.init(M, N8, G, bx, 4, true);
              pg8::EpiIn E{P.PA(), P.GT(), P.SSQ() + (size_t)(2 * l) * M, 1, 1.f / 512.f};
              pg8::gemm_phase<pg8::EpiIn, pg8::StaticOrder, true, true>(lds, g, S, E); }
            { pg8::Gemm g{P.XB(), P.WINB() + (size_t)l * NB16 * DM, DM, DM, DM, 0, 0, P.wave}; pg8::StaticOrder S; S.init(M, NB16, G, bx, WGM_BF);
              pg8::EpiIn E{P.PA(), P.GT(), P.SSQ() + (size_t)(2 * l) * M, 2, 1.f};
              pg8::gemm_phase<pg8::EpiIn, pg8::StaticOrder, true, false>(lds, g, S, E); }
#endif
        }
        SEAM(pb);
        if (IN(pb + 1)) {
            PHASE_BEGIN();
#ifndef NO_P2A
#ifndef REP_P2A
#define REP_P2A 1
#endif
            for (int rep = 0; rep < REP_P2A; ++rep) {
            if (bx == 0) P.SELCNT()[(P.wave << 6) | lane_id()] = 0u;
#ifndef REP_KM
#define REP_KM 1
#endif
#ifndef REP_VT
#define REP_VT 1
#endif
#ifndef REP_LRU
#define REP_LRU 1
#endif
            for (int r2 = 0; r2 < REP_KM; ++r2)
            for (int it = bx; it < BATCH * 8 * 16; it += G) kmean_item(lds, P, it);
            for (int r2 = 0; r2 < REP_VT; ++r2)
            for (int it = gw; it < 5120; it += NGW) vtrans_item(lds + wave * 9216, P, it, lane);
            __syncthreads();
            for (int r2 = 0; r2 < REP_LRU; ++r2)
            lru_local_phase(lds, P, l, bx, G);
            __syncthreads(); }
#endif
        }
        SEAM(pb + 1);
        if (IN(pb + 2)) {
            PHASE_BEGIN();
            for (int it = bx; it < 512; it += G) { const int j = it & 15; if (j > 0) moba_list_item(P, it >> 4, j); }
            for (int it = bx; it < 256; it += G) lru_fix_item(P, it);
            for (int it = bx; it < 512; it += G) swa_item(lds, P, l, it >> 7, (it >> 5) & 3, it & 31);
        }
        SEAM(pb + 2);
        if (IN(pb + 3)) {
            PHASE_BEGIN();
#ifndef REP_KV
#define REP_KV 1
#endif
            for (int rep = 0; rep < REP_KV; ++rep)
            for (int it = bx; it < 256; it += G) { const int bh = it >> 3, sb = it & 7;
#pragma unroll 1
                for (int q = 0; q < 3; ++q) { const int code = MOBA_SCHED[sb][q]; if (code != 255) moba_kv_item(lds, P, bh, code & 15, (code >> 4) & 1, (code & 32) != 0); } }
        }
        SEAM(pb + 3);
        if (IN(pb + 4)) {
            PHASE_BEGIN();
#ifndef REP_OWN
#define REP_OWN 1
#endif
            for (int rep = 0; rep < REP_OWN; ++rep)
            for (int it = bx; it < 256; it += G) { const int bh = it >> 3, sb = it & 7;
                moba_own_item(lds, P, bh >> 3, bh & 7, 15 - sb);
                moba_own_item(lds, P, bh >> 3, bh & 7, sb); }
        }
        SEAM(pb + 4);
        if (IN(pb + 5)) {
            PHASE_BEGIN();
#ifndef NO_P3
            { pg8::Gemm g{(const bf16_t*)P.Y8(), (const bf16_t*)(P.WBR8() + (size_t)l * 2 * DM * 1024), 1024, 512, 512, (size_t)1024, (size_t)DM * 1024, P.wave}; pg8::ZOrder2 S; S.S.init(M, DM, G, bx);
              pg8::EpiMerge E{P.GT(), P.MG(), 1.f / 512.f};
              pg8::gemm_phase<pg8::EpiMerge, pg8::ZOrder2, true, true>(lds, g, S, E); }
            { pg8::Gemm g{P.YC(), P.WBR() + (size_t)(l * 3 + 2) * DM * 1024, 1024, 1024, 1024, 0, 0, P.wave}; pg8::ZFixed S; S.S.init(M, DM, G, bx); S.z = 2;
              pg8::EpiMerge E{P.GT(), P.MG(), 1.f};
              pg8::gemm_phase<pg8::EpiMerge, pg8::ZFixed, true, false>(lds, g, S, E); }
#endif
        }
        SEAM(pb + 5);
        if (IN(pb + 6)) {
            PHASE_BEGIN();
            { pg8::Gemm g{P.MG(), P.WOUT() + (size_t)l * DM * DM, DM, DM, DM, 0, 0, P.wave}; pg8::StaticOrder S; S.init(M, DM, G, bx, WGM_BF);
              pg8::EpiOut E{l == 0 ? P.x : P.out, P.X1(), P.XB1(), P.SSQ() + (size_t)(1 + 2 * l) * M};
#ifndef NO_P4
              pg8::gemm_phase<pg8::EpiOut, pg8::StaticOrder, true>(lds, g, S, E);
#endif
            }
            { pg8::Gemm g{P.PB() + (size_t)l * M * PLE, P.WPP() + (size_t)l * DM * PLE, PLE, PLE, PLE, 0, 0, P.wave}; pg8::StaticOrder S; S.init(M, DM, G, bx, WGM_BF);
              pg8::EpiPlain E{P.T(), DM};
#ifndef NO_P4T
              pg8::gemm_phase<pg8::EpiPlain, pg8::StaticOrder, true>(lds, g, S, E);
#endif
            }
        }
        SEAM(pb + 6);
        if (IN(pb + 7)) {
            PHASE_BEGIN();
            pg8::Gemm g{P.XB1(), P.WPG() + (size_t)l * DM * DM, DM, DM, DM, 0, 0, P.wave}; pg8::StaticOrder S; S.init(M, DM, G, bx, WGM_BF);
            pg8::EpiPle E{P.X1(), P.T(), P.SSQ() + (size_t)(1 + 2 * l) * M, P.out, P.XB(), P.XB8(), P.SSQ() + (size_t)(2 + 2 * l) * M, l + 1 < DEPTH};
#ifndef NO_P5
            pg8::gemm_phase<pg8::EpiPle, pg8::StaticOrder, true>(lds, g, S, E);
#endif
        }
        SEAM(pb + 7);

#undef IN
#undef SEAM
#undef PHASE_BEGIN
}

constexpr int NPH = 18;

__global__ void __launch_bounds__(NTHR, 2) fwd_kernel(Args args) {
    extern __shared__ __attribute__((aligned(16))) unsigned char lds_raw[];
    LAS unsigned char* lds = (LAS unsigned char*)lds_raw;
    cg::grid_group grid = cg::this_grid();
    const int tid = threadIdx.x, lane0 = tid & 63, wave = __builtin_amdgcn_readfirstlane(tid >> 6);
    const int G0 = gridDim.x, bx0 = blockIdx.x;
#define PHASE_BEGIN() P.reload(launder_s(kargs)); const int G = sopq(G0), bx = sopq(bx0); const int lane = opq(lane_id()); const int gw = bx * 8 + wave, NGW = G * 8; (void)gw; (void)NGW; (void)lane
    unsigned char* ws = args.ws;
    Ptrs P;
    KArgs kargs = (KArgs)__builtin_amdgcn_kernarg_segment_ptr();
    P.wave = wave;
    const int lo = args.ph_lo, hi = args.ph_hi;
    volatile LAS unsigned* bst = (volatile LAS unsigned*)(lds + LDS_BYTES - 64);
    if (tid < 2) bst[tid] = 0u;
    __syncthreads();
    const XcdBarrier xbar = xcd_barrier_post((unsigned*)(ws + OFF_BAR), bst, wave);
    if (hi > 1000) grid.sync();
#define IN(k) (lo <= (k) && (k) < hi)
#define SEAM(k) do { if (IN(k) && IN((k) + 1)) xcd_barrier(xbar); } while (0)

#ifndef REP_P0
#define REP_P0 1
#endif
    if (IN(0)) for (int rep0 = 0; rep0 < REP_P0; ++rep0) {
        PHASE_BEGIN();
        LAS float* scr = (LAS float*)(lds + wave * 16640);
        for (int l = 0; l < DEPTH; ++l) {
            { const float* wl = P.w_in + (size_t)l * DM * NIN; const float* ng = P.norm_g + l * DM;
              unsigned char* w8 = P.WIN8() + (size_t)l * N8 * DM; bf16_t* wb = P.WINB() + (size_t)l * NB16 * DM;
              transpose_matrix<true>(wl + 2048, DM, 4608, NIN, w8, ng, 64.f, scr, gw, NGW, lane);
              transpose_matrix<true>(wl + 8704, DM, 6144, NIN, w8 + (size_t)4608 * DM, ng, 64.f, scr, gw, NGW, lane);
              transpose_matrix(wl, DM, 2048, NIN, wb, ng, 1.f, scr, gw, NGW, lane);
              transpose_matrix(wl + 6656, DM, 2048, NIN, wb + (size_t)2048 * DM, ng, 1.f, scr, gw, NGW, lane); }
            for (int z = 0; z < 2; ++z) transpose_matrix<true>(P.w_br + (size_t)(l * 3 + z) * 1024 * DM, 1024, DM, DM, P.WBR8() + (size_t)(l * 2 + z) * DM * 1024, nullptr, 32.f, scr, gw, NGW, lane);
            transpose_matrix(P.w_br + (size_t)(l * 3 + 2) * 1024 * DM, 1024, DM, DM, P.WBR() + (size_t)(l * 3 + 2) * DM * 1024, nullptr, 1.f, scr, gw, NGW, lane);
            transpose_matrix(P.w_out + (size_t)l * DM * DM, DM, DM, DM, P.WOUT() + (size_t)l * DM * DM, nullptr, 1.f, scr, gw, NGW, lane);
            transpose_matrix(P.w_pg + (size_t)l * DM * DM, DM, DM, DM, P.WPG() + (size_t)l * DM * DM, P.ple_g + l * DM, 1.f, scr, gw, NGW, lane);
            transpose_matrix(P.w_pp + (size_t)l * PLE * DM, PLE, DM, DM, P.WPP() + (size_t)l * DM * PLE, nullptr, 1.f, scr, gw, NGW, lane);
            for (int n = 0; n < 8; ++n) {
                transpose_matrix(P.w_r + (size_t)(l * 8 + n) * 16384, 128, 128, 128, P.WR() + (size_t)(l * 8 + n) * 16384, nullptr, 1.f, scr, gw, NGW, lane);
                transpose_matrix(P.w_i + (size_t)(l * 8 + n) * 16384, 128, 128, 128, P.WI() + (size_t)(l * 8 + n) * 16384, nullptr, 1.f, scr, gw, NGW, lane);
            }
        }
        for (int mrow = gw; mrow < M; mrow += NGW) {
            const f32x4* xr = (const f32x4*)(P.x + (size_t)mrow * DM) + lane; u32x2* ob = (u32x2*)(P.XB() + (size_t)mrow * DM) + lane; unsigned* o8 = (unsigned*)(P.XB8() + (size_t)mrow * DM) + lane; float s = 0.f;
#pragma unroll
            for (int jv = 0; jv < 8; ++jv) { const f32x4 v = xr[64 * jv]; s += (v[0] * v[0] + v[1] * v[1]) + (v[2] * v[2] + v[3] * v[3]); ob[64 * jv] = (u32x2){pk2(v[0], v[1]), pk2(v[2], v[3])};
                int q = 0; q = __builtin_amdgcn_cvt_pk_fp8_f32(v[0] * 8.f, v[1] * 8.f, q, false); q = __builtin_amdgcn_cvt_pk_fp8_f32(v[2] * 8.f, v[3] * 8.f, q, true); o8[64 * jv] = (unsigned)q; }
            s = wave_sum(s);
            if (lane == 0) P.SSQ()[mrow] = s;
        }
        for (size_t i = (size_t)bx * NTHR + tid; i < (size_t)DEPTH * M * PLE / 8; i += (size_t)G * NTHR) {
            const f32x4 v0 = *(const f32x4*)(P.p + i * 8), v1 = *(const f32x4*)(P.p + i * 8 + 4);
            *(u32x4*)(P.PB() + i * 8) = (u32x4){pk2(v0[0], v0[1]), pk2(v0[2], v0[3]), pk2(v1[0], v1[1]), pk2(v1[2], v1[3])}; }
        for (int i = bx * NTHR + tid; i < 4 * M; i += G * NTHR) P.SSQ()[M + i] = 0.f;
    }
    SEAM(0);

    layer_phases<0>(lds, P, xbar, kargs, lo, hi, lane0, wave, G0, bx0);
    layer_phases<1>(lds, P, xbar, kargs, lo, hi, lane0, wave, G0, bx0);
    if (IN(17)) {
        PHASE_BEGIN();
        for (int mrow = gw; mrow < M; mrow += NGW) {
            const float rs = rsqrtf(P.SSQ()[(size_t)4 * M + mrow] * (1.f / DM) + EPS);
            f32x4* xr = (f32x4*)(P.out + (size_t)mrow * DM) + lane; const f32x4* gr = (const f32x4*)P.fin_g + lane;
#pragma unroll
            for (int jv = 0; jv < 8; ++jv) { const f32x4 v = xr[64 * jv], gg = gr[64 * jv]; xr[64 * jv] = v * rs * gg; }
        }
    }
#undef IN
#undef SEAM
}

extern "C" void kernel_launch(void* const* d_in, const int* in_sizes, int n_in, void* d_out, int out_size, void* d_ws, size_t ws_size, hipStream_t stream) {
    static int grid = 0;
    if (grid == 0) {
        if (n_in != 19 || out_size != M * DM || ws_size < WS_END) { fprintf(stderr, "kernel_launch: unexpected problem (n_in %d, out %d, ws %zu < %zu)\n", n_in, out_size, ws_size, (size_t)WS_END); grid = -1; return; }
        int dev = 0, cus = 0, per_cu = 0;
        (void)hipGetDevice(&dev); (void)hipDeviceGetAttribute(&cus, hipDeviceAttributeMultiprocessorCount, dev);
        (void)hipFuncSetAttribute((const void*)fwd_kernel, hipFuncAttributeMaxDynamicSharedMemorySize, LDS_BYTES);
        if (hipOccupancyMaxActiveBlocksPerMultiprocessor(&per_cu, (const void*)fwd_kernel, NTHR, LDS_BYTES) != hipSuccess || per_cu < 1) per_cu = 1;
        (void)hipGetLastError();
        grid = cus > 0 ? cus : 256;
    }
    if (grid < 0) return;
    (void)hipMemsetAsync((unsigned char*)d_ws + OFF_BAR, 0, BAR_BYTES, stream);
    Args a{};
    for (int i = 0; i < 19; ++i) a.in[i] = (const float*)d_in[i];
    a.out = (float*)d_out; a.ws = (unsigned char*)d_ws; a.ph_lo = 0; a.ph_hi = NPH;
    void* params[] = {&a};
    hipError_t e = hipLaunchCooperativeKernel((const void*)fwd_kernel, dim3(grid), dim3(NTHR), params, LDS_BYTES, stream);
    if (e != hipSuccess) fprintf(stderr, "cooperative launch failed: %s (grid %d)\n", hipGetErrorString(e), grid);
}
```
